# Optimizing an MI355X kernel written in HIP

```python
import jax
import jax.numpy as jnp
from jax import lax
import numpy as np


D_MODEL = 1024
BATCH = 1
SEQ = 16384
DEPTH = 2
DEC_BATCH = 8
DEC_SEQ = 32
PAST_LEN = 2048

CHUNK = 64
MIX_BRANCH = D_MODEL // 2
POOL_WINDOWS = (2, 4, 8, 16)
POOL_GROUPS = 4
POOL_WIDTH = MIX_BRANCH
POOL_GW = POOL_WIDTH // POOL_GROUPS
POOL_HIST = 15
GLA_HEADS = 4
GLA_QK_W = D_MODEL // 4
GLA_V_W = MIX_BRANCH
GLA_DK = GLA_QK_W // GLA_HEADS
GLA_DV = GLA_V_W // GLA_HEADS
GLA_RANK = 16
GLA_TAU = 16.0
ATT_HEADS = 8
ATT_DH = 64
ATT_WIDTH = ATT_HEADS * ATT_DH
LEFT_CHUNKS = 8
ATT_WIN = LEFT_CHUNKS * CHUNK
MAX_REL = 128
N_BRANCH = 3
D_FF = -(-8 * D_MODEL // (3 * 256)) * 256
D_IN = POOL_WIDTH + 2 * GLA_QK_W + 2 * GLA_V_W + GLA_RANK + 3 * ATT_WIDTH + N_BRANCH * D_MODEL
EPS = 1e-6

kernel_name = "hybrid_pool_gla_chunkattn_stream_step"


def rms_norm(x, g):
    xf = x.astype(jnp.float32)
    y = xf * lax.rsqrt(jnp.mean(xf * xf, axis=-1, keepdims=True) + EPS)
    return (y * g.astype(jnp.float32)).astype(x.dtype)


def in_proj_offsets():
    sizes = (POOL_WIDTH, GLA_QK_W, GLA_QK_W, GLA_V_W, GLA_V_W, GLA_RANK,
             ATT_WIDTH, ATT_WIDTH, ATT_WIDTH, N_BRANCH * D_MODEL)
    return [int(o) for o in np.cumsum(sizes)[:-1]]


def pool_mixer(u, hist, pos0, pool_map, pool_scale):
    B, T, _ = u.shape
    f32 = jnp.float32
    full = jnp.concatenate([hist.astype(u.dtype), u], axis=1)
    ff = full.astype(f32)
    cs = jnp.concatenate([jnp.zeros((B, 1, POOL_WIDTH), f32), jnp.cumsum(ff, axis=1)], axis=1)
    pos = (pos0 + jnp.arange(T)).astype(f32)
    end = cs[:, POOL_HIST + 1:POOL_HIST + 1 + T]
    groups = []
    for g, w in enumerate(POOL_WINDOWS):
        sl = slice(g * POOL_GW, (g + 1) * POOL_GW)
        start = cs[:, POOL_HIST + 1 - w:POOL_HIST + 1 - w + T, sl]
        cnt = jnp.minimum(float(w), pos + 1.0)[None, :, None]
        groups.append((end[..., sl] - start) / cnt - ff[:, POOL_HIST:, sl])
    p = jnp.stack(groups, axis=2)
    y = jnp.einsum('btgc,gcd->btgd', p, pool_map.astype(f32)).reshape(B, T, POOL_WIDTH)
    y = y * pool_scale.astype(f32)
    return y.astype(u.dtype), full[:, -POOL_HIST:]


def gla_recurrence(q, k, v, log_a, s0):
    B, T, H, DK = q.shape
    DV = v.shape[-1]
    L = min(CHUNK, T)
    n = T // L

    def blocks(a):
        return a.reshape(B, n, L, H, a.shape[-1]).transpose(1, 0, 3, 2, 4)

    causal = jnp.tril(jnp.ones((L, L), dtype=bool))[:, :, None]

    def step(s, blk):
        qb, kb, vb, gb = blk
        b = jnp.cumsum(gb, axis=2)
        o_inter = jnp.einsum('bhld,bhde->bhle', qb * jnp.exp(b), s)
        diff = b[:, :, :, None, :] - b[:, :, None, :, :]
        decay = jnp.exp(jnp.where(causal, diff, -jnp.inf))
        att = jnp.einsum('bhid,bhjd,bhijd->bhij', qb, kb, decay)
        o = o_inter + jnp.einsum('bhij,bhje->bhie', att, vb)
        b_last = b[:, :, -1:, :]
        s_new = jnp.exp(b_last[:, :, 0, :, None]) * s + jnp.einsum('bhld,bhle->bhde', kb * jnp.exp(b_last - b), vb)
        return s_new, o

    s_fin, o = lax.scan(step, s0, (blocks(q), blocks(k), blocks(v), blocks(log_a)))
    o = o.transpose(1, 0, 3, 2, 4).reshape(B, T, H, DV)
    return o, s_fin


def rel_bias_matrix(rel_bias, q_rel, k_rel):
    dist = q_rel[:, None] - k_rel[None, :]
    idx = jnp.clip(dist, -MAX_REL, MAX_REL) + MAX_REL
    return rel_bias[:, idx].astype(jnp.float32)


def band_softmax_attention(qb, kb, vb, bias, valid):
    s = jnp.einsum('bnqhd,bnkhd->bnhqk', qb, kb).astype(jnp.float32) * (ATT_DH ** -0.5) + bias[None, None]
    s = jnp.where(valid[None, :, None, None, :], s, -jnp.inf)
    p = jax.nn.softmax(s, axis=-1).astype(vb.dtype)
    return jnp.einsum('bnhqk,bnkhd->bnqhd', p, vb)


def chunk_band_prompt(q, k, v, rel_bias):
    B, T, H, DH = q.shape
    n = T // CHUNK

    def band(a):
        ap = jnp.pad(a, ((0, 0), (ATT_WIN, 0), (0, 0), (0, 0))).reshape(B, n + LEFT_CHUNKS, CHUNK, H, DH)
        return jnp.concatenate([ap[:, c:c + n] for c in range(LEFT_CHUNKS + 1)], axis=2)

    q_rel = jnp.arange(CHUNK)
    k_rel = jnp.arange((LEFT_CHUNKS + 1) * CHUNK) - ATT_WIN
    valid = (jnp.arange(n)[:, None] * CHUNK + k_rel[None, :]) >= 0
    o = band_softmax_attention(q.reshape(B, n, CHUNK, H, DH), band(k), band(v),
                               rel_bias_matrix(rel_bias, q_rel, k_rel), valid)
    return o.reshape(B, T, H * DH)


def chunk_band_sample(q, k, v, k_cache, v_cache, rel_bias):
    B, T, H, DH = q.shape
    W = k_cache.shape[1]
    keys = jnp.concatenate([k_cache.astype(k.dtype), k], axis=1)[:, None]
    vals = jnp.concatenate([v_cache.astype(v.dtype), v], axis=1)[:, None]
    q_rel = jnp.arange(T)
    k_rel = jnp.concatenate([jnp.arange(W) - W, jnp.arange(T)])
    valid = jnp.ones((1, W + T), dtype=bool)
    o = band_softmax_attention(q[:, None], keys, vals, rel_bias_matrix(rel_bias, q_rel, k_rel), valid)
    return o.reshape(B, T, H * DH)


def hybrid_layer(x, state, pos0, lw):
    (attn_norm_g, w_in, w_gate2, b_gate, gla_norm_g, pool_map, pool_scale, rel_bias,
     w_branch, w_out, ffn_norm_g, w_ffn_in, w_ffn_out) = lw
    B, T, _ = x.shape
    f32 = jnp.float32
    xn = rms_norm(x, attn_norm_g)
    h = xn @ w_in
    u_a, q_b, k_b, v_b, r_b, z_b, q_c, k_c, v_c, gate_logits = jnp.split(h, in_proj_offsets(), axis=-1)

    if state is None:
        pool_hist = jnp.zeros((B, POOL_HIST, POOL_WIDTH), x.dtype)
        s0 = jnp.zeros((B, GLA_HEADS, GLA_DK, GLA_DV), f32)
    else:
        pool_hist, s0, k_cache, v_cache = state
        s0 = s0.astype(f32)

    y_a, pool_new = pool_mixer(u_a, pool_hist, pos0, pool_map, pool_scale)

    log_a = jax.nn.log_sigmoid((z_b @ w_gate2 + b_gate).astype(f32)) / GLA_TAU
    qh = q_b.astype(f32).reshape(B, T, GLA_HEADS, GLA_DK) * (GLA_DK ** -0.5)
    kh = k_b.astype(f32).reshape(B, T, GLA_HEADS, GLA_DK)
    vh = v_b.astype(f32).reshape(B, T, GLA_HEADS, GLA_DV)
    o_b, s_fin = gla_recurrence(qh, kh, vh, log_a.reshape(B, T, GLA_HEADS, GLA_DK), s0)
    o_b = o_b * lax.rsqrt(jnp.mean(o_b * o_b, axis=-1, keepdims=True) + EPS) * gla_norm_g.astype(f32)
    y_b = (o_b.reshape(B, T, GLA_V_W) * jax.nn.silu(r_b.astype(f32))).astype(x.dtype)

    qa = q_c.reshape(B, T, ATT_HEADS, ATT_DH)
    ka = k_c.reshape(B, T, ATT_HEADS, ATT_DH)
    va = v_c.reshape(B, T, ATT_HEADS, ATT_DH)
    if state is None:
        y_c = chunk_band_prompt(qa, ka, va, rel_bias)
        keep = min(ATT_WIN, T)
        k_new, v_new = ka[:, T - keep:], va[:, T - keep:]
    else:
        y_c = chunk_band_sample(qa, ka, va, k_cache, v_cache, rel_bias)
        k_new, v_new = ka, va

    ys = jnp.stack([y_a, y_b, y_c.astype(x.dtype)], axis=2)
    branch = jnp.einsum('btgc,gcd->btgd', ys, w_branch)
    gates = jax.nn.sigmoid(gate_logits.reshape(B, T, N_BRANCH, D_MODEL))
    x = x + jnp.sum(gates * branch, axis=2) @ w_out

    hf = rms_norm(x, ffn_norm_g) @ w_ffn_in
    a, g = jnp.split(hf, 2, axis=-1)
    x = x + (jax.nn.silu(a) * g) @ w_ffn_out
    return x, (pool_new, s_fin.astype(x.dtype), k_new, v_new)


def setup_inputs(seed: int = 0) -> dict:
    key = jax.random.key(seed)
    ks = jax.random.split(key, 20)
    f32 = jnp.float32

    def nrm(k, shape, scale):
        return jax.random.normal(k, shape, f32) * scale

    c_win = min(ATT_WIN, PAST_LEN)
    return {
        'x_prompt': nrm(ks[0], (BATCH, SEQ, D_MODEL), 1.0),
        'x_sample': nrm(ks[1], (DEC_BATCH, DEC_SEQ, D_MODEL), 1.0),
        'cache_pool': nrm(ks[2], (DEPTH, DEC_BATCH, POOL_HIST, POOL_WIDTH), 1.0),
        'state_gla': nrm(ks[3], (DEPTH, DEC_BATCH, GLA_HEADS, GLA_DK, GLA_DV), 1.0),
        'cache_k': nrm(ks[4], (DEPTH, DEC_BATCH, c_win, ATT_HEADS, ATT_DH), 1.0),
        'cache_v': nrm(ks[5], (DEPTH, DEC_BATCH, c_win, ATT_HEADS, ATT_DH), 1.0),
        'attn_norm_g': 1.0 + nrm(ks[6], (DEPTH, D_MODEL), 0.1),
        'w_in': nrm(ks[7], (DEPTH, D_MODEL, D_IN), D_MODEL ** -0.5),
        'w_gate2': nrm(ks[8], (DEPTH, GLA_RANK, GLA_QK_W), GLA_RANK ** -0.5),
        'b_gate': nrm(ks[9], (DEPTH, GLA_QK_W), 0.1),
        'gla_norm_g': 1.0 + nrm(ks[10], (DEPTH, GLA_DV), 0.1),
        'pool_map': nrm(ks[11], (DEPTH, POOL_GROUPS, POOL_GW, POOL_GW), POOL_GW ** -0.5),
        'pool_scale': 1.0 + nrm(ks[12], (DEPTH, POOL_WIDTH), 0.1),
        'rel_bias': nrm(ks[13], (DEPTH, ATT_HEADS, 2 * MAX_REL + 1), 0.5),
        'w_branch': nrm(ks[14], (DEPTH, N_BRANCH, MIX_BRANCH, D_MODEL), MIX_BRANCH ** -0.5),
        'w_out': nrm(ks[15], (DEPTH, D_MODEL, D_MODEL), D_MODEL ** -0.5),
        'ffn_norm_g': 1.0 + nrm(ks[16], (DEPTH, D_MODEL), 0.1),
        'w_ffn_in': nrm(ks[17], (DEPTH, D_MODEL, 2 * D_FF), D_MODEL ** -0.5),
        'w_ffn_out': nrm(ks[18], (DEPTH, D_FF, D_MODEL), D_FF ** -0.5),
        'final_norm_g': 1.0 + nrm(ks[19], (D_MODEL,), 0.1),
    }


def reference(x_prompt, x_sample, cache_pool, state_gla, cache_k, cache_v, attn_norm_g, w_in, w_gate2, b_gate,
              gla_norm_g, pool_map, pool_scale, rel_bias, w_branch, w_out, ffn_norm_g, w_ffn_in, w_ffn_out,
              final_norm_g):
    hp, hs = x_prompt, x_sample
    pool_p, pool_s, gla_p, gla_s, k_p, k_s, v_p, v_s = [], [], [], [], [], [], [], []
    for l in range(DEPTH):
        lw = (attn_norm_g[l], w_in[l], w_gate2[l], b_gate[l], gla_norm_g[l], pool_map[l], pool_scale[l],
              rel_bias[l], w_branch[l], w_out[l], ffn_norm_g[l], w_ffn_in[l], w_ffn_out[l])
        hp, (pp, gp, kp, vp) = hybrid_layer(hp, None, 0, lw)
        hs, (ps, gs, kss, vss) = hybrid_layer(hs, (cache_pool[l], state_gla[l], cache_k[l], cache_v[l]), PAST_LEN, lw)
        pool_p.append(pp); gla_p.append(gp); k_p.append(kp); v_p.append(vp)
        pool_s.append(ps); gla_s.append(gs); k_s.append(kss); v_s.append(vss)
    y_prompt = rms_norm(hp, final_norm_g)
    y_sample = rms_norm(hs, final_norm_g)
    new_pool_prompt = jnp.stack(pool_p)
    new_pool_sample = jnp.stack(pool_s)
    new_gla_prompt = jnp.stack(gla_p)
    new_gla_sample = jnp.stack(gla_s)
    new_k_prompt = jnp.stack(k_p)
    new_k_sample = jnp.stack(k_s)
    new_v_prompt = jnp.stack(v_p)
    new_v_sample = jnp.stack(v_s)
    return (y_prompt, y_sample, new_pool_prompt, new_pool_sample, new_gla_prompt, new_gla_sample,
            new_k_prompt, new_k_sample, new_v_prompt, new_v_sample)
```

```cpp
#include <hip/hip_runtime.h>
#include <hip/hip_bf16.h>
#include <cstdio>
#include <cstdint>

#ifndef MK_ONE_LAUNCH
#define MK_ONE_LAUNCH 0
#endif
#ifndef PH_MASK
#define PH_MASK 0x3ff
#endif
#define PHON(i) (((PH_MASK) >> (i)) & 1)

#define LAS __attribute__((address_space(3)))
#define GAS __attribute__((address_space(1)))
typedef unsigned short bf16_t;
typedef short bf16x8 __attribute__((ext_vector_type(8)));
typedef short s16x4 __attribute__((ext_vector_type(4)));
typedef float f32x4 __attribute__((ext_vector_type(4)));
typedef float f32x2 __attribute__((ext_vector_type(2)));
typedef float f32x16 __attribute__((ext_vector_type(16)));
typedef unsigned u32x4 __attribute__((ext_vector_type(4)));
typedef unsigned u32x2 __attribute__((ext_vector_type(2)));
typedef GAS unsigned gu32;

constexpr int DM = 1024, SEQ = 16384, NSB = 8, NST = 32, MROWS = SEQ + NSB * NST;
constexpr int NPAN = MROWS / 256;
constexpr int DIN = 6672, DFF = 2816;
constexpr float EPS = 1e-6f;
constexpr float LOG2E = 1.4426950408889634f;
constexpr int APITCH = 4864;
constexpr int C_UA = 0, C_QB = 512, C_KB = 768, C_VB = 1024, C_RB = 1536, C_Z = 2048, C_QC = 2304, C_KC = 2816, C_VC = 3328, C_XB = 3840;
constexpr int C_M = 0;
constexpr int C_YA = C_KC, C_YB = C_RB, C_YC = C_QC;
constexpr int C_HID = 0;
__host__ __device__ constexpr int gscr_col(int pn) { return pn == 0 ? 1024 : pn == 1 ? 1280 : pn == 2 ? 2048 : 3328; }
constexpr size_t MiB = 1u << 20;
constexpr size_t WS_CTL = 0, CTL_BYTES = 1 * MiB;
constexpr size_t WS_SS = 1 * MiB;
constexpr size_t WS_AN = 3 * MiB;
constexpr size_t WS_BIAS = 3 * MiB + 512 * 1024;
constexpr size_t WS_W2T = WS_BIAS + 16384;
constexpr size_t WS_PMT = WS_W2T + 16384;
constexpr size_t WS_W = 4 * MiB;
constexpr size_t W_IN = 0, W_G = W_IN + (size_t)3840 * 1024 * 2, W_B = W_G + (size_t)3072 * 1024 * 2, W_O = W_B + (size_t)3072 * 1024 * 2,
                 W_FI = W_O + (size_t)1024 * 1024 * 2, W_FO = W_FI + (size_t)5632 * 1024 * 2, W_END = W_FO + (size_t)1024 * 2816 * 2;
static_assert(W_END <= 38 * MiB, "weights");
constexpr size_t WS_KVS = 42 * MiB;
constexpr size_t WS_DS = 50 * MiB;
constexpr int NGU = 1024 + 32;
constexpr size_t WS_ACT = 67 * MiB;
constexpr size_t WS_END = WS_ACT + (size_t)MROWS * APITCH * 2;
static_assert(WS_DS + (size_t)NGU * 16384 <= WS_ACT && WS_END <= 224 * MiB, "ws map");
constexpr size_t O_Y = 0, O_POOLP = 17039360, O_POOLS = 17054720, O_GLAP = 17177600, O_GLAS = 17243136, O_KP = 17767424, O_KS = 18291712, O_VP = 18553856, O_VS = 19078144, O_TOTAL = 19340288;
constexpr int RING_BYTES = 131072, LDS_BIAS = 131072, LDS_WSF = 131072 + 8448, LDS_MISC = 144 * 1024 - 256, LDS_BYTES = 147456;

struct Params {
    const float* in[20];
    float* out;
    unsigned char* ws;
    int ph_lo, ph_hi;
};

__device__ __forceinline__ unsigned f2bf(float f) { unsigned u = __builtin_bit_cast(unsigned, f); return (u + 0x7fffu + ((u >> 16) & 1u)) >> 16; }
__device__ __forceinline__ unsigned pk2(float lo, float hi) { typedef __bf16 b2 __attribute__((ext_vector_type(2))); f32x2 v = {lo, hi}; b2 b = __builtin_convertvector(v, b2); return __builtin_bit_cast(unsigned, b); }
__device__ __forceinline__ float bf2f(unsigned short h) { return __builtin_bit_cast(float, (unsigned)h << 16); }
__device__ __forceinline__ float bflo(unsigned w) { return __builtin_bit_cast(float, w << 16); }
__device__ __forceinline__ float bfhi(unsigned w) { return __builtin_bit_cast(float, w & 0xffff0000u); }
__device__ __forceinline__ int crow(int r, int hi) { return (r & 3) + 8 * (r >> 2) + 4 * hi; }
__device__ __forceinline__ float fast_sigmoid(float x) { return __builtin_amdgcn_rcpf(1.0f + __builtin_amdgcn_exp2f(-x * LOG2E)); }
#define VM_WAIT() asm volatile("s_waitcnt vmcnt(0)" ::: "memory")
#define LGKM_WAIT() asm volatile("s_waitcnt lgkmcnt(0)" ::: "memory")
#define SBAR() __builtin_amdgcn_sched_barrier(0)
__device__ __forceinline__ s16x4 vtr(const LAS unsigned char* p) { typedef short v4 __attribute__((ext_vector_type(4))); return __builtin_bit_cast(s16x4, __builtin_amdgcn_ds_read_tr16_b64_v4i16((LAS v4*)p)); }
__device__ __forceinline__ bf16x8 cat8(s16x4 a, s16x4 b) { return (bf16x8){a[0], a[1], a[2], a[3], b[0], b[1], b[2], b[3]}; }
__device__ __forceinline__ void dma16(const void* gsrc, LAS unsigned char* dst) { __builtin_amdgcn_global_load_lds((const unsigned*)gsrc, (LAS unsigned*)dst, 16, 0, 0); }
__device__ __forceinline__ float row_rstd_full(const float* ss, int row) {
    const f32x4* p = (const f32x4*)(ss + (size_t)row * 16); f32x4 a = p[0], b = p[1], c = p[2], d = p[3];
    const float s = ((a[0] + a[1]) + (a[2] + a[3])) + ((b[0] + b[1]) + (b[2] + b[3])) + ((c[0] + c[1]) + (c[2] + c[3])) + ((d[0] + d[1]) + (d[2] + d[3]));
    return __builtin_amdgcn_rsqf(s * (1.0f / DM) + EPS);
}

namespace pg8 {
constexpr int BM = 256, BK = 64, HALF = 128, HTB = HALF * BK * 2, STAGE_BYTES = 8 * HTB, NXCD = 8, WGM = 8;
__host__ __device__ __forceinline__ int lds_byte(int r, int c) { const int st = (r >> 4) * 2 + (c >> 5), rr = r & 15, cc = c & 31, ob = rr * 64 + cc * 2; return st * 1024 + (ob ^ (((ob >> 9) & 1) << 5)); }
__host__ __device__ __forceinline__ void stage_rc(int b, int& R, int& C) { const int st = b / 1024, sb = b % 1024, swz = sb ^ (((sb >> 9) & 1) << 5); R = (st >> 1) * 16 + swz / 64; C = (st & 1) * 32 + (swz % 64) / 2; }
__host__ __device__ __forceinline__ int perm32(int rho) { const int n = rho >> 4, i = rho & 15; return 8 * (i >> 2) + 4 * n + (i & 3); }

struct Unit { unsigned A, B; int nt, pm, pn, kind; };
template <int nM, int nN, bool EXTRA>
__device__ __forceinline__ bool tile_of(int L, int& pm, int& pn) {
    constexpr int nwg = nM * nN; static_assert(nM % 8 == 0, "nM");
    if (L >= nwg) { if (EXTRA && L < nwg + nN) { pm = nM; pn = L - nwg; return true; } return false; }
    int wgid = L; { constexpr int q = nwg / NXCD, r = nwg % NXCD; const int xcd = wgid % NXCD, off = wgid / NXCD; wgid = (xcd < r ? xcd * (q + 1) : r * (q + 1) + (xcd - r) * q) + off; }
    constexpr int nig = WGM * nN; const int gid = wgid / nig, rem = wgid - gid * nig;
    pm = gid * WGM + (rem & (WGM - 1)); pn = rem / WGM; return true;
}

template <class Epi, class Sched, bool ALIGN_EPI, int lda, int ldb>
__device__ __forceinline__ void gemm_phase(LAS unsigned char* lds, const char* wsb, const Sched& S, const Epi& E, const int tid) {
    const int wid = __builtin_amdgcn_readfirstlane(tid >> 6), lane = tid & 63, wr = wid >> 2, wc = wid & 3, fr = lane & 15, fq = lane >> 4;
    unsigned voffA[2], voffB[2];
#pragma unroll
    for (int i = 0; i < 2; ++i) { int R, C; stage_rc(tid * 16 + i * 8192, R, C); const int Rb = Epi::PERM ? ((R & ~31) + perm32(R & 31)) : R;
        voffA[i] = (unsigned)(R * lda + C) * 2u; voffB[i] = (unsigned)(Rb * ldb + C) * 2u; }
    const size_t kstep = (size_t)(BK * 2);
    const size_t hstepA = (size_t)HALF * lda * 2, hstepB = (size_t)HALF * ldb * 2;
    const unsigned ldsw = (unsigned)wid * 1024u;
    const int aoff = lds_byte(wr * 64 + fr, fq * 8), boff = lds_byte(wc * 32 + fr, fq * 8);
#define PG8_SA(b, h) (((b) * 2 + (h)) * HTB)
#define PG8_SB(b, h) ((4 + (b) * 2 + (h)) * HTB)
#define PG8_STAGE(bufoff, gbase, voff) do { _Pragma("unroll") for (int _i = 0; _i < 2; ++_i) \
        __builtin_amdgcn_global_load_lds((const unsigned*)((const char*)(gbase) + (voff)[_i]), (LAS unsigned*)(lds + (bufoff) + ldsw + _i * 8192), 16, 0, 0); } while (0)
#define PG8_LDA(dst, b, h) do { _Pragma("unroll") for (int m = 0; m < 4; ++m) _Pragma("unroll") for (int k = 0; k < 2; ++k) dst[m][k] = *(const LAS bf16x8*)(lds + PG8_SA(b, h) + aoff + m * 2048 + k * 1024); } while (0)
#define PG8_LDB(dst, b, h) do { _Pragma("unroll") for (int n = 0; n < 2; ++n) _Pragma("unroll") for (int k = 0; k < 2; ++k) dst[n][k] = *(const LAS bf16x8*)(lds + PG8_SB(b, h) + boff + n * 2048 + k * 1024); } while (0)
#define PG8_MMA(ai, bj, At, Bt) do { __builtin_amdgcn_s_setprio(1); _Pragma("unroll") for (int m = 0; m < 4; ++m) _Pragma("unroll") for (int n = 0; n < 2; ++n) _Pragma("unroll") for (int k = 0; k < 2; ++k) \
        acc[ai][bj][m][n] = __builtin_amdgcn_mfma_f32_16x16x32_bf16(Bt[n][k], At[m][k], acc[ai][bj][m][n], 0, 0, 0); __builtin_amdgcn_s_setprio(0); } while (0)
#define PG8_WAIT_V(n) asm volatile("s_waitcnt vmcnt(" #n ")" ::: "memory")
#define PG8_WAIT_L(n) asm volatile("s_waitcnt lgkmcnt(" #n ")" ::: "memory")
#define PG8_BAR __builtin_amdgcn_s_barrier()
#define PG8_SCHED __builtin_amdgcn_sched_barrier(0)
    Unit cur, nxt; int ui = 0;
    if (!S.next(0, cur)) return;
    f32x4 acc[2][2][4][2];
#pragma unroll
    for (int a = 0; a < 2; ++a)
#pragma unroll
        for (int b = 0; b < 2; ++b)
#pragma unroll
            for (int m = 0; m < 4; ++m)
#pragma unroll
                for (int n = 0; n < 2; ++n) acc[a][b][m][n] = (f32x4){0.f, 0.f, 0.f, 0.f};
    bf16x8 At[4][2], B0[2][2], B1[2][2];
    const char* cA = wsb + cur.A; const char* cB = wsb + cur.B;
    PG8_STAGE(PG8_SB(0, 0), cB, voffB); PG8_STAGE(PG8_SB(0, 1), cB + hstepB, voffB); PG8_STAGE(PG8_SA(0, 0), cA, voffA); PG8_STAGE(PG8_SA(0, 1), cA + hstepA, voffA);
    if (wr == 1) PG8_BAR;
    PG8_WAIT_V(2); PG8_BAR;
    PG8_STAGE(PG8_SB(1, 0), cB + kstep, voffB); PG8_STAGE(PG8_SA(1, 0), cA + kstep, voffA); PG8_STAGE(PG8_SB(1, 1), cB + hstepB + kstep, voffB);
    PG8_WAIT_V(6); PG8_BAR;
    for (;;) {
        const bool has_next = S.next(ui + 1, nxt);
        const char* nA = has_next ? wsb + nxt.A : cA; const char* nB = has_next ? wsb + nxt.B : cB;
        const int nt = cur.nt;
        for (int t = 0; t < nt; t += 2) {
            const bool last = (t == nt - 2);
            const char* a1 = cA + (size_t)(t + 1) * kstep;
            const char* a2 = last ? nA : cA + (size_t)(t + 2) * kstep; const char* b2 = last ? nB : cB + (size_t)(t + 2) * kstep;
            const char* a3 = a2 + kstep; const char* b3 = b2 + kstep;
            PG8_LDB(B0, 0, 0); PG8_LDB(B1, 0, 1); PG8_SCHED; PG8_LDA(At, 0, 0); PG8_STAGE(PG8_SA(1, 1), a1 + hstepA, voffA);
            PG8_WAIT_V(8); PG8_WAIT_L(0); PG8_BAR; PG8_MMA(0, 0, At, B0); PG8_MMA(0, 1, At, B1); PG8_BAR; PG8_SCHED;
            PG8_LDA(At, 0, 1); PG8_STAGE(PG8_SB(0, 0), b2, voffB); PG8_STAGE(PG8_SB(0, 1), b2 + hstepB, voffB); PG8_STAGE(PG8_SA(0, 0), a2, voffA);
            PG8_WAIT_V(8); PG8_WAIT_L(0); PG8_BAR; PG8_MMA(1, 0, At, B0); PG8_MMA(1, 1, At, B1); PG8_BAR; PG8_SCHED;
            PG8_LDB(B0, 1, 0); PG8_LDB(B1, 1, 1); PG8_SCHED; PG8_LDA(At, 1, 0); PG8_STAGE(PG8_SA(0, 1), a2 + hstepA, voffA);
            PG8_WAIT_V(8); PG8_WAIT_L(0); PG8_BAR; PG8_MMA(0, 0, At, B0); PG8_MMA(0, 1, At, B1); PG8_BAR; PG8_SCHED;
            PG8_LDA(At, 1, 1); PG8_STAGE(PG8_SB(1, 0), b3, voffB); PG8_STAGE(PG8_SB(1, 1), b3 + hstepB, voffB); PG8_STAGE(PG8_SA(1, 0), a3, voffA);
            PG8_WAIT_V(8); PG8_WAIT_L(0); PG8_BAR; PG8_MMA(1, 0, At, B0); PG8_MMA(1, 1, At, B1); PG8_BAR; PG8_SCHED;
        }
        if constexpr (ALIGN_EPI) { if (wr == 0) PG8_BAR; }
        E(acc, cur, wr, wc, fr, fq);
        if (!has_next) break;
#pragma unroll
        for (int a = 0; a < 2; ++a)
#pragma unroll
            for (int b = 0; b < 2; ++b)
#pragma unroll
                for (int m = 0; m < 4; ++m)
#pragma unroll
                    for (int n = 0; n < 2; ++n) acc[a][b][m][n] = (f32x4){0.f, 0.f, 0.f, 0.f};
        cur = nxt; cA = nA; cB = nB; ++ui;
        if constexpr (ALIGN_EPI) { if (wr == 1) PG8_BAR; }
    }
    PG8_WAIT_V(0);
    if constexpr (!ALIGN_EPI) { if (wr == 0) PG8_BAR; }
    PG8_BAR;
#undef PG8_SA
#undef PG8_SB
#undef PG8_STAGE
#undef PG8_LDA
#undef PG8_LDB
#undef PG8_MMA
#undef PG8_WAIT_V
#undef PG8_WAIT_L
#undef PG8_BAR
#undef PG8_SCHED
}
}

using pg8::Unit;
template <int nM, int nN, bool EXTRA, unsigned ABASE, unsigned WBASE, int NT, unsigned WROWB>
struct SchedDense {
    int G, c;
    __device__ __forceinline__ bool next(int i, Unit& u) const {
        int pm, pn; if (!pg8::tile_of<nM, nN, EXTRA>(i * G + c, pm, pn)) return false;
        u.pm = pm; u.pn = pn; u.kind = 0; u.nt = NT; u.A = ABASE + (unsigned)pm * (256u * APITCH * 2u); u.B = WBASE + (unsigned)pn * (256u * WROWB); return true; }
};
struct SchedMerge {
    int G, c;
    __device__ __forceinline__ bool next(int i, Unit& u) const {
        const int su = i / 6, sub = i - su * 6; int pm, pn; if (!pg8::tile_of<64, 4, false>(su * G + c, pm, pn)) return false;
        const int g = sub >> 1; u.pm = pm; u.pn = pn; u.kind = sub;
        const unsigned arow = (unsigned)WS_ACT + (unsigned)pm * (256u * APITCH * 2u), brow = (unsigned)(g * 1024 + pn * 256) * 2048u;
        if ((sub & 1) == 0) { u.nt = 16; u.A = arow + C_XB * 2; u.B = (unsigned)(WS_W + W_G) + brow; }
        else { const int yc = g == 0 ? C_YA : g == 1 ? C_YB : C_YC; u.nt = 8; u.A = arow + yc * 2; u.B = (unsigned)(WS_W + W_B) + brow; }
        return true; }
};

__device__ __forceinline__ float row_rstd_q(const float* ss, int row, int fq) {
    const f32x4 a = *(const f32x4*)(ss + (size_t)row * 16 + 4 * fq); float s = (a[0] + a[1]) + (a[2] + a[3]);
    s += __shfl_xor(s, 16); s += __shfl_xor(s, 32); return __builtin_amdgcn_rsqf(s * (1.0f / DM) + EPS);
}
struct EpiA {
    static constexpr bool PERM = true;
    bf16_t* act; const float* ss;
    __device__ __forceinline__ void operator()(const f32x4 (&acc)[2][2][4][2], const Unit& u, int wr, int wc, int fr, int fq) const {
        const int row0 = u.pm * 256 + wr * 64 + fr, col0 = u.pn * 256 + wc * 32 + 8 * fq;
#pragma unroll
        for (int ai = 0; ai < 2; ++ai)
#pragma unroll
            for (int m = 0; m < 4; ++m) { const int row = row0 + ai * 128 + m * 16; const float rs = row_rstd_q(ss, row, fq); bf16_t* rowp = act + (size_t)row * APITCH + col0;
#pragma unroll
                for (int bj = 0; bj < 2; ++bj) { const f32x4 v0 = acc[ai][bj][m][0] * rs, v1 = acc[ai][bj][m][1] * rs;
                    u32x4 w; w.x = pk2(v0[0], v0[1]); w.y = pk2(v0[2], v0[3]); w.z = pk2(v1[0], v1[1]); w.w = pk2(v1[2], v1[3]); *(u32x4*)(rowp + bj * 128) = w; } }
    }
};
struct EpiE {
    static constexpr bool PERM = true;
    bf16_t* act; const float* ss;
    __device__ __forceinline__ void operator()(const f32x4 (&acc)[2][2][4][2], const Unit& u, int wr, int wc, int fr, int fq) const {
        const int row0 = u.pm * 256 + wr * 64 + fr, col0 = C_HID + u.pn * 128 + wc * 32 + 8 * fq;
#pragma unroll
        for (int ai = 0; ai < 2; ++ai)
#pragma unroll
            for (int m = 0; m < 4; ++m) { const int row = row0 + ai * 128 + m * 16; const float rs = row_rstd_q(ss, row, fq);
                float h[8];
#pragma unroll
                for (int n = 0; n < 2; ++n)
#pragma unroll
                    for (int e = 0; e < 4; ++e) { const float a = acc[ai][0][m][n][e] * rs, g = acc[ai][1][m][n][e] * rs; h[n * 4 + e] = a * fast_sigmoid(a) * g; }
                u32x4 w; w.x = pk2(h[0], h[1]); w.y = pk2(h[2], h[3]); w.z = pk2(h[4], h[5]); w.w = pk2(h[6], h[7]); *(u32x4*)(act + (size_t)row * APITCH + col0) = w; }
    }
};
struct EpiRes {
    static constexpr bool PERM = false;
    const float* res; float* out; bf16_t* act; float* ss;
    __device__ __forceinline__ void operator()(const f32x4 (&acc)[2][2][4][2], const Unit& u, int wr, int wc, int fr, int fq) const {
        const int row0 = u.pm * 256 + wr * 64 + fr, col0 = u.pn * 256 + wc * 32 + 4 * fq;
#pragma unroll
        for (int ai = 0; ai < 2; ++ai)
#pragma unroll
            for (int m = 0; m < 4; ++m) { const int row = row0 + ai * 128 + m * 16; float q = 0.f;
#pragma unroll
                for (int bj = 0; bj < 2; ++bj)
#pragma unroll
                    for (int n = 0; n < 2; ++n) { const int c = col0 + bj * 128 + n * 16; const f32x4 x = *(const f32x4*)(res + (size_t)row * DM + c) + acc[ai][bj][m][n];
                        *(f32x4*)(out + (size_t)row * DM + c) = x; q += (x[0] * x[0] + x[1] * x[1]) + (x[2] * x[2] + x[3] * x[3]);
                        u32x2 w; w.x = pk2(x[0], x[1]); w.y = pk2(x[2], x[3]); *(u32x2*)(act + (size_t)row * APITCH + C_XB + c) = w; }
                q += __shfl_xor(q, 16); q += __shfl_xor(q, 32);
                if (fq == 0) ss[(size_t)row * 16 + 4 * u.pn + wc] = q; }
    }
};
struct EpiMerge {
    static constexpr bool PERM = true;
    bf16_t* act; const float* ss;
    __device__ __forceinline__ void operator()(const f32x4 (&acc)[2][2][4][2], const Unit& u, int wr, int wc, int fr, int fq) const {
        const int row0 = u.pm * 256 + wr * 64 + fr, cin = wc * 32 + 8 * fq, gcol = gscr_col(u.pn) + cin, mcol = C_M + u.pn * 256 + cin;
        if ((u.kind & 1) == 0) {
#pragma unroll
            for (int ai = 0; ai < 2; ++ai)
#pragma unroll
                for (int m = 0; m < 4; ++m) { const int row = row0 + ai * 128 + m * 16; const float rs = row_rstd_q(ss, row, fq); bf16_t* rowp = act + (size_t)row * APITCH + gcol;
#pragma unroll
                    for (int bj = 0; bj < 2; ++bj) { f32x4 v0 = acc[ai][bj][m][0] * rs, v1 = acc[ai][bj][m][1] * rs;
#pragma unroll
                        for (int e = 0; e < 4; ++e) { v0[e] = fast_sigmoid(v0[e]); v1[e] = fast_sigmoid(v1[e]); }
                        u32x4 w; w.x = pk2(v0[0], v0[1]); w.y = pk2(v0[2], v0[3]); w.z = pk2(v1[0], v1[1]); w.w = pk2(v1[2], v1[3]); *(u32x4*)(rowp + bj * 128) = w; } }
        } else {
            const bool first = (u.kind == 1);
#pragma unroll
            for (int ai = 0; ai < 2; ++ai)
#pragma unroll
                for (int m = 0; m < 4; ++m) { const int row = row0 + ai * 128 + m * 16; bf16_t* rowp = act + (size_t)row * APITCH;
#pragma unroll
                    for (int bj = 0; bj < 2; ++bj) { const u32x4 gw = *(const u32x4*)(rowp + gcol + bj * 128); u32x4 mo = (u32x4){0u, 0u, 0u, 0u}; if (!first) mo = *(const u32x4*)(rowp + mcol + bj * 128);
                        const f32x4 a0 = acc[ai][bj][m][0], a1 = acc[ai][bj][m][1]; float r[8];
                        r[0] = a0[0] * bflo(gw.x) + bflo(mo.x); r[1] = a0[1] * bfhi(gw.x) + bfhi(mo.x); r[2] = a0[2] * bflo(gw.y) + bflo(mo.y); r[3] = a0[3] * bfhi(gw.y) + bfhi(mo.y);
                        r[4] = a1[0] * bflo(gw.z) + bflo(mo.z); r[5] = a1[1] * bfhi(gw.z) + bfhi(mo.z); r[6] = a1[2] * bflo(gw.w) + bflo(mo.w); r[7] = a1[3] * bfhi(gw.w) + bfhi(mo.w);
                        u32x4 w; w.x = pk2(r[0], r[1]); w.y = pk2(r[2], r[3]); w.z = pk2(r[4], r[5]); w.w = pk2(r[6], r[7]); *(u32x4*)(rowp + mcol + bj * 128) = w; } }
        }
    }
};

template <int KSTEPS>
__device__ __forceinline__ void small_tile_partial(const bf16_t* A, int lda, const bf16_t* Bt, int ldb, int wave, int lane, f32x4 (&acc)[4]) {
    const int kk0 = wave * KSTEPS * 32 + 8 * (lane >> 4); const bf16_t* ap = A + (size_t)(lane & 15) * lda + kk0; const bf16_t* bp = Bt + (size_t)(lane & 15) * ldb + kk0;
#pragma unroll
    for (int j = 0; j < 4; ++j) acc[j] = (f32x4){0.f, 0.f, 0.f, 0.f};
#pragma unroll
    for (int s = 0; s < KSTEPS; ++s) { const bf16x8 a = *(const bf16x8*)(ap + 32 * s);
#pragma unroll
        for (int j = 0; j < 4; ++j) { const bf16x8 b = *(const bf16x8*)(bp + (size_t)(16 * j) * ldb + 32 * s); acc[j] = __builtin_amdgcn_mfma_f32_16x16x32_bf16(a, b, acc[j], 0, 0, 0); } }
}
__device__ __forceinline__ f32x2 small_tile_reduce(LAS float* red, const f32x4 (&acc)[4], int wave, int lane, int tid) {
#pragma unroll
    for (int j = 0; j < 4; ++j)
#pragma unroll
        for (int r = 0; r < 4; ++r) red[(wave * 16 + 4 * (lane >> 4) + r) * 68 + 16 * j + (lane & 15)] = acc[j][r];
    __syncthreads();
    const int row = tid >> 5, c2 = 2 * (tid & 31); f32x2 s = {0.f, 0.f};
#pragma unroll
    for (int w = 0; w < 8; ++w) { const f32x2 v = *(const LAS f32x2*)(red + (w * 16 + row) * 68 + c2); s += v; }
    __syncthreads();
    return s;
}

constexpr float ATT_THR = 8.0f;
template <bool SAMP>
__device__ __forceinline__ void attn_task(bf16_t* act, const bf16_t* kvs, int cb, int h, int qb0, LAS unsigned char* vbuf, LAS float* wsf, const LAS float* tab, int lane) {
    constexpr int NQB = 1;
    const int r32 = lane & 31, hi = lane >> 5;
    const int nt = SAMP ? 9 : ((cb < 8 ? cb : 8) + 1);
    const int qrow0 = SAMP ? SEQ + 32 * cb : 64 * cb + 32 * qb0;
    const int vp0 = ((lane >> 4) & 1) * 32 + (lane & 3) * 8 + (4 * hi + ((lane & 15) >> 2)) * 64;
    bf16x8 qr[NQB][4];
#pragma unroll
    for (int qb = 0; qb < NQB; ++qb)
#pragma unroll
        for (int j = 0; j < 4; ++j) qr[qb][j] = *(const bf16x8*)(act + (size_t)(qrow0 + 32 * qb + r32) * APITCH + C_QC + h * 64 + 16 * j + 8 * hi);
    float mhat[NQB], lsum[NQB]; f32x16 o[NQB][2];
#pragma unroll
    for (int qb = 0; qb < NQB; ++qb) { mhat[qb] = 0.f; lsum[qb] = 0.f;
#pragma unroll
        for (int r = 0; r < 16; ++r) { o[qb][0][r] = 0.f; o[qb][1][r] = 0.f; } }
    const float bconst = tab[256];
#define ATT_TILE(t, kp, vp, pitch) do { if (SAMP && (t) < 8) { const size_t off_ = ((size_t)(cb * 512 + 64 * (t)) * 512 + h * 64) * 2; kp = (const char*)kvs + off_; vp = (const char*)kvs + (size_t)8 * 512 * 512 * 2 + off_; pitch = 1024; } \
        else { const int row_ = SAMP ? SEQ + 32 * cb : 64 * (cb - (nt - 1) + (t)); kp = (const char*)(act + (size_t)row_ * APITCH + C_KC + h * 64); vp = (const char*)(act + (size_t)row_ * APITCH + C_VC + h * 64); pitch = (size_t)APITCH * 2; } } while (0)
#define ATT_VDMA(vp, pitch, buf) do { _Pragma("unroll") for (int p_ = 0; p_ < 8; ++p_) dma16((vp) + (size_t)(16 * (p_ & 3) + (lane >> 2)) * (pitch) + ((p_ >> 2) * 32 + (lane & 3) * 8) * 2, (buf) + p_ * 1024); } while (0)
#define ATT_KLOAD(kp, pitch) do { _Pragma("unroll") for (int j_ = 0; j_ < 4; ++j_) { kf[2 * j_] = *(const bf16x8*)((kp) + (size_t)r32 * (pitch) + (16 * j_ + 8 * hi) * 2); kf[2 * j_ + 1] = *(const bf16x8*)((kp) + (size_t)(32 + r32) * (pitch) + (16 * j_ + 8 * hi) * 2); } } while (0)
    bf16x8 kf[8];
    { const char* kp; const char* vp; size_t pitch; ATT_TILE(0, kp, vp, pitch); LGKM_WAIT(); ATT_VDMA(vp, pitch, vbuf); ATT_KLOAD(kp, pitch); }
    for (int t = 0; t < nt; ++t) {
        const int delta = nt - 1 - t; const bool half = SAMP && (t == 8);
        LAS unsigned char* vcur = vbuf + (t & 1) * 8192;
        VM_WAIT();
        const char* kpn = nullptr; const char* vpn = nullptr; size_t pitchn = 0;
        if (t + 1 < nt) { ATT_TILE(t + 1, kpn, vpn, pitchn); LGKM_WAIT(); ATT_VDMA(vpn, pitchn, vbuf + ((t + 1) & 1) * 8192); }
#pragma unroll
        for (int qb = 0; qb < NQB; ++qb) {
            f32x16 c0, c1;
            if (delta >= 3) { const float cbv = bconst - mhat[qb];
#pragma unroll
                for (int r = 0; r < 16; ++r) { c0[r] = cbv; c1[r] = cbv; } }
            else { const int base = 64 * delta + 32 * (qb0 + qb) + r32 + 128;
#pragma unroll
                for (int r = 0; r < 16; ++r) { const int i0 = base - crow(r, hi), i1 = i0 - 32; c0[r] = tab[i0 < 256 ? i0 : 256] - mhat[qb]; c1[r] = tab[i1 < 256 ? i1 : 256] - mhat[qb]; } }
#pragma unroll
            for (int j = 0; j < 4; ++j) { c0 = __builtin_amdgcn_mfma_f32_32x32x16_bf16(kf[2 * j], qr[qb][j], c0, 0, 0, 0); if (!half) c1 = __builtin_amdgcn_mfma_f32_32x32x16_bf16(kf[2 * j + 1], qr[qb][j], c1, 0, 0, 0); }
            if (qb == NQB - 1 && t + 1 < nt) { asm volatile("" ::: "memory"); ATT_KLOAD(kpn, pitchn); }
            float rm = c0[0];
#pragma unroll
            for (int r = 1; r < 16; ++r) rm = fmaxf(rm, c0[r]);
            if (!half) {
#pragma unroll
                for (int r = 0; r < 16; ++r) rm = fmaxf(rm, c1[r]); }
            rm = fmaxf(rm, __shfl_xor(rm, 32));
            if (t == 0) { mhat[qb] += rm;
#pragma unroll
                for (int r = 0; r < 16; ++r) { c0[r] -= rm; c1[r] -= rm; } }
            else if (__any(rm > ATT_THR)) { const float dl = fmaxf(rm, 0.f); mhat[qb] += dl;
#pragma unroll
                for (int r = 0; r < 16; ++r) { c0[r] -= dl; c1[r] -= dl; }
                const float f = __builtin_amdgcn_exp2f(-dl); lsum[qb] *= f; if (hi == 0) wsf[r32] = f;
#pragma unroll
                for (int r = 0; r < 16; ++r) { const float fr_ = wsf[crow(r, hi)]; o[qb][0][r] *= fr_; o[qb][1][r] *= fr_; } }
            float ps = 0.f;
#pragma unroll
            for (int r = 0; r < 16; ++r) { c0[r] = __builtin_amdgcn_exp2f(c0[r]); ps += c0[r]; }
            if (!half) {
#pragma unroll
                for (int r = 0; r < 16; ++r) { c1[r] = __builtin_amdgcn_exp2f(c1[r]); ps += c1[r]; } }
            lsum[qb] += ps;
            u32x4 pw[4];
            pw[0] = (u32x4){pk2(c0[0], c0[1]), pk2(c0[2], c0[3]), pk2(c0[4], c0[5]), pk2(c0[6], c0[7])};
            pw[1] = (u32x4){pk2(c0[8], c0[9]), pk2(c0[10], c0[11]), pk2(c0[12], c0[13]), pk2(c0[14], c0[15])};
            pw[2] = (u32x4){pk2(c1[0], c1[1]), pk2(c1[2], c1[3]), pk2(c1[4], c1[5]), pk2(c1[6], c1[7])};
            pw[3] = (u32x4){pk2(c1[8], c1[9]), pk2(c1[10], c1[11]), pk2(c1[12], c1[13]), pk2(c1[14], c1[15])};
#pragma unroll
            for (int d0 = 0; d0 < 2; ++d0)
#pragma unroll
                for (int ks = 0; ks < 4; ++ks) { if (half && ks >= 2) continue;
                    const bf16x8 vf = cat8(vtr(vcur + d0 * 4096 + ks * 1024 + vp0), vtr(vcur + d0 * 4096 + ks * 1024 + vp0 + 512));
                    o[qb][d0] = __builtin_amdgcn_mfma_f32_32x32x16_bf16(__builtin_bit_cast(bf16x8, pw[ks]), vf, o[qb][d0], 0, 0, 0); }
        }
    }
#undef ATT_TILE
#undef ATT_VDMA
#undef ATT_KLOAD
    LAS bf16_t* stg = (LAS bf16_t*)vbuf;
#pragma unroll
    for (int qb = 0; qb < NQB; ++qb) {
        float lt = lsum[qb]; lt += __shfl_xor(lt, 32);
        if (hi == 0) wsf[32 + r32] = lt;
#pragma unroll
        for (int r = 0; r < 16; ++r) { const float rl = __builtin_amdgcn_rcpf(wsf[32 + crow(r, hi)]); const int orow = crow(r, hi);
            stg[orow * 64 + r32] = (bf16_t)f2bf(o[qb][0][r] * rl); stg[orow * 64 + 32 + r32] = (bf16_t)f2bf(o[qb][1][r] * rl); }
#pragma unroll
        for (int i = 0; i < 4; ++i) { const int row = i * 8 + (lane >> 3), ch = lane & 7; const u32x4 v = *(const LAS u32x4*)(stg + row * 64 + ch * 8);
            *(u32x4*)(act + (size_t)(qrow0 + 32 * qb + row) * APITCH + C_YC + h * 64 + ch * 8) = v; }
        LGKM_WAIT();
    }
}

__device__ __forceinline__ float log_sigmoid_f(float x) { const float ax = fabsf(x); return fminf(x, 0.f) - 0.6931471805599453f * __builtin_amdgcn_logf(1.0f + __builtin_amdgcn_exp2f(-ax * LOG2E)); }
template <int L>
__device__ __forceinline__ void gla1_unit(bf16_t* act, const bf16_t* w2t, const float* bgate, float* an, bf16_t* ds, int u, int tok0, int h, int parity, LAS unsigned char* lds, int tid, int wave, int lane) {
    constexpr int NTB = L / 32, NKS = L / 16;
    const int r32 = lane & 31, hi = lane >> 5;
    LAS float* Ep = (LAS float*)lds; LAS float* Em = (LAS float*)(lds + 16384); LAS unsigned char* kimg = lds + 32768; LAS unsigned char* vimg = lds + 40960 + parity * 16384; LAS float* totl = (LAS float*)(lds + 73728);
    const int vp0 = ((lane >> 4) & 1) * 32 + (lane & 3) * 8 + (4 * hi + ((lane & 15) >> 2)) * 64;
    float b[16]; const int tb = wave >> 1, db = wave & 1;
    if (wave < 2 * NTB) {
        const bf16x8 A = *(const bf16x8*)(act + (size_t)(tok0 + 32 * tb + r32) * APITCH + C_Z + 8 * hi);
        const bf16x8 B = *(const bf16x8*)(w2t + (h * 64 + 32 * db + r32) * 16 + 8 * hi);
        const float bg = bgate[h * 64 + 32 * db + r32]; f32x16 X;
#pragma unroll
        for (int r = 0; r < 16; ++r) X[r] = bg;
        X = __builtin_amdgcn_mfma_f32_32x32x16_bf16(A, B, X, 0, 0, 0);
        float la[16], seg[4], oth[4];
#pragma unroll
        for (int r = 0; r < 16; ++r) la[r] = log_sigmoid_f(X[r]) * 0.0625f;
#pragma unroll
        for (int q = 0; q < 4; ++q) { seg[q] = (la[4 * q] + la[4 * q + 1]) + (la[4 * q + 2] + la[4 * q + 3]); oth[q] = __shfl_xor(seg[q], 32); }
        float run = 0.f;
#pragma unroll
        for (int q = 0; q < 4; ++q) { float st = run + (hi ? oth[q] : 0.f);
#pragma unroll
            for (int i = 0; i < 4; ++i) { st += la[4 * q + i]; b[4 * q + i] = st; }
            run += seg[q] + oth[q]; }
        if (NTB == 2 && tb == 0 && hi == 0) totl[db * 32 + r32] = run;
    } else if (wave >= 4) {
        const int eb = wave - 4;
#pragma unroll
        for (int ks = 0; ks < NKS; ++ks) dma16(act + (size_t)(tok0 + 16 * ks + (lane >> 2)) * APITCH + C_VB + h * 128 + 32 * eb + (lane & 3) * 8, vimg + (eb * 4 + ks) * 1024);
        VM_WAIT();
    }
    __syncthreads();
    if (wave < 2 * NTB) {
        if (NTB == 2 && tb == 1) { const float carry = totl[db * 32 + r32];
#pragma unroll
            for (int r = 0; r < 16; ++r) b[r] += carry; }
#pragma unroll
        for (int r = 0; r < 16; ++r) { const int tok = 32 * tb + crow(r, hi); const float bl = b[r] * LOG2E; Ep[tok * 64 + 32 * db + r32] = __builtin_amdgcn_exp2f(bl); Em[tok * 64 + 32 * db + r32] = __builtin_amdgcn_exp2f(-bl); }
        if (tb == NTB - 1 && hi == 1) an[(size_t)u * 64 + 32 * db + r32] = __builtin_amdgcn_exp2f(b[15] * LOG2E);
    }
    __syncthreads();
    if (tid < L * 8) {
        const int tok = tid >> 3, c8 = tid & 7; bf16_t* qp = act + (size_t)(tok0 + tok) * APITCH + C_QB + h * 64 + 8 * c8; bf16_t* kp = act + (size_t)(tok0 + tok) * APITCH + C_KB + h * 64 + 8 * c8;
        const u32x4 qv = *(const u32x4*)qp, kv = *(const u32x4*)kp;
        const f32x4 e0 = *(const LAS f32x4*)(Ep + tok * 64 + 8 * c8), e1 = *(const LAS f32x4*)(Ep + tok * 64 + 8 * c8 + 4), m0 = *(const LAS f32x4*)(Em + tok * 64 + 8 * c8), m1 = *(const LAS f32x4*)(Em + tok * 64 + 8 * c8 + 4);
        u32x4 qo, ko;
        qo.x = pk2(bflo(qv.x) * e0[0], bfhi(qv.x) * e0[1]); qo.y = pk2(bflo(qv.y) * e0[2], bfhi(qv.y) * e0[3]); qo.z = pk2(bflo(qv.z) * e1[0], bfhi(qv.z) * e1[1]); qo.w = pk2(bflo(qv.w) * e1[2], bfhi(qv.w) * e1[3]);
        ko.x = pk2(bflo(kv.x) * m0[0], bfhi(kv.x) * m0[1]); ko.y = pk2(bflo(kv.y) * m0[2], bfhi(kv.y) * m0[3]); ko.z = pk2(bflo(kv.z) * m1[0], bfhi(kv.z) * m1[1]); ko.w = pk2(bflo(kv.w) * m1[2], bfhi(kv.w) * m1[3]);
        *(u32x4*)qp = qo; *(u32x4*)kp = ko;
        *(LAS u32x4*)(kimg + ((c8 >> 2) * 4 + (tok >> 4)) * 1024 + (tok & 15) * 64 + (c8 & 3) * 16) = ko;
    }
    __syncthreads();
    {
        const int eb = wave & 3, db2 = wave >> 2; f32x16 acc;
#pragma unroll
        for (int r = 0; r < 16; ++r) acc[r] = 0.f;
#pragma unroll
        for (int ks = 0; ks < NKS; ++ks) { const bf16x8 va = cat8(vtr(vimg + (eb * 4 + ks) * 1024 + vp0), vtr(vimg + (eb * 4 + ks) * 1024 + vp0 + 512));
            const bf16x8 kb = cat8(vtr(kimg + (db2 * 4 + ks) * 1024 + vp0), vtr(kimg + (db2 * 4 + ks) * 1024 + vp0 + 512));
            acc = __builtin_amdgcn_mfma_f32_32x32x16_bf16(va, kb, acc, 0, 0, 0); }
        bf16_t* dp = ds + (size_t)u * 8192 + 32 * db2 + r32;
#pragma unroll
        for (int r = 0; r < 16; ++r) dp[(32 * eb + crow(r, hi)) * 64] = (bf16_t)f2bf(acc[r]);
    }
}
template <int L>
__device__ __forceinline__ void gla3_task(bf16_t* act, const bf16_t* ds, const float* gn, int u, int tok0, int h, int ib, LAS unsigned char* vimg, int lane) {
    constexpr int NKS = L / 16;
    const int r32 = lane & 31, hi = lane >> 5;
    const int vp0 = ((lane >> 4) & 1) * 32 + (lane & 3) * 8 + (4 * hi + ((lane & 15) >> 2)) * 64;
    LGKM_WAIT();
#pragma unroll
    for (int eb = 0; eb < 4; ++eb)
#pragma unroll
        for (int ks = 0; ks < NKS; ++ks) dma16(act + (size_t)(tok0 + 16 * ks + (lane >> 2)) * APITCH + C_VB + h * 128 + 32 * eb + (lane & 3) * 8, vimg + (eb * 4 + ks) * 1024);
    bf16x8 qf[4];
#pragma unroll
    for (int s = 0; s < 4; ++s) qf[s] = *(const bf16x8*)(act + (size_t)(tok0 + 32 * ib + r32) * APITCH + C_QB + h * 64 + 16 * s + 8 * hi);
    f32x16 acc[4];
#pragma unroll
    for (int eb = 0; eb < 4; ++eb)
#pragma unroll
        for (int r = 0; r < 16; ++r) acc[eb][r] = 0.f;
    const bf16_t* sg = ds + (size_t)u * 8192;
#pragma unroll
    for (int eb = 0; eb < 4; ++eb) { asm volatile("" ::: "memory");
#pragma unroll
        for (int s = 0; s < 4; ++s) { const bf16x8 sa = *(const bf16x8*)(sg + (32 * eb + r32) * 64 + 16 * s + 8 * hi); acc[eb] = __builtin_amdgcn_mfma_f32_32x32x16_bf16(sa, qf[s], acc[eb], 0, 0, 0); } }
    VM_WAIT();
    for (int jb = 0; jb <= ib; ++jb) {
        f32x16 X;
#pragma unroll
        for (int r = 0; r < 16; ++r) X[r] = 0.f;
        asm volatile("" ::: "memory");
#pragma unroll
        for (int s = 0; s < 4; ++s) { const bf16x8 kfr = *(const bf16x8*)(act + (size_t)(tok0 + 32 * jb + r32) * APITCH + C_KB + h * 64 + 16 * s + 8 * hi); X = __builtin_amdgcn_mfma_f32_32x32x16_bf16(kfr, qf[s], X, 0, 0, 0); }
        if (jb == ib) {
#pragma unroll
            for (int r = 0; r < 16; ++r) if (crow(r, hi) > r32) X[r] = 0.f; }
        const u32x4 x0 = (u32x4){pk2(X[0], X[1]), pk2(X[2], X[3]), pk2(X[4], X[5]), pk2(X[6], X[7])}, x1 = (u32x4){pk2(X[8], X[9]), pk2(X[10], X[11]), pk2(X[12], X[13]), pk2(X[14], X[15])};
#pragma unroll
        for (int eb = 0; eb < 4; ++eb)
#pragma unroll
            for (int s2 = 0; s2 < 2; ++s2) { asm volatile("" ::: "memory"); const int ks = 2 * jb + s2; const bf16x8 vf = cat8(vtr(vimg + (eb * 4 + ks) * 1024 + vp0), vtr(vimg + (eb * 4 + ks) * 1024 + vp0 + 512));
                acc[eb] = __builtin_amdgcn_mfma_f32_32x32x16_bf16(vf, __builtin_bit_cast(bf16x8, s2 ? x1 : x0), acc[eb], 0, 0, 0); }
    }
    float ssq = 0.f;
#pragma unroll
    for (int eb = 0; eb < 4; ++eb)
#pragma unroll
        for (int r = 0; r < 16; ++r) ssq += acc[eb][r] * acc[eb][r];
    ssq += __shfl_xor(ssq, 32);
    const float rs = __builtin_amdgcn_rsqf(ssq * (1.0f / 128.0f) + EPS);
    bf16_t* rowp = act + (size_t)(tok0 + 32 * ib + r32) * APITCH + C_RB + h * 128;
#pragma unroll
    for (int eb = 0; eb < 4; ++eb)
#pragma unroll
        for (int q = 0; q < 4; ++q) { asm volatile("" ::: "memory"); const int e0 = 32 * eb + 8 * q + 4 * hi; const f32x4 g = *(const f32x4*)(gn + e0); const u32x2 rv = *(const u32x2*)(rowp + e0);
            const float r0 = bflo(rv.x), r1 = bfhi(rv.x), r2 = bflo(rv.y), r3 = bfhi(rv.y);
            u32x2 w; w.x = pk2(acc[eb][4 * q] * rs * g[0] * r0 * fast_sigmoid(r0), acc[eb][4 * q + 1] * rs * g[1] * r1 * fast_sigmoid(r1));
            w.y = pk2(acc[eb][4 * q + 2] * rs * g[2] * r2 * fast_sigmoid(r2), acc[eb][4 * q + 3] * rs * g[3] * r3 * fast_sigmoid(r3)); *(u32x2*)(rowp + e0) = w; }
}

template <int GI>
__device__ __forceinline__ void pool_task(bf16_t* act, const float* hist  , const bf16_t* pmt, const float* pscale, int row0, int pos0, LAS unsigned char* ptile, int lane) {
    constexpr int W = 2 << GI;
    const int r32 = lane & 31, hi = lane >> 5;
    const int col = 128 * GI + 2 * lane;
    f32x2 uv[W - 1 + 32];
#pragma unroll
    for (int j = 0; j < W - 1 + 32; ++j) { const int t = j - (W - 1);
        if (t >= 0 || (hist == nullptr && row0 + t >= 0)) { const unsigned w = *(const unsigned*)(act + (size_t)(row0 + t) * APITCH + C_UA + col); uv[j] = (f32x2){bflo(w), bfhi(w)}; }
        else if (hist != nullptr) uv[j] = *(const f32x2*)(hist + (size_t)(15 + t) * 512 + col);
        else uv[j] = (f32x2){0.f, 0.f}; }
    f32x2 sum = {0.f, 0.f};
#pragma unroll
    for (int j = 0; j < W - 1; ++j) sum += uv[j];
    LGKM_WAIT();
#pragma unroll
    for (int t = 0; t < 32; ++t) { sum += uv[t + W - 1]; const int pos = pos0 + t; const float inv = 1.0f / (float)(pos + 1 < W ? pos + 1 : W);
        const f32x2 p = sum * inv - uv[t + W - 1]; *(LAS unsigned*)(ptile + (t * 136 + 2 * lane) * 2) = pk2(p[0], p[1]); sum -= uv[t]; }
    f32x16 acc[4];
#pragma unroll
    for (int db = 0; db < 4; ++db)
#pragma unroll
        for (int r = 0; r < 16; ++r) acc[db][r] = 0.f;
#pragma unroll
    for (int s = 0; s < 8; ++s) { asm volatile("" ::: "memory"); const bf16x8 pf = *(const LAS bf16x8*)(ptile + (r32 * 136 + 16 * s + 8 * hi) * 2);
#pragma unroll
        for (int db = 0; db < 4; ++db) { const bf16x8 mf = *(const bf16x8*)(pmt + (size_t)GI * 16384 + (32 * db + r32) * 128 + 16 * s + 8 * hi); acc[db] = __builtin_amdgcn_mfma_f32_32x32x16_bf16(mf, pf, acc[db], 0, 0, 0); } }
    bf16_t* rowp = act + (size_t)(row0 + r32) * APITCH + C_YA + 128 * GI;
#pragma unroll
    for (int db = 0; db < 4; ++db)
#pragma unroll
        for (int q = 0; q < 4; ++q) { asm volatile("" ::: "memory"); const int d0 = 32 * db + 8 * q + 4 * hi; const f32x4 sc = *(const f32x4*)(pscale + 128 * GI + d0);
            u32x2 w; w.x = pk2(acc[db][4 * q] * sc[0], acc[db][4 * q + 1] * sc[1]); w.y = pk2(acc[db][4 * q + 2] * sc[2], acc[db][4 * q + 3] * sc[3]); *(u32x2*)(rowp + d0) = w; }
}

#define XB_TMO      128
#define XB_XCNT(j)  (256  + 64 * (j))
#define XB_XSUB(j)  (1280 + 64 * (j))
#define XB_XGEN(j)  (2304 + 64 * (j))
#define XB_TOP      3328
#define XB_TOPGEN   3392
#define XCD_BAR_WORDS 3456
#define XB_SPIN_CAP (1u << 22)
__device__ __forceinline__ unsigned xb_ld(unsigned* p)              { return __hip_atomic_load(p, __ATOMIC_RELAXED, __HIP_MEMORY_SCOPE_AGENT); }
__device__ __forceinline__ unsigned xb_add(unsigned* p, unsigned v) { return __hip_atomic_fetch_add(p, v, __ATOMIC_RELAXED, __HIP_MEMORY_SCOPE_AGENT); }
__device__ __forceinline__ unsigned xb_xcc_id() { return (unsigned)__builtin_amdgcn_s_getreg((3 << 11) | 20) & 0xFu; }
#define XB_SPIN(cond, bar) do { unsigned _sp = 0; while (cond) { __builtin_amdgcn_s_sleep(1); \
    if ((++_sp & 255u) == 0u) { if (xb_ld(&(bar)[XB_TMO])) break; if (_sp > XB_SPIN_CAP) { atomicAdd(&(bar)[XB_TMO], 1u); break; } } } } while (0)
struct XcdBarrier { unsigned* bar; unsigned x; volatile LAS unsigned* st; };
__device__ __forceinline__ XcdBarrier xcd_barrier_post(unsigned* bar, volatile LAS unsigned* st) {
    XcdBarrier b; b.bar = bar; b.x = xb_xcc_id(); b.st = st;
    if (threadIdx.x == 0) (void)xb_add(&bar[XB_XCNT(b.x)], 1u);
    return b;
}
__device__ __forceinline__ void xcd_barrier_complete(unsigned* bar, unsigned x, unsigned& nloc, unsigned& nx) {
    const unsigned G = gridDim.x * gridDim.y * gridDim.z;
    unsigned sum, cnt, mine, sp = 0u;
    for (;;) {
        sum = 0u; cnt = 0u; mine = 0u;
#pragma unroll
        for (unsigned j = 0; j < 16; ++j) { const unsigned c = xb_ld(&bar[XB_XCNT(j)]); sum += c; cnt += (c > 0u) ? 1u : 0u; mine = (j == x) ? c : mine; }
        if (sum == G) break;
        __builtin_amdgcn_s_sleep(1);
        if ((++sp & 255u) == 0u) { if (xb_ld(&bar[XB_TMO])) break; if (sp > XB_SPIN_CAP) { atomicAdd(&bar[XB_TMO], 1u); break; } }
    }
    nloc = mine > 0u ? mine : 1u; nx = cnt > 0u ? cnt : 1u;
}
__device__ __forceinline__ void xcd_barrier(const XcdBarrier& b) {
    asm volatile("s_waitcnt vmcnt(0)" ::: "memory");
    __syncthreads();
    if (threadIdx.x == 0) {
        unsigned* bar = b.bar;
        __builtin_amdgcn_s_waitcnt(0);
        unsigned nloc = b.st[0], nx = b.st[1];
        if (nloc == 0u) { xcd_barrier_complete(bar, b.x, nloc, nx); b.st[0] = nloc; b.st[1] = nx; }
        const unsigned old = xb_add(&bar[XB_XSUB(b.x)], 1u);
        const unsigned gen = old / nloc;
        if (old + 1u == (gen + 1u) * nloc) {
            __builtin_amdgcn_fence(__ATOMIC_RELEASE, "agent");
            asm volatile("s_waitcnt vmcnt(0)" ::: "memory");
            const unsigned og = xb_add(&bar[XB_TOP], 1u);
            const unsigned tg = og / nx;
            if (og + 1u == (tg + 1u) * nx) xb_add(&bar[XB_TOPGEN], 1u);
            else XB_SPIN(xb_ld(&bar[XB_TOPGEN]) == tg, bar);
            __builtin_amdgcn_fence(__ATOMIC_ACQUIRE, "agent");
            xb_add(&bar[XB_XGEN(b.x)], 1u);
            asm volatile("s_waitcnt vmcnt(0)" ::: "memory");
        } else {
            XB_SPIN(xb_ld(&bar[XB_XGEN(b.x)]) == gen, bar);
            __builtin_amdgcn_fence(__ATOMIC_ACQUIRE, "agent");
            asm volatile("s_waitcnt vmcnt(0)" ::: "memory");
        }
    }
    __syncthreads();
}

__device__ __forceinline__ float wave_sum(float v) {
#pragma unroll
    for (int o = 1; o < 64; o <<= 1) v += __shfl_xor(v, o);
    return v;
}
__device__ __forceinline__ int src_col(int sel, int n) {
    if (sel == 1) return n < 2064 ? n : (n < 2304 ? -1 : n - 240);
    if (sel == 2) { const int pn = n >> 8, jj = n & 255; return jj < 128 ? 128 * pn + jj : 2816 + 128 * pn + (jj - 128); }
    return n;
}
__device__ __forceinline__ void tr_item(const float* W, int ldw, int sel, int coff, const float* gain, bf16_t* WT, int dpitch, int kb, int nb, LAS float* scr, int lane) {
    const int k0 = 64 * kb, n0 = 32 * nb; const int sc = src_col(sel, n0 + (lane & 31));
#pragma unroll 8
    for (int i = 0; i < 32; ++i) { const int kk = 2 * i + (lane >> 5); float v = 0.f; if (sc >= 0) v = W[(size_t)(k0 + kk) * ldw + coff + sc]; if (gain) v *= gain[k0 + kk]; scr[kk * 33 + (lane & 31)] = v; }
    LGKM_WAIT(); asm volatile("" ::: "memory");
    const int c = lane & 7;
#pragma unroll
    for (int j = 0; j < 4; ++j) { const int n = (lane >> 3) + 8 * j; const LAS float* s = scr + (8 * c) * 33 + n; const int dn = n0 + n;
        float rsc = 1.f; if (sel == 1) rsc = (dn >= 512 && dn < 768) ? 0.125f : ((dn >= 2304 && dn < 2816) ? 0.125f * LOG2E : 1.f);
        u32x4 o; o.x = pk2(s[0 * 33] * rsc, s[1 * 33] * rsc); o.y = pk2(s[2 * 33] * rsc, s[3 * 33] * rsc); o.z = pk2(s[4 * 33] * rsc, s[5 * 33] * rsc); o.w = pk2(s[6 * 33] * rsc, s[7 * 33] * rsc);
        *(u32x4*)(WT + (size_t)dn * dpitch + k0 + 8 * c) = o; }
    LGKM_WAIT(); asm volatile("" ::: "memory");
}
__device__ __forceinline__ void phase_wconv(const Params& p, int l, LAS unsigned char* lds, int tid, int wave, int lane, int vcu, int G) {
    LAS float* scr = (LAS float*)(lds + wave * 16384);
    unsigned char* ws = p.ws; bf16_t* wbase = (bf16_t*)(ws + WS_W);
    const int gw = vcu * 8 + wave, NGW = G * 8;
    const float* w_in = p.in[7] + (size_t)l * DM * DIN; const float* ang = p.in[6] + l * DM; const float* fng = p.in[16] + l * DM;
    constexpr int I0 = 120 * 16, I1 = 96 * 16, I2 = 3 * 32 * 8, I3 = 32 * 16, I4 = 176 * 16, I5 = 32 * 44, I6 = 4 * 4 * 2, NIT = I0 + I1 + I2 + I3 + I4 + I5 + I6;
    for (int it = gw; it < NIT; it += NGW) {
        int r = it;
        if (r < I0) { tr_item(w_in, DIN, 1, 0, ang, wbase + W_IN / 2, 1024, r % 16, r / 16, scr, lane); continue; } r -= I0;
        if (r < I1) { tr_item(w_in, DIN, 0, 3600, ang, wbase + W_G / 2, 1024, r % 16, r / 16, scr, lane); continue; } r -= I1;
        if (r < I2) { const int g = r / 256, rr = r % 256; tr_item(p.in[14] + (size_t)(l * 3 + g) * 512 * 1024, 1024, 0, 0, nullptr, wbase + W_B / 2 + (size_t)g * 1024 * 1024, 1024, rr % 8, rr / 8, scr, lane); continue; } r -= I2;
        if (r < I3) { tr_item(p.in[15] + (size_t)l * 1024 * 1024, 1024, 0, 0, nullptr, wbase + W_O / 2, 1024, r % 16, r / 16, scr, lane); continue; } r -= I3;
        if (r < I4) { tr_item(p.in[17] + (size_t)l * 1024 * 5632, 5632, 2, 0, fng, wbase + W_FI / 2, 1024, r % 16, r / 16, scr, lane); continue; } r -= I4;
        if (r < I5) { tr_item(p.in[18] + (size_t)l * 2816 * 1024, 1024, 0, 0, nullptr, wbase + W_FO / 2, 2816, r % 44, r / 44, scr, lane); continue; } r -= I5;
        { const int g = r / 8, rr = r % 8; tr_item(p.in[11] + (size_t)(l * 4 + g) * 128 * 128, 128, 0, 0, nullptr, (bf16_t*)(ws + WS_PMT) + (size_t)g * 16384, 128, rr % 2, rr / 2, scr, lane); }
    }
    const int gt = vcu * 512 + tid, NGT = G * 512;
    for (int i = gt; i < 4096; i += NGT) { const int col = i >> 4, k = i & 15; ((bf16_t*)(ws + WS_W2T))[i] = (bf16_t)f2bf(p.in[8][(size_t)l * 16 * 256 + k * 256 + col]); }
    for (int i = gt; i < 8 * 260; i += NGT) { const int h = i / 260, j = i % 260; ((float*)(ws + WS_BIAS))[i] = j < 257 ? p.in[13][(size_t)(l * 8 + h) * 257 + j] * LOG2E : 0.f; }
    { const float* ck = p.in[4] + (size_t)l * 2097152; const float* cv = p.in[5] + (size_t)l * 2097152; bf16_t* kd = (bf16_t*)(ws + WS_KVS);
        for (int i = gt; i < 2 * 262144; i += NGT) { const int which = i >= 262144, j = which ? i - 262144 : i; const float* s = (which ? cv : ck) + (size_t)j * 8; const f32x4 a = *(const f32x4*)s, b = *(const f32x4*)(s + 4);
            u32x4 o; o.x = pk2(a[0], a[1]); o.y = pk2(a[2], a[3]); o.z = pk2(b[0], b[1]); o.w = pk2(b[2], b[3]); *(u32x4*)(kd + (size_t)which * 2097152 + (size_t)j * 8) = o; } }
    if (l == 0) {
        bf16_t* act = (bf16_t*)(ws + WS_ACT); float* ss = (float*)(ws + WS_SS);
        for (int m = gw; m < MROWS; m += NGW) { const float* xr = m < SEQ ? p.in[0] + (size_t)m * DM : p.in[1] + (size_t)(m - SEQ) * DM; float q = 0.f;
#pragma unroll
            for (int j = 0; j < 4; ++j) { const f32x4 v = *(const f32x4*)(xr + 256 * j + 4 * lane); q += (v[0] * v[0] + v[1] * v[1]) + (v[2] * v[2] + v[3] * v[3]);
                u32x2 w; w.x = pk2(v[0], v[1]); w.y = pk2(v[2], v[3]); *(u32x2*)(act + (size_t)m * APITCH + C_XB + 256 * j + 4 * lane) = w; }
            q = wave_sum(q); if (lane < 16) ss[(size_t)m * 16 + lane] = lane == 0 ? q : 0.f; }
    }
}

__device__ __forceinline__ void phase_scan(const Params& p, int l, int tid, int wave, int lane, int vcu, int G) {
    unsigned char* ws = p.ws; bf16_t* ds = (bf16_t*)(ws + WS_DS); const float* an = (const float*)(ws + WS_AN);
    if (wave < 2) {
        for (int wv = vcu * 2 + wave; wv < 512; wv += G * 2) {
            const int el = wv * 64 + lane, h = el >> 13, idx = el & 8191, d = idx & 63, e = idx >> 6; float S = 0.f;
            for (int n0 = 0; n0 < 256; n0 += 8) { float dv[8], av[8];
#pragma unroll
                for (int j = 0; j < 8; ++j) { const int u = (n0 + j) * 4 + h; dv[j] = bf2f(ds[(size_t)u * 8192 + idx]); av[j] = an[(size_t)u * 64 + d]; }
#pragma unroll
                for (int j = 0; j < 8; ++j) { const int u = (n0 + j) * 4 + h; ds[(size_t)u * 8192 + idx] = (bf16_t)f2bf(S); S = av[j] * (S + dv[j]); } }
            p.out[O_GLAP + (size_t)l * 32768 + (size_t)h * 8192 + d * 128 + e] = S;
        }
    } else {
        for (int wv = vcu * 6 + (wave - 2); wv < 32 * 128; wv += G * 6) {
            const int el = wv * 64 + lane, ub = el >> 13, idx = el & 8191, d = idx & 63, e = idx >> 6, u = 1024 + ub;
            const float s0 = p.in[3][(size_t)l * 262144 + (size_t)ub * 8192 + d * 128 + e]; const float dv = bf2f(ds[(size_t)u * 8192 + idx]);
            ds[(size_t)u * 8192 + idx] = (bf16_t)f2bf(s0);
            p.out[O_GLAS + (size_t)l * 262144 + (size_t)ub * 8192 + d * 128 + e] = an[(size_t)u * 64 + d] * (s0 + dv);
        }
    }
}

__device__ __forceinline__ void copy8(const bf16_t* s, float* d) { const u32x4 v = *(const u32x4*)s; *(f32x4*)d = (f32x4){bflo(v.x), bfhi(v.x), bflo(v.y), bfhi(v.y)}; *(f32x4*)(d + 4) = (f32x4){bflo(v.z), bfhi(v.z), bflo(v.w), bfhi(v.w)}; }
__device__ __forceinline__ void phase_copies(const Params& p, int l, int tid, int vcu, int G) {
    const bf16_t* act = (const bf16_t*)(p.ws + WS_ACT); float* out = p.out;
    const int gt = vcu * 512 + tid, NGT = G * 512;
    constexpr int NKP = 512 * 64, NKS_ = 256 * 64, NPP = 15 * 64, NPS = 8 * 15 * 64, NTOT = 2 * NKP + 2 * NKS_ + NPP + NPS;
    for (int i = gt; i < NTOT; i += NGT) {
        int r = i;
        if (r < 2 * NKP) { const int v = r >= NKP; if (v) r -= NKP; const int row = r >> 6, c8 = r & 63; copy8(act + (size_t)(SEQ - 512 + row) * APITCH + (v ? C_VC : C_KC) + 8 * c8, out + (v ? O_VP : O_KP) + (size_t)l * 262144 + (size_t)row * 512 + 8 * c8); continue; } r -= 2 * NKP;
        if (r < 2 * NKS_) { const int v = r >= NKS_; if (v) r -= NKS_; const int row = r >> 6, c8 = r & 63; copy8(act + (size_t)(SEQ + row) * APITCH + (v ? C_VC : C_KC) + 8 * c8, out + (v ? O_VS : O_KS) + (size_t)l * 131072 + (size_t)row * 512 + 8 * c8); continue; } r -= 2 * NKS_;
        if (r < NPP) { const int row = r >> 6, c8 = r & 63; copy8(act + (size_t)(SEQ - 15 + row) * APITCH + C_UA + 8 * c8, out + O_POOLP + (size_t)l * 7680 + (size_t)row * 512 + 8 * c8); continue; } r -= NPP;
        { const int b = r / (15 * 64), rr = r % (15 * 64), row = rr >> 6, c8 = rr & 63; copy8(act + (size_t)(SEQ + 32 * b + 17 + row) * APITCH + C_UA + 8 * c8, out + O_POOLS + (size_t)l * 61440 + (size_t)(b * 15 + row) * 512 + 8 * c8); }
    }
}

constexpr int CW_BAR = 4096;
constexpr int NPHASE = 19;

__global__ void __launch_bounds__(512, 2) mk_fwd(Params p) {
    extern __shared__ __attribute__((aligned(16))) unsigned char lds_raw[];
    LAS unsigned char* lds = (LAS unsigned char*)lds_raw;
    const int tid0 = threadIdx.x;
    const int G = gridDim.x; const int bx = blockIdx.x; const int vcu = (G % 8 == 0) ? (bx % 8) * (G / 8) + bx / 8 : bx;
    volatile LAS unsigned* MISC = (volatile LAS unsigned*)(lds + LDS_MISC);
    if (tid0 < 64) MISC[tid0] = 0u;
    __syncthreads();
    unsigned char* ws = p.ws;
    unsigned* ctl = (unsigned*)(ws + WS_CTL);
    bf16_t* act = (bf16_t*)(ws + WS_ACT); float* ss = (float*)(ws + WS_SS); bf16_t* wbase = (bf16_t*)(ws + WS_W);
    XcdBarrier bar; bar.bar = ctl + CW_BAR; bar.x = 0; bar.st = nullptr;
    if (p.ph_hi - p.ph_lo > 1) bar = xcd_barrier_post(ctl + CW_BAR, MISC + 8);

    for (int ph = p.ph_lo; ph < p.ph_hi; ++ph) {
        int tid = tid0; asm volatile("" : "+v"(tid));
        const int lane = tid & 63, wave = __builtin_amdgcn_readfirstlane(tid >> 6);
        const int l = ph == 0 ? 0 : (ph - 1) / 9, sub = ph == 0 ? -1 : (ph - 1) % 9;
        if (ph == 0) { if (PHON(9)) phase_wconv(p, 0, lds, tid, wave, lane, vcu, G); }
        else if (sub == 0 && PHON(0)) {
            typedef SchedDense<64, 15, true, (unsigned)(WS_ACT + C_XB * 2), (unsigned)(WS_W + W_IN), 16, 2048u> SA;
            SA S{G, bx}; EpiA E{act, ss};
            pg8::gemm_phase<EpiA, SA, true, APITCH, 1024>(lds, (const char*)ws, S, E, tid);
        } else if (sub == 1 && PHON(1)) {
            const float* bsrc = (const float*)(ws + WS_BIAS); LAS float* tab = (LAS float*)(lds + LDS_BIAS);
            for (int i = tid; i < 8 * 260; i += 512) tab[i] = bsrc[i];
            __syncthreads();
            LAS unsigned char* vbuf = lds + wave * 16384; LAS float* wsf = (LAS float*)(lds + LDS_WSF) + wave * 128;
            const bf16_t* kvs = (const bf16_t*)(ws + WS_KVS);
            for (int c = vcu; c < 256; c += G) { int ln = lane; asm volatile("" : "+v"(ln)); attn_task<false>(act, kvs, c, wave, 0, vbuf, wsf, tab + wave * 260, ln); asm volatile("" : "+v"(ln)); attn_task<false>(act, kvs, c, wave, 1, vbuf, wsf, tab + wave * 260, ln); }
            for (int b = 0; b < 8; ++b) if ((G - 1 - b) % G == vcu) { int ln = lane; asm volatile("" : "+v"(ln)); attn_task<true>(act, kvs, b, wave, 0, vbuf, wsf, tab + wave * 260, ln); }
            VM_WAIT(); LGKM_WAIT();
            __syncthreads();
            const bf16_t* w2t = (const bf16_t*)(ws + WS_W2T); const float* bgate = p.in[9] + l * 256; float* an = (float*)(ws + WS_AN); bf16_t* ds = (bf16_t*)(ws + WS_DS);
            int cnt = 0;
            for (int u = vcu; u < 1024; u += G) { gla1_unit<64>(act, w2t, bgate, an, ds, u, (u >> 2) * 64, u & 3, cnt & 1, lds, tid, wave, lane); ++cnt; }
            for (int su = vcu; su < 32; su += G) { gla1_unit<32>(act, w2t, bgate, an, ds, 1024 + su, SEQ + 32 * (su >> 2), su & 3, cnt & 1, lds, tid, wave, lane); ++cnt; }
            phase_copies(p, l, tid, vcu, G);
        } else if (sub == 2 && PHON(2)) phase_scan(p, l, tid, wave, lane, vcu, G);
        else if (sub == 3 && PHON(3)) {
            const int gw = vcu * 8 + wave, NGW = G * 8; LAS unsigned char* wl = lds + wave * 16384;
            const bf16_t* ds = (const bf16_t*)(ws + WS_DS); const float* gn = p.in[10] + l * 128;
            for (int t = gw; t < 2048; t += NGW) { int ln = lane; asm volatile("" : "+v"(ln)); const int u = t >> 1; gla3_task<64>(act, ds, gn, u, (u >> 2) * 64, u & 3, t & 1, wl, ln); }
            for (int t = gw; t < 32; t += NGW) { int ln = lane; asm volatile("" : "+v"(ln)); gla3_task<32>(act, ds, gn, 1024 + t, SEQ + 32 * (t >> 2), t & 3, 0, wl, ln); }
            const bf16_t* pmt = (const bf16_t*)(ws + WS_PMT); const float* psc = p.in[12] + l * 512;
            for (int t = NGW - 1 - gw; t < 520 * 4; t += NGW) { int ln = lane; asm volatile("" : "+v"(ln)); const int tt = t >> 2, g = t & 3; const bool sm = tt >= 512;
                const int row0 = sm ? SEQ + 32 * (tt - 512) : 32 * tt, pos0 = sm ? 2048 : 32 * tt; const float* hist = sm ? p.in[2] + (size_t)((l * 8 + (tt - 512)) * 15) * 512 : nullptr;
                if (g == 0) pool_task<0>(act, hist, pmt, psc, row0, pos0, wl, ln); else if (g == 1) pool_task<1>(act, hist, pmt, psc, row0, pos0, wl, ln);
                else if (g == 2) pool_task<2>(act, hist, pmt, psc, row0, pos0, wl, ln); else pool_task<3>(act, hist, pmt, psc, row0, pos0, wl, ln); }
        } else if (sub == 4 && PHON(4)) {
            SchedMerge S{G, bx}; EpiMerge E{act, ss};
            pg8::gemm_phase<EpiMerge, SchedMerge, true, APITCH, 1024>(lds, (const char*)ws, S, E, tid);
            LAS float* red = (LAS float*)lds;
            for (int T = vcu; T < 256; T += G) { const int rb = T >> 4, cb = T & 15, row0 = SEQ + 16 * rb, col0 = 64 * cb, row = row0 + (tid >> 5), col = col0 + 2 * (tid & 31);
                const float rs = row_rstd_full(ss, row); f32x2 m2 = {0.f, 0.f};
#pragma unroll
                for (int g = 0; g < 3; ++g) { f32x4 acc[4]; const int yc = g == 0 ? C_YA : g == 1 ? C_YB : C_YC;
                    small_tile_partial<4>(act + (size_t)row0 * APITCH + C_XB, APITCH, wbase + W_G / 2 + (size_t)(g * 1024 + col0) * 1024, 1024, wave, lane, acc);
                    const f32x2 gv = small_tile_reduce(red, acc, wave, lane, tid);
                    small_tile_partial<2>(act + (size_t)row0 * APITCH + yc, APITCH, wbase + W_B / 2 + (size_t)(g * 1024 + col0) * 1024, 1024, wave, lane, acc);
                    const f32x2 bv = small_tile_reduce(red, acc, wave, lane, tid);
                    m2[0] += fast_sigmoid(gv[0] * rs) * bv[0]; m2[1] += fast_sigmoid(gv[1] * rs) * bv[1]; }
                *(unsigned*)(act + (size_t)row * APITCH + C_M + col) = pk2(m2[0], m2[1]); }
        } else if ((sub == 5 || sub == 7) && PHON(5)) {
            const bool fo = sub == 7;
            const float* resp = (l == 0 && !fo) ? p.in[0] : p.out;
            EpiRes E{resp, p.out, act, ss};
            if (!fo) { typedef SchedDense<64, 4, false, (unsigned)(WS_ACT + C_M * 2), (unsigned)(WS_W + W_O), 16, 2048u> SD; SD S{G, bx}; pg8::gemm_phase<EpiRes, SD, true, APITCH, 1024>(lds, (const char*)ws, S, E, tid); }
            else { typedef SchedDense<64, 4, false, (unsigned)(WS_ACT + C_HID * 2), (unsigned)(WS_W + W_FO), 44, 5632u> SF; SF S{G, bx}; pg8::gemm_phase<EpiRes, SF, true, APITCH, 2816>(lds, (const char*)ws, S, E, tid); }
            LAS float* red = (LAS float*)lds;
            for (int T = vcu; T < 256; T += G) { const int rb = T >> 4, cb = T & 15, row0 = SEQ + 16 * rb, col0 = 64 * cb, row = row0 + (tid >> 5), col = col0 + 2 * (tid & 31);
                f32x4 acc[4];
                if (!fo) small_tile_partial<4>(act + (size_t)row0 * APITCH + C_M, APITCH, wbase + W_O / 2 + (size_t)col0 * 1024, 1024, wave, lane, acc);
                else small_tile_partial<11>(act + (size_t)row0 * APITCH + C_HID, APITCH, wbase + W_FO / 2 + (size_t)col0 * 2816, 2816, wave, lane, acc);
                const f32x2 v = small_tile_reduce(red, acc, wave, lane, tid);
                const float* rp = (l == 0 && !fo) ? p.in[1] + (size_t)(row - SEQ) * DM + col : p.out + (size_t)row * DM + col;
                const f32x2 x = *(const f32x2*)rp + v; *(f32x2*)(p.out + (size_t)row * DM + col) = x;
                *(unsigned*)(act + (size_t)row * APITCH + C_XB + col) = pk2(x[0], x[1]);
                float q = x[0] * x[0] + x[1] * x[1];
#pragma unroll
                for (int o = 1; o < 32; o <<= 1) q += __shfl_xor(q, o);
                if ((tid & 31) == 0) ss[(size_t)row * 16 + cb] = q; }
        } else if (sub == 6 && PHON(6)) {
            typedef SchedDense<64, 22, true, (unsigned)(WS_ACT + C_XB * 2), (unsigned)(WS_W + W_FI), 16, 2048u> SE;
            SE S{G, bx}; EpiE E{act, ss};
            pg8::gemm_phase<EpiE, SE, true, APITCH, 1024>(lds, (const char*)ws, S, E, tid);
        } else if (sub == 8 && l == 0) { if (PHON(9)) phase_wconv(p, 1, lds, tid, wave, lane, vcu, G); }
        else if (sub == 8 && PHON(8)) {
            const float* fg = p.in[19]; const int gw = vcu * 8 + wave, NGW = G * 8;
            for (int m = gw; m < MROWS; m += NGW) { const float rs = row_rstd_full(ss, m); float* xr = p.out + (size_t)m * DM;
#pragma unroll
                for (int j = 0; j < 4; ++j) { const f32x4 v = *(const f32x4*)(xr + 256 * j + 4 * lane), g = *(const f32x4*)(fg + 256 * j + 4 * lane); *(f32x4*)(xr + 256 * j + 4 * lane) = v * rs * g; } }
        }
        if (ph + 1 < p.ph_hi) xcd_barrier(bar);
    }
}

extern "C" void kernel_launch(void* const* d_in, const int* in_sizes, int n_in, void* d_out, int out_size, void* d_ws, size_t ws_size, hipStream_t stream) {
    static int grid = 0;
    if (grid == 0) {
        if (n_in != 20 || out_size != (int)O_TOTAL || ws_size < WS_END) { fprintf(stderr, "kernel_launch: unexpected problem (n_in %d out %d ws %zu)\n", n_in, out_size, ws_size); grid = -1; return; }
        int dev = 0, cus = 0, per_cu = 0;
        if (hipGetDevice(&dev) != hipSuccess || hipDeviceGetAttribute(&cus, hipDeviceAttributeMultiprocessorCount, dev) != hipSuccess) { grid = -1; return; }
        if (hipFuncSetAttribute((const void*)mk_fwd, hipFuncAttributeMaxDynamicSharedMemorySize, LDS_BYTES) != hipSuccess) { fprintf(stderr, "kernel_launch: hipFuncSetAttribute failed\n"); grid = -1; return; }
        if (hipOccupancyMaxActiveBlocksPerMultiprocessor(&per_cu, (const void*)mk_fwd, 512, LDS_BYTES) != hipSuccess || per_cu < 1) { fprintf(stderr, "kernel_launch: occupancy query says %d\n", per_cu); per_cu = 1; }
        (void)hipGetLastError();
        grid = cus;
    }
    if (grid < 0) return;
    (void)hipMemsetAsync((char*)d_ws + WS_CTL, 0, CTL_BYTES, stream);
    Params a{};
    for (int i = 0; i < 20; ++i) a.in[i] = (const float*)d_in[i];
    a.out = (float*)d_out; a.ws = (unsigned char*)d_ws;
#if MK_ONE_LAUNCH
    a.ph_lo = 0; a.ph_hi = NPHASE;
    hipLaunchKernelGGL(mk_fwd, dim3(grid), dim3(512), LDS_BYTES, stream, a);
#else
    for (int ph = 0; ph < NPHASE; ++ph) { a.ph_lo = ph; a.ph_hi = ph + 1; hipLaunchKernelGGL(mk_fwd, dim3(grid), dim3(512), LDS_BYTES, stream, a); }
#endif
}
```

```cpp
#include <hip/hip_runtime.h>
#include <hip/hip_bf16.h>
#include <cstdio>
#include <cstdint>

#ifndef MK_ONE_LAUNCH
#define MK_ONE_LAUNCH 1
#endif
#ifndef PH_MASK
#define PH_MASK 0x3ff
#endif
#define PHON(i) (((PH_MASK) >> (i)) & 1)

#define LAS __attribute__((address_space(3)))
#define GAS __attribute__((address_space(1)))
typedef unsigned short bf16_t;
typedef short bf16x8 __attribute__((ext_vector_type(8)));
typedef short s16x4 __attribute__((ext_vector_type(4)));
typedef float f32x4 __attribute__((ext_vector_type(4)));
typedef float f32x2 __attribute__((ext_vector_type(2)));
typedef float f32x16 __attribute__((ext_vector_type(16)));
typedef unsigned u32x4 __attribute__((ext_vector_type(4)));
typedef unsigned u32x2 __attribute__((ext_vector_type(2)));
typedef GAS unsigned gu32;

constexpr int DM = 1024, SEQ = 16384, NSB = 8, NST = 32, MROWS = SEQ + NSB * NST;
constexpr int NPAN = MROWS / 256;
constexpr int DIN = 6672, DFF = 2816;
constexpr float EPS = 1e-6f;
constexpr float LOG2E = 1.4426950408889634f;
constexpr int APITCH = 4864;
constexpr int C_UA = 0, C_QB = 512, C_KB = 768, C_VB = 1024, C_RB = 1536, C_Z = 2048, C_QC = 2304, C_KC = 2816, C_VC = 3328, C_XB = 3840;
constexpr int C_M = 0;
constexpr int C_YA = C_KC, C_YB = C_RB, C_YC = C_QC;
constexpr int C_HID = 0;
__host__ __device__ constexpr int gscr_col(int pn) { return pn == 0 ? 1024 : pn == 1 ? 1280 : pn == 2 ? 2048 : 3328; }
constexpr size_t MiB = 1u << 20;
constexpr size_t WS_CTL = 0, CTL_BYTES = 1 * MiB;
constexpr size_t WS_SS = 1 * MiB;
constexpr size_t WS_AN = 3 * MiB;
constexpr size_t WS_BIAS = 3 * MiB + 512 * 1024;
constexpr size_t WS_W2T = WS_BIAS + 16384;
constexpr size_t WS_PMT = WS_W2T + 16384;
constexpr size_t WS_W = 4 * MiB;
constexpr size_t W_IN = 0, W_G = W_IN + (size_t)3840 * 1024 * 2, W_B = W_G + (size_t)3072 * 1024 * 2, W_O = W_B + (size_t)3072 * 1024 * 2,
                 W_FI = W_O + (size_t)1024 * 1024 * 2, W_FO = W_FI + (size_t)5632 * 1024 * 2, W_END = W_FO + (size_t)1024 * 2816 * 2;
static_assert(W_END <= 38 * MiB, "weights");
constexpr size_t WS_KVS = 42 * MiB;
constexpr size_t WS_DS = 50 * MiB;
constexpr int NGU = 1024 + 32;
constexpr size_t WS_ACT = 67 * MiB;
constexpr size_t WS_END = WS_ACT + (size_t)MROWS * APITCH * 2;
static_assert(WS_DS + (size_t)NGU * 16384 <= WS_ACT && WS_END <= 224 * MiB, "ws map");
constexpr size_t O_Y = 0, O_POOLP = 17039360, O_POOLS = 17054720, O_GLAP = 17177600, O_GLAS = 17243136, O_KP = 17767424, O_KS = 18291712, O_VP = 18553856, O_VS = 19078144, O_TOTAL = 19340288;
constexpr int RING_BYTES = 131072, LDS_BIAS = 131072, LDS_WSF = 131072 + 8448, LDS_MISC = 144 * 1024 - 256, LDS_BYTES = 147456;

struct Params {
    const float* in[20];
    float* out;
    unsigned char* ws;
    int ph_lo, ph_hi;
};

__device__ __forceinline__ unsigned f2bf(float f) { unsigned u = __builtin_bit_cast(unsigned, f); return (u + 0x7fffu + ((u >> 16) & 1u)) >> 16; }
__device__ __forceinline__ unsigned pk2(float lo, float hi) { typedef __bf16 b2 __attribute__((ext_vector_type(2))); f32x2 v = {lo, hi}; b2 b = __builtin_convertvector(v, b2); return __builtin_bit_cast(unsigned, b); }
__device__ __forceinline__ float bf2f(unsigned short h) { return __builtin_bit_cast(float, (unsigned)h << 16); }
__device__ __forceinline__ float bflo(unsigned w) { return __builtin_bit_cast(float, w << 16); }
__device__ __forceinline__ float bfhi(unsigned w) { return __builtin_bit_cast(float, w & 0xffff0000u); }
__device__ __forceinline__ int crow(int r, int hi) { return (r & 3) + 8 * (r >> 2) + 4 * hi; }
__device__ __forceinline__ float fast_sigmoid(float x) { return __builtin_amdgcn_rcpf(1.0f + __builtin_amdgcn_exp2f(-x * LOG2E)); }
#define VM_WAIT() asm volatile("s_waitcnt vmcnt(0)" ::: "memory")
#define LGKM_WAIT() asm volatile("s_waitcnt lgkmcnt(0)" ::: "memory")
#define SBAR() __builtin_amdgcn_sched_barrier(0)
__device__ __forceinline__ s16x4 vtr(const LAS unsigned char* p) { typedef short v4 __attribute__((ext_vector_type(4))); return __builtin_bit_cast(s16x4, __builtin_amdgcn_ds_read_tr16_b64_v4i16((LAS v4*)p)); }
__device__ __forceinline__ bf16x8 cat8(s16x4 a, s16x4 b) { return (bf16x8){a[0], a[1], a[2], a[3], b[0], b[1], b[2], b[3]}; }
__device__ __forceinline__ void dma16(const void* gsrc, LAS unsigned char* dst) { __builtin_amdgcn_global_load_lds((const unsigned*)gsrc, (LAS unsigned*)dst, 16, 0, 0); }
__device__ __forceinline__ float row_rstd_full(const float* ss, int row) {
    const f32x4* p = (const f32x4*)(ss + (size_t)row * 16); f32x4 a = p[0], b = p[1], c = p[2], d = p[3];
    const float s = ((a[0] + a[1]) + (a[2] + a[3])) + ((b[0] + b[1]) + (b[2] + b[3])) + ((c[0] + c[1]) + (c[2] + c[3])) + ((d[0] + d[1]) + (d[2] + d[3]));
    return __builtin_amdgcn_rsqf(s * (1.0f / DM) + EPS);
}

namespace pg8 {
constexpr int BM = 256, BK = 64, HALF = 128, HTB = HALF * BK * 2, STAGE_BYTES = 8 * HTB, NXCD = 8, WGM = 8;
__host__ __device__ __forceinline__ int lds_byte(int r, int c) { const int st = (r >> 4) * 2 + (c >> 5), rr = r & 15, cc = c & 31, ob = rr * 64 + cc * 2; return st * 1024 + (ob ^ (((ob >> 9) & 1) << 5)); }
__host__ __device__ __forceinline__ void stage_rc(int b, int& R, int& C) { const int st = b / 1024, sb = b % 1024, swz = sb ^ (((sb >> 9) & 1) << 5); R = (st >> 1) * 16 + swz / 64; C = (st & 1) * 32 + (swz % 64) / 2; }
__host__ __device__ __forceinline__ int perm32(int rho) { const int n = rho >> 4, i = rho & 15; return 8 * (i >> 2) + 4 * n + (i & 3); }

struct Unit { unsigned A, B; int nt, pm, pn, kind; };
template <int nM, int nN, bool EXTRA>
__device__ __forceinline__ bool tile_of(int L, int& pm, int& pn) {
    constexpr int nwg = nM * nN; static_assert(nM % 8 == 0, "nM");
    if (L >= nwg) { if (EXTRA && L < nwg + nN) { pm = nM; pn = L - nwg; return true; } return false; }
    int wgid = L; { constexpr int q = nwg / NXCD, r = nwg % NXCD; const int xcd = wgid % NXCD, off = wgid / NXCD; wgid = (xcd < r ? xcd * (q + 1) : r * (q + 1) + (xcd - r) * q) + off; }
    constexpr int nig = WGM * nN; const int gid = wgid / nig, rem = wgid - gid * nig;
    pm = gid * WGM + (rem & (WGM - 1)); pn = rem / WGM; return true;
}

template <class Epi, class Sched, bool ALIGN_EPI, int lda, int ldb>
__device__ __forceinline__ void gemm_phase(LAS unsigned char* lds, const char* wsb, const Sched& S, const Epi& E, const int tid) {
    const int wid = __builtin_amdgcn_readfirstlane(tid >> 6), lane = tid & 63, wr = wid >> 2, wc = wid & 3, fr = lane & 15, fq = lane >> 4;
    unsigned voffA[2], voffB[2];
#pragma unroll
    for (int i = 0; i < 2; ++i) { int R, C; stage_rc(tid * 16 + i * 8192, R, C); const int Rb = Epi::PERM ? ((R & ~31) + perm32(R & 31)) : R;
        voffA[i] = (unsigned)(R * lda + C) * 2u; voffB[i] = (unsigned)(Rb * ldb + C) * 2u; }
    const size_t kstep = (size_t)(BK * 2);
    const size_t hstepA = (size_t)HALF * lda * 2, hstepB = (size_t)HALF * ldb * 2;
    const unsigned ldsw = (unsigned)wid * 1024u;
    const int aoff = lds_byte(wr * 64 + fr, fq * 8), boff = lds_byte(wc * 32 + fr, fq * 8);
#define PG8_SA(b, h) (((b) * 2 + (h)) * HTB)
#define PG8_SB(b, h) ((4 + (b) * 2 + (h)) * HTB)
#define PG8_STAGE(bufoff, gbase, voff) do { _Pragma("unroll") for (int _i = 0; _i < 2; ++_i) \
        __builtin_amdgcn_global_load_lds((const unsigned*)((const char*)(gbase) + (voff)[_i]), (LAS unsigned*)(lds + (bufoff) + ldsw + _i * 8192), 16, 0, 0); } while (0)
#define PG8_LDA(dst, b, h) do { _Pragma("unroll") for (int m = 0; m < 4; ++m) _Pragma("unroll") for (int k = 0; k < 2; ++k) dst[m][k] = *(const LAS bf16x8*)(lds + PG8_SA(b, h) + aoff + m * 2048 + k * 1024); } while (0)
#define PG8_LDB(dst, b, h) do { _Pragma("unroll") for (int n = 0; n < 2; ++n) _Pragma("unroll") for (int k = 0; k < 2; ++k) dst[n][k] = *(const LAS bf16x8*)(lds + PG8_SB(b, h) + boff + n * 2048 + k * 1024); } while (0)
#define PG8_MMA(ai, bj, At, Bt) do { __builtin_amdgcn_s_setprio(1); _Pragma("unroll") for (int m = 0; m < 4; ++m) _Pragma("unroll") for (int n = 0; n < 2; ++n) _Pragma("unroll") for (int k = 0; k < 2; ++k) \
        acc[ai][bj][m][n] = __builtin_amdgcn_mfma_f32_16x16x32_bf16(Bt[n][k], At[m][k], acc[ai][bj][m][n], 0, 0, 0); __builtin_amdgcn_s_setprio(0); } while (0)
#define PG8_WAIT_V(n) asm volatile("s_waitcnt vmcnt(" #n ")" ::: "memory")
#define PG8_WAIT_L(n) asm volatile("s_waitcnt lgkmcnt(" #n ")" ::: "memory")
#define PG8_BAR __builtin_amdgcn_s_barrier()
#define PG8_SCHED __builtin_amdgcn_sched_barrier(0)
    Unit cur, nxt; int ui = 0;
    if (!S.next(0, cur)) return;
    f32x4 acc[2][2][4][2];
#pragma unroll
    for (int a = 0; a < 2; ++a)
#pragma unroll
        for (int b = 0; b < 2; ++b)
#pragma unroll
            for (int m = 0; m < 4; ++m)
#pragma unroll
                for (int n = 0; n < 2; ++n) acc[a][b][m][n] = (f32x4){0.f, 0.f, 0.f, 0.f};
    bf16x8 At[4][2], B0[2][2], B1[2][2];
    const char* cA = wsb + cur.A; const char* cB = wsb + cur.B;
    PG8_STAGE(PG8_SB(0, 0), cB, voffB); PG8_STAGE(PG8_SB(0, 1), cB + hstepB, voffB); PG8_STAGE(PG8_SA(0, 0), cA, voffA); PG8_STAGE(PG8_SA(0, 1), cA + hstepA, voffA);
    if (wr == 1) PG8_BAR;
    PG8_WAIT_V(2); PG8_BAR;
    PG8_STAGE(PG8_SB(1, 0), cB + kstep, voffB); PG8_STAGE(PG8_SA(1, 0), cA + kstep, voffA); PG8_STAGE(PG8_SB(1, 1), cB + hstepB + kstep, voffB);
    PG8_WAIT_V(6); PG8_BAR;
    for (;;) {
        const bool has_next = S.next(ui + 1, nxt);
        const char* nA = has_next ? wsb + nxt.A : cA; const char* nB = has_next ? wsb + nxt.B : cB;
        const int nt = cur.nt;
        for (int t = 0; t < nt; t += 2) {
            const bool last = (t == nt - 2);
            const char* a1 = cA + (size_t)(t + 1) * kstep;
            const char* a2 = last ? nA : cA + (size_t)(t + 2) * kstep; const char* b2 = last ? nB : cB + (size_t)(t + 2) * kstep;
            const char* a3 = a2 + kstep; const char* b3 = b2 + kstep;
            PG8_LDB(B0, 0, 0); PG8_LDB(B1, 0, 1); PG8_SCHED; PG8_LDA(At, 0, 0); PG8_STAGE(PG8_SA(1, 1), a1 + hstepA, voffA);
            PG8_WAIT_V(8); PG8_WAIT_L(0); PG8_BAR; PG8_MMA(0, 0, At, B0); PG8_MMA(0, 1, At, B1); PG8_BAR; PG8_SCHED;
            PG8_LDA(At, 0, 1); PG8_STAGE(PG8_SB(0, 0), b2, voffB); PG8_STAGE(PG8_SB(0, 1), b2 + hstepB, voffB); PG8_STAGE(PG8_SA(0, 0), a2, voffA);
            PG8_WAIT_V(8); PG8_WAIT_L(0); PG8_BAR; PG8_MMA(1, 0, At, B0); PG8_MMA(1, 1, At, B1); PG8_BAR; PG8_SCHED;
            PG8_LDB(B0, 1, 0); PG8_LDB(B1, 1, 1); PG8_SCHED; PG8_LDA(At, 1, 0); PG8_STAGE(PG8_SA(0, 1), a2 + hstepA, voffA);
            PG8_WAIT_V(8); PG8_WAIT_L(0); PG8_BAR; PG8_MMA(0, 0, At, B0); PG8_MMA(0, 1, At, B1); PG8_BAR; PG8_SCHED;
            PG8_LDA(At, 1, 1); PG8_STAGE(PG8_SB(1, 0), b3, voffB); PG8_STAGE(PG8_SB(1, 1), b3 + hstepB, voffB); PG8_STAGE(PG8_SA(1, 0), a3, voffA);
            PG8_WAIT_V(8); PG8_WAIT_L(0); PG8_BAR; PG8_MMA(1, 0, At, B0); PG8_MMA(1, 1, At, B1); PG8_BAR; PG8_SCHED;
        }
        if constexpr (ALIGN_EPI) { if (wr == 0) PG8_BAR; }
        E(acc, cur, wr, wc, fr, fq);
        if (!has_next) break;
#pragma unroll
        for (int a = 0; a < 2; ++a)
#pragma unroll
            for (int b = 0; b < 2; ++b)
#pragma unroll
                for (int m = 0; m < 4; ++m)
#pragma unroll
                    for (int n = 0; n < 2; ++n) acc[a][b][m][n] = (f32x4){0.f, 0.f, 0.f, 0.f};
        cur = nxt; cA = nA; cB = nB; ++ui;
        if constexpr (ALIGN_EPI) { if (wr == 1) PG8_BAR; }
    }
    PG8_WAIT_V(0);
    if constexpr (!ALIGN_EPI) { if (wr == 0) PG8_BAR; }
    PG8_BAR;
#undef PG8_SA
#undef PG8_SB
#undef PG8_STAGE
#undef PG8_LDA
#undef PG8_LDB
#undef PG8_MMA
#undef PG8_WAIT_V
#undef PG8_WAIT_L
#undef PG8_BAR
#undef PG8_SCHED
}
}

using pg8::Unit;
template <int nM, int nN, bool EXTRA, unsigned ABASE, unsigned WBASE, int NT, unsigned WROWB>
struct SchedDense {
    int G, c;
    __device__ __forceinline__ bool next(int i, Unit& u) const {
        int pm, pn; if (!pg8::tile_of<nM, nN, EXTRA>(i * G + c, pm, pn)) return false;
        u.pm = pm; u.pn = pn; u.kind = 0; u.nt = NT; u.A = ABASE + (unsigned)pm * (256u * APITCH * 2u); u.B = WBASE + (unsigned)pn * (256u * WROWB); return true; }
};
struct SchedMerge {
    int G, c;
    __device__ __forceinline__ bool next(int i, Unit& u) const {
        const int su = i / 6, sub = i - su * 6; int pm, pn; if (!pg8::tile_of<64, 4, false>(su * G + c, pm, pn)) return false;
        const int g = sub >> 1; u.pm = pm; u.pn = pn; u.kind = sub;
        const unsigned arow = (unsigned)WS_ACT + (unsigned)pm * (256u * APITCH * 2u), brow = (unsigned)(g * 1024 + pn * 256) * 2048u;
        if ((sub & 1) == 0) { u.nt = 16; u.A = arow + C_XB * 2; u.B = (unsigned)(WS_W + W_G) + brow; }
        else { const int yc = g == 0 ? C_YA : g == 1 ? C_YB : C_YC; u.nt = 8; u.A = arow + yc * 2; u.B = (unsigned)(WS_W + W_B) + brow; }
        return true; }
};

__device__ __forceinline__ float row_rstd_q(const float* ss, int row, int fq) {
    const f32x4 a = *(const f32x4*)(ss + (size_t)row * 16 + 4 * fq); float s = (a[0] + a[1]) + (a[2] + a[3]);
    s += __shfl_xor(s, 16); s += __shfl_xor(s, 32); return __builtin_amdgcn_rsqf(s * (1.0f / DM) + EPS);
}
struct EpiA {
    static constexpr bool PERM = true;
    bf16_t* act; const float* ss;
    __device__ __forceinline__ void operator()(const f32x4 (&acc)[2][2][4][2], const Unit& u, int wr, int wc, int fr, int fq) const {
        const int row0 = u.pm * 256 + wr * 64 + fr, col0 = u.pn * 256 + wc * 32 + 8 * fq;
#pragma unroll
        for (int ai = 0; ai < 2; ++ai)
#pragma unroll
            for (int m = 0; m < 4; ++m) { const int row = row0 + ai * 128 + m * 16; const float rs = row_rstd_q(ss, row, fq); bf16_t* rowp = act + (size_t)row * APITCH + col0;
#pragma unroll
                for (int bj = 0; bj < 2; ++bj) { const f32x4 v0 = acc[ai][bj][m][0] * rs, v1 = acc[ai][bj][m][1] * rs;
                    u32x4 w; w.x = pk2(v0[0], v0[1]); w.y = pk2(v0[2], v0[3]); w.z = pk2(v1[0], v1[1]); w.w = pk2(v1[2], v1[3]); *(u32x4*)(rowp + bj * 128) = w; } }
    }
};
struct EpiE {
    static constexpr bool PERM = true;
    bf16_t* act; const float* ss;
    __device__ __forceinline__ void operator()(const f32x4 (&acc)[2][2][4][2], const Unit& u, int wr, int wc, int fr, int fq) const {
        const int row0 = u.pm * 256 + wr * 64 + fr, col0 = C_HID + u.pn * 128 + wc * 32 + 8 * fq;
#pragma unroll
        for (int ai = 0; ai < 2; ++ai)
#pragma unroll
            for (int m = 0; m < 4; ++m) { const int row = row0 + ai * 128 + m * 16; const float rs = row_rstd_q(ss, row, fq);
                float h[8];
#pragma unroll
                for (int n = 0; n < 2; ++n)
#pragma unroll
                    for (int e = 0; e < 4; ++e) { const float a = acc[ai][0][m][n][e] * rs, g = acc[ai][1][m][n][e] * rs; h[n * 4 + e] = a * fast_sigmoid(a) * g; }
                u32x4 w; w.x = pk2(h[0], h[1]); w.y = pk2(h[2], h[3]); w.z = pk2(h[4], h[5]); w.w = pk2(h[6], h[7]); *(u32x4*)(act + (size_t)row * APITCH + col0) = w; }
    }
};
struct EpiRes {
    static constexpr bool PERM = false;
    const float* res; float* out; bf16_t* act; float* ss;
    __device__ __forceinline__ void operator()(const f32x4 (&acc)[2][2][4][2], const Unit& u, int wr, int wc, int fr, int fq) const {
        const int row0 = u.pm * 256 + wr * 64 + fr, col0 = u.pn * 256 + wc * 32 + 4 * fq;
#pragma unroll
        for (int ai = 0; ai < 2; ++ai)
#pragma unroll
            for (int m = 0; m < 4; ++m) { const int row = row0 + ai * 128 + m * 16; float q = 0.f;
#pragma unroll
                for (int bj = 0; bj < 2; ++bj)
#pragma unroll
                    for (int n = 0; n < 2; ++n) { const int c = col0 + bj * 128 + n * 16; const f32x4 x = *(const f32x4*)(res + (size_t)row * DM + c) + acc[ai][bj][m][n];
                        *(f32x4*)(out + (size_t)row * DM + c) = x; q += (x[0] * x[0] + x[1] * x[1]) + (x[2] * x[2] + x[3] * x[3]);
                        u32x2 w; w.x = pk2(x[0], x[1]); w.y = pk2(x[2], x[3]); *(u32x2*)(act + (size_t)row * APITCH + C_XB + c) = w; }
                q += __shfl_xor(q, 16); q += __shfl_xor(q, 32);
                if (fq == 0) ss[(size_t)row * 16 + 4 * u.pn + wc] = q; }
    }
};
struct EpiMerge {
    static constexpr bool PERM = true;
    bf16_t* act; const float* ss;
    __device__ __forceinline__ void operator()(const f32x4 (&acc)[2][2][4][2], const Unit& u, int wr, int wc, int fr, int fq) const {
        const int row0 = u.pm * 256 + wr * 64 + fr, cin = wc * 32 + 8 * fq, gcol = gscr_col(u.pn) + cin, mcol = C_M + u.pn * 256 + cin;
        if ((u.kind & 1) == 0) {
#pragma unroll
            for (int ai = 0; ai < 2; ++ai)
#pragma unroll
                for (int m = 0; m < 4; ++m) { const int row = row0 + ai * 128 + m * 16; const float rs = row_rstd_q(ss, row, fq); bf16_t* rowp = act + (size_t)row * APITCH + gcol;
#pragma unroll
                    for (int bj = 0; bj < 2; ++bj) { f32x4 v0 = acc[ai][bj][m][0] * rs, v1 = acc[ai][bj][m][1] * rs;
#pragma unroll
                        for (int e = 0; e < 4; ++e) { v0[e] = fast_sigmoid(v0[e]); v1[e] = fast_sigmoid(v1[e]); }
                        u32x4 w; w.x = pk2(v0[0], v0[1]); w.y = pk2(v0[2], v0[3]); w.z = pk2(v1[0], v1[1]); w.w = pk2(v1[2], v1[3]); *(u32x4*)(rowp + bj * 128) = w; } }
        } else {
            const bool first = (u.kind == 1);
#pragma unroll
            for (int ai = 0; ai < 2; ++ai)
#pragma unroll
                for (int m = 0; m < 4; ++m) { const int row = row0 + ai * 128 + m * 16; bf16_t* rowp = act + (size_t)row * APITCH;
#pragma unroll
                    for (int bj = 0; bj < 2; ++bj) { const u32x4 gw = *(const u32x4*)(rowp + gcol + bj * 128); u32x4 mo = (u32x4){0u, 0u, 0u, 0u}; if (!first) mo = *(const u32x4*)(rowp + mcol + bj * 128);
                        const f32x4 a0 = acc[ai][bj][m][0], a1 = acc[ai][bj][m][1]; float r[8];
                        r[0] = a0[0] * bflo(gw.x) + bflo(mo.x); r[1] = a0[1] * bfhi(gw.x) + bfhi(mo.x); r[2] = a0[2] * bflo(gw.y) + bflo(mo.y); r[3] = a0[3] * bfhi(gw.y) + bfhi(mo.y);
                        r[4] = a1[0] * bflo(gw.z) + bflo(mo.z); r[5] = a1[1] * bfhi(gw.z) + bfhi(mo.z); r[6] = a1[2] * bflo(gw.w) + bflo(mo.w); r[7] = a1[3] * bfhi(gw.w) + bfhi(mo.w);
                        u32x4 w; w.x = pk2(r[0], r[1]); w.y = pk2(r[2], r[3]); w.z = pk2(r[4], r[5]); w.w = pk2(r[6], r[7]); *(u32x4*)(rowp + mcol + bj * 128) = w; } }
        }
    }
};

template <int KSTEPS>
__device__ __forceinline__ void small_tile_partial(const bf16_t* A, int lda, const bf16_t* Bt, int ldb, int wave, int lane, f32x4 (&acc)[4]) {
    const int kk0 = wave * KSTEPS * 32 + 8 * (lane >> 4); const bf16_t* ap = A + (size_t)(lane & 15) * lda + kk0; const bf16_t* bp = Bt + (size_t)(lane & 15) * ldb + kk0;
#pragma unroll
    for (int j = 0; j < 4; ++j) acc[j] = (f32x4){0.f, 0.f, 0.f, 0.f};
#pragma unroll
    for (int s = 0; s < KSTEPS; ++s) { const bf16x8 a = *(const bf16x8*)(ap + 32 * s);
#pragma unroll
        for (int j = 0; j < 4; ++j) { const bf16x8 b = *(const bf16x8*)(bp + (size_t)(16 * j) * ldb + 32 * s); acc[j] = __builtin_amdgcn_mfma_f32_16x16x32_bf16(a, b, acc[j], 0, 0, 0); } }
}
__device__ __forceinline__ f32x2 small_tile_reduce(LAS float* red, const f32x4 (&acc)[4], int wave, int lane, int tid) {
#pragma unroll
    for (int j = 0; j < 4; ++j)
#pragma unroll
        for (int r = 0; r < 4; ++r) red[(wave * 16 + 4 * (lane >> 4) + r) * 68 + 16 * j + (lane & 15)] = acc[j][r];
    __syncthreads();
    const int row = tid >> 5, c2 = 2 * (tid & 31); f32x2 s = {0.f, 0.f};
#pragma unroll
    for (int w = 0; w < 8; ++w) { const f32x2 v = *(const LAS f32x2*)(red + (w * 16 + row) * 68 + c2); s += v; }
    __syncthreads();
    return s;
}

constexpr float ATT_THR = 8.0f;
template <bool SAMP>
__device__ __forceinline__ void attn_task(bf16_t* act, const bf16_t* kvs, int cb, int h, int qb0, LAS unsigned char* vbuf, LAS float* wsf, const LAS float* tab, int lane) {
    constexpr int NQB = 1;
    const int r32 = lane & 31, hi = lane >> 5;
    const int nt = SAMP ? 9 : ((cb < 8 ? cb : 8) + 1);
    const int qrow0 = SAMP ? SEQ + 32 * cb : 64 * cb + 32 * qb0;
    const int vp0 = ((lane >> 4) & 1) * 32 + (lane & 3) * 8 + (4 * hi + ((lane & 15) >> 2)) * 64;
    bf16x8 qr[NQB][4];
#pragma unroll
    for (int qb = 0; qb < NQB; ++qb)
#pragma unroll
        for (int j = 0; j < 4; ++j) qr[qb][j] = *(const bf16x8*)(act + (size_t)(qrow0 + 32 * qb + r32) * APITCH + C_QC + h * 64 + 16 * j + 8 * hi);
    float mhat[NQB], lsum[NQB]; f32x16 o[NQB][2];
#pragma unroll
    for (int qb = 0; qb < NQB; ++qb) { mhat[qb] = 0.f; lsum[qb] = 0.f;
#pragma unroll
        for (int r = 0; r < 16; ++r) { o[qb][0][r] = 0.f; o[qb][1][r] = 0.f; } }
    const float bconst = tab[256];
#define ATT_TILE(t, kp, vp, pitch) do { if (SAMP && (t) < 8) { const size_t off_ = ((size_t)(cb * 512 + 64 * (t)) * 512 + h * 64) * 2; kp = (const char*)kvs + off_; vp = (const char*)kvs + (size_t)8 * 512 * 512 * 2 + off_; pitch = 1024; } \
        else { const int row_ = SAMP ? SEQ + 32 * cb : 64 * (cb - (nt - 1) + (t)); kp = (const char*)(act + (size_t)row_ * APITCH + C_KC + h * 64); vp = (const char*)(act + (size_t)row_ * APITCH + C_VC + h * 64); pitch = (size_t)APITCH * 2; } } while (0)
#define ATT_VDMA(vp, pitch, buf) do { _Pragma("unroll") for (int p_ = 0; p_ < 8; ++p_) dma16((vp) + (size_t)(16 * (p_ & 3) + (lane >> 2)) * (pitch) + ((p_ >> 2) * 32 + (lane & 3) * 8) * 2, (buf) + p_ * 1024); } while (0)
#define ATT_KLOAD(kp, pitch) do { _Pragma("unroll") for (int j_ = 0; j_ < 4; ++j_) { kf[2 * j_] = *(const bf16x8*)((kp) + (size_t)r32 * (pitch) + (16 * j_ + 8 * hi) * 2); kf[2 * j_ + 1] = *(const bf16x8*)((kp) + (size_t)(32 + r32) * (pitch) + (16 * j_ + 8 * hi) * 2); } } while (0)
    bf16x8 kf[8];
    { const char* kp; const char* vp; size_t pitch; ATT_TILE(0, kp, vp, pitch); LGKM_WAIT(); ATT_VDMA(vp, pitch, vbuf); ATT_KLOAD(kp, pitch); }
    for (int t = 0; t < nt; ++t) {
        const int delta = nt - 1 - t; const bool half = SAMP && (t == 8);
        LAS unsigned char* vcur = vbuf + (t & 1) * 8192;
        VM_WAIT();
        const char* kpn = nullptr; const char* vpn = nullptr; size_t pitchn = 0;
        if (t + 1 < nt) { ATT_TILE(t + 1, kpn, vpn, pitchn); LGKM_WAIT(); ATT_VDMA(vpn, pitchn, vbuf + ((t + 1) & 1) * 8192); }
#pragma unroll
        for (int qb = 0; qb < NQB; ++qb) {
            f32x16 c0, c1;
            if (delta >= 3) { const float cbv = bconst - mhat[qb];
#pragma unroll
                for (int r = 0; r < 16; ++r) { c0[r] = cbv; c1[r] = cbv; } }
            else { const int base = 64 * delta + 32 * (qb0 + qb) + r32 + 128;
#pragma unroll
                for (int r = 0; r < 16; ++r) { const int i0 = base - crow(r, hi), i1 = i0 - 32; c0[r] = tab[i0 < 256 ? i0 : 256] - mhat[qb]; c1[r] = tab[i1 < 256 ? i1 : 256] - mhat[qb]; } }
#pragma unroll
            for (int j = 0; j < 4; ++j) { c0 = __builtin_amdgcn_mfma_f32_32x32x16_bf16(kf[2 * j], qr[qb][j], c0, 0, 0, 0); if (!half) c1 = __builtin_amdgcn_mfma_f32_32x32x16_bf16(kf[2 * j + 1], qr[qb][j], c1, 0, 0, 0); }
            if (qb == NQB - 1 && t + 1 < nt) { asm volatile("" ::: "memory"); ATT_KLOAD(kpn, pitchn); }
            float rm = c0[0];
#pragma unroll
            for (int r = 1; r < 16; ++r) rm = fmaxf(rm, c0[r]);
            if (!half) {
#pragma unroll
                for (int r = 0; r < 16; ++r) rm = fmaxf(rm, c1[r]); }
            rm = fmaxf(rm, __shfl_xor(rm, 32));
            if (t == 0) { mhat[qb] += rm;
#pragma unroll
                for (int r = 0; r < 16; ++r) { c0[r] -= rm; c1[r] -= rm; } }
            else if (__any(rm > ATT_THR)) { const float dl = fmaxf(rm, 0.f); mhat[qb] += dl;
#pragma unroll
                for (int r = 0; r < 16; ++r) { c0[r] -= dl; c1[r] -= dl; }
                const float f = __builtin_amdgcn_exp2f(-dl); lsum[qb] *= f; if (hi == 0) wsf[r32] = f;
#pragma unroll
                for (int r = 0; r < 16; ++r) { const float fr_ = wsf[crow(r, hi)]; o[qb][0][r] *= fr_; o[qb][1][r] *= fr_; } }
            float ps = 0.f;
#pragma unroll
            for (int r = 0; r < 16; ++r) { c0[r] = __builtin_amdgcn_exp2f(c0[r]); ps += c0[r]; }
            if (!half) {
#pragma unroll
                for (int r = 0; r < 16; ++r) { c1[r] = __builtin_amdgcn_exp2f(c1[r]); ps += c1[r]; } }
            lsum[qb] += ps;
            u32x4 pw[4];
            pw[0] = (u32x4){pk2(c0[0], c0[1]), pk2(c0[2], c0[3]), pk2(c0[4], c0[5]), pk2(c0[6], c0[7])};
            pw[1] = (u32x4){pk2(c0[8], c0[9]), pk2(c0[10], c0[11]), pk2(c0[12], c0[13]), pk2(c0[14], c0[15])};
            pw[2] = (u32x4){pk2(c1[0], c1[1]), pk2(c1[2], c1[3]), pk2(c1[4], c1[5]), pk2(c1[6], c1[7])};
            pw[3] = (u32x4){pk2(c1[8], c1[9]), pk2(c1[10], c1[11]), pk2(c1[12], c1[13]), pk2(c1[14], c1[15])};
#pragma unroll
            for (int d0 = 0; d0 < 2; ++d0)
#pragma unroll
                for (int ks = 0; ks < 4; ++ks) { if (half && ks >= 2) continue;
                    const bf16x8 vf = cat8(vtr(vcur + d0 * 4096 + ks * 1024 + vp0), vtr(vcur + d0 * 4096 + ks * 1024 + vp0 + 512));
                    o[qb][d0] = __builtin_amdgcn_mfma_f32_32x32x16_bf16(__builtin_bit_cast(bf16x8, pw[ks]), vf, o[qb][d0], 0, 0, 0); }
        }
    }
#undef ATT_TILE
#undef ATT_VDMA
#undef ATT_KLOAD
    LAS bf16_t* stg = (LAS bf16_t*)vbuf;
#pragma unroll
    for (int qb = 0; qb < NQB; ++qb) {
        float lt = lsum[qb]; lt += __shfl_xor(lt, 32);
        if (hi == 0) wsf[32 + r32] = lt;
#pragma unroll
        for (int r = 0; r < 16; ++r) { const float rl = __builtin_amdgcn_rcpf(wsf[32 + crow(r, hi)]); const int orow = crow(r, hi);
            stg[orow * 64 + r32] = (bf16_t)f2bf(o[qb][0][r] * rl); stg[orow * 64 + 32 + r32] = (bf16_t)f2bf(o[qb][1][r] * rl); }
#pragma unroll
        for (int i = 0; i < 4; ++i) { const int row = i * 8 + (lane >> 3), ch = lane & 7; const u32x4 v = *(const LAS u32x4*)(stg + row * 64 + ch * 8);
            *(u32x4*)(act + (size_t)(qrow0 + 32 * qb + row) * APITCH + C_YC + h * 64 + ch * 8) = v; }
        LGKM_WAIT();
    }
}

__device__ __forceinline__ float log_sigmoid_f(float x) { const float ax = fabsf(x); return fminf(x, 0.f) - 0.6931471805599453f * __builtin_amdgcn_logf(1.0f + __builtin_amdgcn_exp2f(-ax * LOG2E)); }
template <int L>
__device__ __forceinline__ void gla1_unit(bf16_t* act, const bf16_t* w2t, const float* bgate, float* an, bf16_t* ds, int u, int tok0, int h, int parity, LAS unsigned char* lds, int tid, int wave, int lane) {
    constexpr int NTB = L / 32, NKS = L / 16;
    const int r32 = lane & 31, hi = lane >> 5;
    LAS float* Ep = (LAS float*)lds; LAS float* Em = (LAS float*)(lds + 16384); LAS unsigned char* kimg = lds + 32768; LAS unsigned char* vimg = lds + 40960 + parity * 16384; LAS float* totl = (LAS float*)(lds + 73728);
    const int vp0 = ((lane >> 4) & 1) * 32 + (lane & 3) * 8 + (4 * hi + ((lane & 15) >> 2)) * 64;
    float b[16]; const int tb = wave >> 1, db = wave & 1;
    if (wave < 2 * NTB) {
        const bf16x8 A = *(const bf16x8*)(act + (size_t)(tok0 + 32 * tb + r32) * APITCH + C_Z + 8 * hi);
        const bf16x8 B = *(const bf16x8*)(w2t + (h * 64 + 32 * db + r32) * 16 + 8 * hi);
        const float bg = bgate[h * 64 + 32 * db + r32]; f32x16 X;
#pragma unroll
        for (int r = 0; r < 16; ++r) X[r] = bg;
        X = __builtin_amdgcn_mfma_f32_32x32x16_bf16(A, B, X, 0, 0, 0);
        float la[16], seg[4], oth[4];
#pragma unroll
        for (int r = 0; r < 16; ++r) la[r] = log_sigmoid_f(X[r]) * 0.0625f;
#pragma unroll
        for (int q = 0; q < 4; ++q) { seg[q] = (la[4 * q] + la[4 * q + 1]) + (la[4 * q + 2] + la[4 * q + 3]); oth[q] = __shfl_xor(seg[q], 32); }
        float run = 0.f;
#pragma unroll
        for (int q = 0; q < 4; ++q) { float st = run + (hi ? oth[q] : 0.f);
#pragma unroll
            for (int i = 0; i < 4; ++i) { st += la[4 * q + i]; b[4 * q + i] = st; }
            run += seg[q] + oth[q]; }
        if (NTB == 2 && tb == 0 && hi == 0) totl[db * 32 + r32] = run;
    } else if (wave >= 4) {
        const int eb = wave - 4;
#pragma unroll
        for (int ks = 0; ks < NKS; ++ks) dma16(act + (size_t)(tok0 + 16 * ks + (lane >> 2)) * APITCH + C_VB + h * 128 + 32 * eb + (lane & 3) * 8, vimg + (eb * 4 + ks) * 1024);
        VM_WAIT();
    }
    __syncthreads();
    if (wave < 2 * NTB) {
        if (NTB == 2 && tb == 1) { const float carry = totl[db * 32 + r32];
#pragma unroll
            for (int r = 0; r < 16; ++r) b[r] += carry; }
#pragma unroll
        for (int r = 0; r < 16; ++r) { const int tok = 32 * tb + crow(r, hi); const float bl = b[r] * LOG2E; Ep[tok * 64 + 32 * db + r32] = __builtin_amdgcn_exp2f(bl); Em[tok * 64 + 32 * db + r32] = __builtin_amdgcn_exp2f(-bl); }
        if (tb == NTB - 1 && hi == 1) an[(size_t)u * 64 + 32 * db + r32] = __builtin_amdgcn_exp2f(b[15] * LOG2E);
    }
    __syncthreads();
    if (tid < L * 8) {
        const int tok = tid >> 3, c8 = tid & 7; bf16_t* qp = act + (size_t)(tok0 + tok) * APITCH + C_QB + h * 64 + 8 * c8; bf16_t* kp = act + (size_t)(tok0 + tok) * APITCH + C_KB + h * 64 + 8 * c8;
        const u32x4 qv = *(const u32x4*)qp, kv = *(const u32x4*)kp;
        const f32x4 e0 = *(const LAS f32x4*)(Ep + tok * 64 + 8 * c8), e1 = *(const LAS f32x4*)(Ep + tok * 64 + 8 * c8 + 4), m0 = *(const LAS f32x4*)(Em + tok * 64 + 8 * c8), m1 = *(const LAS f32x4*)(Em + tok * 64 + 8 * c8 + 4);
        u32x4 qo, ko;
        qo.x = pk2(bflo(qv.x) * e0[0], bfhi(qv.x) * e0[1]); qo.y = pk2(bflo(qv.y) * e0[2], bfhi(qv.y) * e0[3]); qo.z = pk2(bflo(qv.z) * e1[0], bfhi(qv.z) * e1[1]); qo.w = pk2(bflo(qv.w) * e1[2], bfhi(qv.w) * e1[3]);
        ko.x = pk2(bflo(kv.x) * m0[0], bfhi(kv.x) * m0[1]); ko.y = pk2(bflo(kv.y) * m0[2], bfhi(kv.y) * m0[3]); ko.z = pk2(bflo(kv.z) * m1[0], bfhi(kv.z) * m1[1]); ko.w = pk2(bflo(kv.w) * m1[2], bfhi(kv.w) * m1[3]);
        *(u32x4*)qp = qo; *(u32x4*)kp = ko;
        *(LAS u32x4*)(kimg + ((c8 >> 2) * 4 + (tok >> 4)) * 1024 + (tok & 15) * 64 + (c8 & 3) * 16) = ko;
    }
    __syncthreads();
    {
        const int eb = wave & 3, db2 = wave >> 2; f32x16 acc;
#pragma unroll
        for (int r = 0; r < 16; ++r) acc[r] = 0.f;
#pragma unroll
        for (int ks = 0; ks < NKS; ++ks) { const bf16x8 va = cat8(vtr(vimg + (eb * 4 + ks) * 1024 + vp0), vtr(vimg + (eb * 4 + ks) * 1024 + vp0 + 512));
            const bf16x8 kb = cat8(vtr(kimg + (db2 * 4 + ks) * 1024 + vp0), vtr(kimg + (db2 * 4 + ks) * 1024 + vp0 + 512));
            acc = __builtin_amdgcn_mfma_f32_32x32x16_bf16(va, kb, acc, 0, 0, 0); }
        bf16_t* dp = ds + (size_t)u * 8192 + 32 * db2 + r32;
#pragma unroll
        for (int r = 0; r < 16; ++r) dp[(32 * eb + crow(r, hi)) * 64] = (bf16_t)f2bf(acc[r]);
    }
}
template <int L>
__device__ __forceinline__ void gla3_task(bf16_t* act, const bf16_t* ds, const float* gn, int u, int tok0, int h, int ib, LAS unsigned char* vimg, int lane) {
    constexpr int NKS = L / 16;
    const int r32 = lane & 31, hi = lane >> 5;
    const int vp0 = ((lane >> 4) & 1) * 32 + (lane & 3) * 8 + (4 * hi + ((lane & 15) >> 2)) * 64;
    LGKM_WAIT();
#pragma unroll
    for (int eb = 0; eb < 4; ++eb)
#pragma unroll
        for (int ks = 0; ks < NKS; ++ks) dma16(act + (size_t)(tok0 + 16 * ks + (lane >> 2)) * APITCH + C_VB + h * 128 + 32 * eb + (lane & 3) * 8, vimg + (eb * 4 + ks) * 1024);
    bf16x8 qf[4];
#pragma unroll
    for (int s = 0; s < 4; ++s) qf[s] = *(const bf16x8*)(act + (size_t)(tok0 + 32 * ib + r32) * APITCH + C_QB + h * 64 + 16 * s + 8 * hi);
    f32x16 acc[4];
#pragma unroll
    for (int eb = 0; eb < 4; ++eb)
#pragma unroll
        for (int r = 0; r < 16; ++r) acc[eb][r] = 0.f;
    const bf16_t* sg = ds + (size_t)u * 8192;
#pragma unroll
    for (int eb = 0; eb < 4; ++eb) { asm volatile("" ::: "memory");
#pragma unroll
        for (int s = 0; s < 4; ++s) { const bf16x8 sa = *(const bf16x8*)(sg + (32 * eb + r32) * 64 + 16 * s + 8 * hi); acc[eb] = __builtin_amdgcn_mfma_f32_32x32x16_bf16(sa, qf[s], acc[eb], 0, 0, 0); } }
    VM_WAIT();
    for (int jb = 0; jb <= ib; ++jb) {
        f32x16 X;
#pragma unroll
        for (int r = 0; r < 16; ++r) X[r] = 0.f;
        asm volatile("" ::: "memory");
#pragma unroll
        for (int s = 0; s < 4; ++s) { const bf16x8 kfr = *(const bf16x8*)(act + (size_t)(tok0 + 32 * jb + r32) * APITCH + C_KB + h * 64 + 16 * s + 8 * hi); X = __builtin_amdgcn_mfma_f32_32x32x16_bf16(kfr, qf[s], X, 0, 0, 0); }
        if (jb == ib) {
#pragma unroll
            for (int r = 0; r < 16; ++r) if (crow(r, hi) > r32) X[r] = 0.f; }
        const u32x4 x0 = (u32x4){pk2(X[0], X[1]), pk2(X[2], X[3]), pk2(X[4], X[5]), pk2(X[6], X[7])}, x1 = (u32x4){pk2(X[8], X[9]), pk2(X[10], X[11]), pk2(X[12], X[13]), pk2(X[14], X[15])};
#pragma unroll
        for (int eb = 0; eb < 4; ++eb)
#pragma unroll
            for (int s2 = 0; s2 < 2; ++s2) { asm volatile("" ::: "memory"); const int ks = 2 * jb + s2; const bf16x8 vf = cat8(vtr(vimg + (eb * 4 + ks) * 1024 + vp0), vtr(vimg + (eb * 4 + ks) * 1024 + vp0 + 512));
                acc[eb] = __builtin_amdgcn_mfma_f32_32x32x16_bf16(vf, __builtin_bit_cast(bf16x8, s2 ? x1 : x0), acc[eb], 0, 0, 0); }
    }
    float ssq = 0.f;
#pragma unroll
    for (int eb = 0; eb < 4; ++eb)
#pragma unroll
        for (int r = 0; r < 16; ++r) ssq += acc[eb][r] * acc[eb][r];
    ssq += __shfl_xor(ssq, 32);
    const float rs = __builtin_amdgcn_rsqf(ssq * (1.0f / 128.0f) + EPS);
    bf16_t* rowp = act + (size_t)(tok0 + 32 * ib + r32) * APITCH + C_RB + h * 128;
#pragma unroll
    for (int eb = 0; eb < 4; ++eb)
#pragma unroll
        for (int q = 0; q < 4; ++q) { asm volatile("" ::: "memory"); const int e0 = 32 * eb + 8 * q + 4 * hi; const f32x4 g = *(const f32x4*)(gn + e0); const u32x2 rv = *(const u32x2*)(rowp + e0);
            const float r0 = bflo(rv.x), r1 = bfhi(rv.x), r2 = bflo(rv.y), r3 = bfhi(rv.y);
            u32x2 w; w.x = pk2(acc[eb][4 * q] * rs * g[0] * r0 * fast_sigmoid(r0), acc[eb][4 * q + 1] * rs * g[1] * r1 * fast_sigmoid(r1));
            w.y = pk2(acc[eb][4 * q + 2] * rs * g[2] * r2 * fast_sigmoid(r2), acc[eb][4 * q + 3] * rs * g[3] * r3 * fast_sigmoid(r3)); *(u32x2*)(rowp + e0) = w; }
}

template <int GI>
__device__ __forceinline__ void pool_task(bf16_t* act, const float* hist  , const bf16_t* pmt, const float* pscale, int row0, int pos0, LAS unsigned char* ptile, int lane) {
    constexpr int W = 2 << GI;
    const int r32 = lane & 31, hi = lane >> 5;
    const int col = 128 * GI + 2 * lane;
    f32x2 uv[W - 1 + 32];
#pragma unroll
    for (int j = 0; j < W - 1 + 32; ++j) { const int t = j - (W - 1);
        if (t >= 0 || (hist == nullptr && row0 + t >= 0)) { const unsigned w = *(const unsigned*)(act + (size_t)(row0 + t) * APITCH + C_UA + col); uv[j] = (f32x2){bflo(w), bfhi(w)}; }
        else if (hist != nullptr) uv[j] = *(const f32x2*)(hist + (size_t)(15 + t) * 512 + col);
        else uv[j] = (f32x2){0.f, 0.f}; }
    f32x2 sum = {0.f, 0.f};
#pragma unroll
    for (int j = 0; j < W - 1; ++j) sum += uv[j];
    LGKM_WAIT();
#pragma unroll
    for (int t = 0; t < 32; ++t) { sum += uv[t + W - 1]; const int pos = pos0 + t; const float inv = 1.0f / (float)(pos + 1 < W ? pos + 1 : W);
        const f32x2 p = sum * inv - uv[t + W - 1]; *(LAS unsigned*)(ptile + (t * 136 + 2 * lane) * 2) = pk2(p[0], p[1]); sum -= uv[t]; }
    f32x16 acc[4];
#pragma unroll
    for (int db = 0; db < 4; ++db)
#pragma unroll
        for (int r = 0; r < 16; ++r) acc[db][r] = 0.f;
#pragma unroll
    for (int s = 0; s < 8; ++s) { asm volatile("" ::: "memory"); const bf16x8 pf = *(const LAS bf16x8*)(ptile + (r32 * 136 + 16 * s + 8 * hi) * 2);
#pragma unroll
        for (int db = 0; db < 4; ++db) { const bf16x8 mf = *(const bf16x8*)(pmt + (size_t)GI * 16384 + (32 * db + r32) * 128 + 16 * s + 8 * hi); acc[db] = __builtin_amdgcn_mfma_f32_32x32x16_bf16(mf, pf, acc[db], 0, 0, 0); } }
    bf16_t* rowp = act + (size_t)(row0 + r32) * APITCH + C_YA + 128 * GI;
#pragma unroll
    for (int db = 0; db < 4; ++db)
#pragma unroll
        for (int q = 0; q < 4; ++q) { asm volatile("" ::: "memory"); const int d0 = 32 * db + 8 * q + 4 * hi; const f32x4 sc = *(const f32x4*)(pscale + 128 * GI + d0);
            u32x2 w; w.x = pk2(acc[db][4 * q] * sc[0], acc[db][4 * q + 1] * sc[1]); w.y = pk2(acc[db][4 * q + 2] * sc[2], acc[db][4 * q + 3] * sc[3]); *(u32x2*)(rowp + d0) = w; }
}

#define XB_TMO      128
#define XB_XCNT(j)  (256  + 64 * (j))
#define XB_XSUB(j)  (1280 + 64 * (j))
#define XB_XGEN(j)  (2304 + 64 * (j))
#define XB_TOP      3328
#define XB_TOPGEN   3392
#define XCD_BAR_WORDS 3456
#define XB_SPIN_CAP (1u << 22)
__device__ __forceinline__ unsigned xb_ld(unsigned* p)              { return __hip_atomic_load(p, __ATOMIC_RELAXED, __HIP_MEMORY_SCOPE_AGENT); }
__device__ __forceinline__ unsigned xb_add(unsigned* p, unsigned v) { return __hip_atomic_fetch_add(p, v, __ATOMIC_RELAXED, __HIP_MEMORY_SCOPE_AGENT); }
__device__ __forceinline__ unsigned xb_xcc_id() { return (unsigned)__builtin_amdgcn_s_getreg((3 << 11) | 20) & 0xFu; }
#define XB_SPIN(cond, bar) do { unsigned _sp = 0; while (cond) { __builtin_amdgcn_s_sleep(1); \
    if ((++_sp & 255u) == 0u) { if (xb_ld(&(bar)[XB_TMO])) break; if (_sp > XB_SPIN_CAP) { atomicAdd(&(bar)[XB_TMO], 1u); break; } } } } while (0)
struct XcdBarrier { unsigned* bar; unsigned x; volatile LAS unsigned* st; };
__device__ __forceinline__ XcdBarrier xcd_barrier_post(unsigned* bar, volatile LAS unsigned* st) {
    XcdBarrier b; b.bar = bar; b.x = xb_xcc_id(); b.st = st;
    if (threadIdx.x == 0) (void)xb_add(&bar[XB_XCNT(b.x)], 1u);
    return b;
}
__device__ __forceinline__ void xcd_barrier_complete(unsigned* bar, unsigned x, unsigned& nloc, unsigned& nx) {
    const unsigned G = gridDim.x * gridDim.y * gridDim.z;
    unsigned sum, cnt, mine, sp = 0u;
    for (;;) {
        sum = 0u; cnt = 0u; mine = 0u;
#pragma unroll
        for (unsigned j = 0; j < 16; ++j) { const unsigned c = xb_ld(&bar[XB_XCNT(j)]); sum += c; cnt += (c > 0u) ? 1u : 0u; mine = (j == x) ? c : mine; }
        if (sum == G) break;
        __builtin_amdgcn_s_sleep(1);
        if ((++sp & 255u) == 0u) { if (xb_ld(&bar[XB_TMO])) break; if (sp > XB_SPIN_CAP) { atomicAdd(&bar[XB_TMO], 1u); break; } }
    }
    nloc = mine > 0u ? mine : 1u; nx = cnt > 0u ? cnt : 1u;
}
__device__ __forceinline__ void xcd_barrier(const XcdBarrier& b) {
    asm volatile("s_waitcnt vmcnt(0)" ::: "memory");
    __syncthreads();
    if (threadIdx.x == 0) {
        unsigned* bar = b.bar;
        __builtin_amdgcn_s_waitcnt(0);
        unsigned nloc = b.st[0], nx = b.st[1];
        if (nloc == 0u) { xcd_barrier_complete(bar, b.x, nloc, nx); b.st[0] = nloc; b.st[1] = nx; }
        const unsigned old = xb_add(&bar[XB_XSUB(b.x)], 1u);
        const unsigned gen = old / nloc;
        if (old + 1u == (gen + 1u) * nloc) {
            __builtin_amdgcn_fence(__ATOMIC_RELEASE, "agent");
            asm volatile("s_waitcnt vmcnt(0)" ::: "memory");
            const unsigned og = xb_add(&bar[XB_TOP], 1u);
            const unsigned tg = og / nx;
            if (og + 1u == (tg + 1u) * nx) xb_add(&bar[XB_TOPGEN], 1u);
            else XB_SPIN(xb_ld(&bar[XB_TOPGEN]) == tg, bar);
            __builtin_amdgcn_fence(__ATOMIC_ACQUIRE, "agent");
            xb_add(&bar[XB_XGEN(b.x)], 1u);
            asm volatile("s_waitcnt vmcnt(0)" ::: "memory");
        } else {
            XB_SPIN(xb_ld(&bar[XB_XGEN(b.x)]) == gen, bar);
            __builtin_amdgcn_fence(__ATOMIC_ACQUIRE, "agent");
            asm volatile("s_waitcnt vmcnt(0)" ::: "memory");
        }
    }
    __syncthreads();
}

__device__ __forceinline__ float wave_sum(float v) {
#pragma unroll
    for (int o = 1; o < 64; o <<= 1) v += __shfl_xor(v, o);
    return v;
}
__device__ __forceinline__ int src_col(int sel, int n) {
    if (sel == 1) return n < 2064 ? n : (n < 2304 ? -1 : n - 240);
    if (sel == 2) { const int pn = n >> 8, jj = n & 255; return jj < 128 ? 128 * pn + jj : 2816 + 128 * pn + (jj - 128); }
    return n;
}
__device__ __forceinline__ void tr_item(const float* W, int ldw, int sel, int coff, const float* gain, bf16_t* WT, int dpitch, int kb, int nb, LAS float* scr, int lane) {
    const int k0 = 64 * kb, n0 = 32 * nb; const int sc = src_col(sel, n0 + (lane & 31));
#pragma unroll 8
    for (int i = 0; i < 32; ++i) { const int kk = 2 * i + (lane >> 5); float v = 0.f; if (sc >= 0) v = W[(size_t)(k0 + kk) * ldw + coff + sc]; if (gain) v *= gain[k0 + kk]; scr[kk * 33 + (lane & 31)] = v; }
    LGKM_WAIT(); asm volatile("" ::: "memory");
    const int c = lane & 7;
#pragma unroll
    for (int j = 0; j < 4; ++j) { const int n = (lane >> 3) + 8 * j; const LAS float* s = scr + (8 * c) * 33 + n; const int dn = n0 + n;
        float rsc = 1.f; if (sel == 1) rsc = (dn >= 512 && dn < 768) ? 0.125f : ((dn >= 2304 && dn < 2816) ? 0.125f * LOG2E : 1.f);
        u32x4 o; o.x = pk2(s[0 * 33] * rsc, s[1 * 33] * rsc); o.y = pk2(s[2 * 33] * rsc, s[3 * 33] * rsc); o.z = pk2(s[4 * 33] * rsc, s[5 * 33] * rsc); o.w = pk2(s[6 * 33] * rsc, s[7 * 33] * rsc);
        *(u32x4*)(WT + (size_t)dn * dpitch + k0 + 8 * c) = o; }
    LGKM_WAIT(); asm volatile("" ::: "memory");
}
__device__ __forceinline__ void phase_wconv(const Params& p, int l, LAS unsigned char* lds, int tid, int wave, int lane, int vcu, int G) {
    LAS float* scr = (LAS float*)(lds + wave * 16384);
    unsigned char* ws = p.ws; bf16_t* wbase = (bf16_t*)(ws + WS_W);
    const int gw = vcu * 8 + wave, NGW = G * 8;
    const float* w_in = p.in[7] + (size_t)l * DM * DIN; const float* ang = p.in[6] + l * DM; const float* fng = p.in[16] + l * DM;
    constexpr int I0 = 120 * 16, I1 = 96 * 16, I2 = 3 * 32 * 8, I3 = 32 * 16, I4 = 176 * 16, I5 = 32 * 44, I6 = 4 * 4 * 2, NIT = I0 + I1 + I2 + I3 + I4 + I5 + I6;
    for (int it = gw; it < NIT; it += NGW) {
        int r = it;
        if (r < I0) { tr_item(w_in, DIN, 1, 0, ang, wbase + W_IN / 2, 1024, r % 16, r / 16, scr, lane); continue; } r -= I0;
        if (r < I1) { tr_item(w_in, DIN, 0, 3600, ang, wbase + W_G / 2, 1024, r % 16, r / 16, scr, lane); continue; } r -= I1;
        if (r < I2) { const int g = r / 256, rr = r % 256; tr_item(p.in[14] + (size_t)(l * 3 + g) * 512 * 1024, 1024, 0, 0, nullptr, wbase + W_B / 2 + (size_t)g * 1024 * 1024, 1024, rr % 8, rr / 8, scr, lane); continue; } r -= I2;
        if (r < I3) { tr_item(p.in[15] + (size_t)l * 1024 * 1024, 1024, 0, 0, nullptr, wbase + W_O / 2, 1024, r % 16, r / 16, scr, lane); continue; } r -= I3;
        if (r < I4) { tr_item(p.in[17] + (size_t)l * 1024 * 5632, 5632, 2, 0, fng, wbase + W_FI / 2, 1024, r % 16, r / 16, scr, lane); continue; } r -= I4;
        if (r < I5) { tr_item(p.in[18] + (size_t)l * 2816 * 1024, 1024, 0, 0, nullptr, wbase + W_FO / 2, 2816, r % 44, r / 44, scr, lane); continue; } r -= I5;
        { const int g = r / 8, rr = r % 8; tr_item(p.in[11] + (size_t)(l * 4 + g) * 128 * 128, 128, 0, 0, nullptr, (bf16_t*)(ws + WS_PMT) + (size_t)g * 16384, 128, rr % 2, rr / 2, scr, lane); }
    }
    const int gt = vcu * 512 + tid, NGT = G * 512;
    for (int i = gt; i < 4096; i += NGT) { const int col = i >> 4, k = i & 15; ((bf16_t*)(ws + WS_W2T))[i] = (bf16_t)f2bf(p.in[8][(size_t)l * 16 * 256 + k * 256 + col]); }
    for (int i = gt; i < 8 * 260; i += NGT) { const int h = i / 260, j = i % 260; ((float*)(ws + WS_BIAS))[i] = j < 257 ? p.in[13][(size_t)(l * 8 + h) * 257 + j] * LOG2E : 0.f; }
    { const float* ck = p.in[4] + (size_t)l * 2097152; const float* cv = p.in[5] + (size_t)l * 2097152; bf16_t* kd = (bf16_t*)(ws + WS_KVS);
        for (int i = gt; i < 2 * 262144; i += NGT) { const int which = i >= 262144, j = which ? i - 262144 : i; const float* s = (which ? cv : ck) + (size_t)j * 8; const f32x4 a = *(const f32x4*)s, b = *(const f32x4*)(s + 4);
            u32x4 o; o.x = pk2(a[0], a[1]); o.y = pk2(a[2], a[3]); o.z = pk2(b[0], b[1]); o.w = pk2(b[2], b[3]); *(u32x4*)(kd + (size_t)which * 2097152 + (size_t)j * 8) = o; } }
    if (l == 0) {
        bf16_t* act = (bf16_t*)(ws + WS_ACT); float* ss = (float*)(ws + WS_SS);
        for (int m = gw; m < MROWS; m += NGW) { const float* xr = m < SEQ ? p.in[0] + (size_t)m * DM : p.in[1] + (size_t)(m - SEQ) * DM; float q = 0.f;
#pragma unroll
            for (int j = 0; j < 4; ++j) { const f32x4 v = *(const f32x4*)(xr + 256 * j + 4 * lane); q += (v[0] * v[0] + v[1] * v[1]) + (v[2] * v[2] + v[3] * v[3]);
                u32x2 w; w.x = pk2(v[0], v[1]); w.y = pk2(v[2], v[3]); *(u32x2*)(act + (size_t)m * APITCH + C_XB + 256 * j + 4 * lane) = w; }
            q = wave_sum(q); if (lane < 16) ss[(size_t)m * 16 + lane] = lane == 0 ? q : 0.f; }
    }
}

__device__ __forceinline__ void phase_scan(const Params& p, int l, int tid, int wave, int lane, int vcu, int G) {
    unsigned char* ws = p.ws; bf16_t* ds = (bf16_t*)(ws + WS_DS); const float* an = (const float*)(ws + WS_AN);
    if (wave < 2) {
        for (int wv = vcu * 2 + wave; wv < 512; wv += G * 2) {
            const int el = wv * 64 + lane, h = el >> 13, idx = el & 8191, d = idx & 63, e = idx >> 6; float S = 0.f;
            for (int n0 = 0; n0 < 256; n0 += 8) { float dv[8], av[8];
#pragma unroll
                for (int j = 0; j < 8; ++j) { const int u = (n0 + j) * 4 + h; dv[j] = bf2f(ds[(size_t)u * 8192 + idx]); av[j] = an[(size_t)u * 64 + d]; }
#pragma unroll
                for (int j = 0; j < 8; ++j) { const int u = (n0 + j) * 4 + h; ds[(size_t)u * 8192 + idx] = (bf16_t)f2bf(S); S = av[j] * (S + dv[j]); } }
            p.out[O_GLAP + (size_t)l * 32768 + (size_t)h * 8192 + d * 128 + e] = S;
        }
    } else {
        for (int wv = vcu * 6 + (wave - 2); wv < 32 * 128; wv += G * 6) {
            const int el = wv * 64 + lane, ub = el >> 13, idx = el & 8191, d = idx & 63, e = idx >> 6, u = 1024 + ub;
            const float s0 = p.in[3][(size_t)l * 262144 + (size_t)ub * 8192 + d * 128 + e]; const float dv = bf2f(ds[(size_t)u * 8192 + idx]);
            ds[(size_t)u * 8192 + idx] = (bf16_t)f2bf(s0);
            p.out[O_GLAS + (size_t)l * 262144 + (size_t)ub * 8192 + d * 128 + e] = an[(size_t)u * 64 + d] * (s0 + dv);
        }
    }
}

__device__ __forceinline__ void copy8(const bf16_t* s, float* d) { const u32x4 v = *(const u32x4*)s; *(f32x4*)d = (f32x4){bflo(v.x), bfhi(v.x), bflo(v.y), bfhi(v.y)}; *(f32x4*)(d + 4) = (f32x4){bflo(v.z), bfhi(v.z), bflo(v.w), bfhi(v.w)}; }
__device__ __forceinline__ void phase_copies(const Params& p, int l, int tid, int vcu, int G) {
    const bf16_t* act = (const bf16_t*)(p.ws + WS_ACT); float* out = p.out;
    const int gt = vcu * 512 + tid, NGT = G * 512;
    constexpr int NKP = 512 * 64, NKS_ = 256 * 64, NPP = 15 * 64, NPS = 8 * 15 * 64, NTOT = 2 * NKP + 2 * NKS_ + NPP + NPS;
    for (int i = gt; i < NTOT; i += NGT) {
        int r = i;
        if (r < 2 * NKP) { const int v = r >= NKP; if (v) r -= NKP; const int row = r >> 6, c8 = r & 63; copy8(act + (size_t)(SEQ - 512 + row) * APITCH + (v ? C_VC : C_KC) + 8 * c8, out + (v ? O_VP : O_KP) + (size_t)l * 262144 + (size_t)row * 512 + 8 * c8); continue; } r -= 2 * NKP;
        if (r < 2 * NKS_) { const int v = r >= NKS_; if (v) r -= NKS_; const int row = r >> 6, c8 = r & 63; copy8(act + (size_t)(SEQ + row) * APITCH + (v ? C_VC : C_KC) + 8 * c8, out + (v ? O_VS : O_KS) + (size_t)l * 131072 + (size_t)row * 512 + 8 * c8); continue; } r -= 2 * NKS_;
        if (r < NPP) { const int row = r >> 6, c8 = r & 63; copy8(act + (size_t)(SEQ - 15 + row) * APITCH + C_UA + 8 * c8, out + O_POOLP + (size_t)l * 7680 + (size_t)row * 512 + 8 * c8); continue; } r -= NPP;
        { const int b = r / (15 * 64), rr = r % (15 * 64), row = rr >> 6, c8 = rr & 63; copy8(act + (size_t)(SEQ + 32 * b + 17 + row) * APITCH + C_UA + 8 * c8, out + O_POOLS + (size_t)l * 61440 + (size_t)(b * 15 + row) * 512 + 8 * c8); }
    }
}

constexpr int CW_BAR = 4096;
constexpr int NPHASE = 19;

__global__ void __launch_bounds__(512, 2) mk_fwd(Params p) {
    extern __shared__ __attribute__((aligned(16))) unsigned char lds_raw[];
    LAS unsigned char* lds = (LAS unsigned char*)lds_raw;
    const int tid0 = threadIdx.x;
    const int G = gridDim.x; const int bx = blockIdx.x; const int vcu = (G % 8 == 0) ? (bx % 8) * (G / 8) + bx / 8 : bx;
    volatile LAS unsigned* MISC = (volatile LAS unsigned*)(lds + LDS_MISC);
    if (tid0 < 64) MISC[tid0] = 0u;
    __syncthreads();
    unsigned char* ws = p.ws;
    unsigned* ctl = (unsigned*)(ws + WS_CTL);
    bf16_t* act = (bf16_t*)(ws + WS_ACT); float* ss = (float*)(ws + WS_SS); bf16_t* wbase = (bf16_t*)(ws + WS_W);
    XcdBarrier bar; bar.bar = ctl + CW_BAR; bar.x = 0; bar.st = nullptr;
    if (p.ph_hi - p.ph_lo > 1) bar = xcd_barrier_post(ctl + CW_BAR, MISC + 8);

    for (int ph = p.ph_lo; ph < p.ph_hi; ++ph) {
        int tid = tid0; asm volatile("" : "+v"(tid));
        const int lane = tid & 63, wave = __builtin_amdgcn_readfirstlane(tid >> 6);
        const int l = ph == 0 ? 0 : (ph - 1) / 9, sub = ph == 0 ? -1 : (ph - 1) % 9;
        if (ph == 0) { if (PHON(9)) phase_wconv(p, 0, lds, tid, wave, lane, vcu, G); }
        else if (sub == 0 && PHON(0)) {
            typedef SchedDense<64, 15, true, (unsigned)(WS_ACT + C_XB * 2), (unsigned)(WS_W + W_IN), 16, 2048u> SA;
            SA S{G, bx}; EpiA E{act, ss};
            pg8::gemm_phase<EpiA, SA, true, APITCH, 1024>(lds, (const char*)ws, S, E, tid);
        } else if (sub == 1 && PHON(1)) {
            const float* bsrc = (const float*)(ws + WS_BIAS); LAS float* tab = (LAS float*)(lds + LDS_BIAS);
            for (int i = tid; i < 8 * 260; i += 512) tab[i] = bsrc[i];
            __syncthreads();
            LAS unsigned char* vbuf = lds + wave * 16384; LAS float* wsf = (LAS float*)(lds + LDS_WSF) + wave * 128;
            const bf16_t* kvs = (const bf16_t*)(ws + WS_KVS);
            for (int c = vcu; c < 256; c += G) { int ln = lane; asm volatile("" : "+v"(ln)); attn_task<false>(act, kvs, c, wave, 0, vbuf, wsf, tab + wave * 260, ln); asm volatile("" : "+v"(ln)); attn_task<false>(act, kvs, c, wave, 1, vbuf, wsf, tab + wave * 260, ln); }
            for (int b = 0; b < 8; ++b) if ((G - 1 - b) % G == vcu) { int ln = lane; asm volatile("" : "+v"(ln)); attn_task<true>(act, kvs, b, wave, 0, vbuf, wsf, tab + wave * 260, ln); }
            VM_WAIT(); LGKM_WAIT();
            __syncthreads();
            const bf16_t* w2t = (const bf16_t*)(ws + WS_W2T); const float* bgate = p.in[9] + l * 256; float* an = (float*)(ws + WS_AN); bf16_t* ds = (bf16_t*)(ws + WS_DS);
            int cnt = 0;
            for (int u = vcu; u < 1024; u += G) { gla1_unit<64>(act, w2t, bgate, an, ds, u, (u >> 2) * 64, u & 3, cnt & 1, lds, tid, wave, lane); ++cnt; }
            for (int su = vcu; su < 32; su += G) { gla1_unit<32>(act, w2t, bgate, an, ds, 1024 + su, SEQ + 32 * (su >> 2), su & 3, cnt & 1, lds, tid, wave, lane); ++cnt; }
            phase_copies(p, l, tid, vcu, G);
        } else if (sub == 2 && PHON(2)) phase_scan(p, l, tid, wave, lane, vcu, G);
        else if (sub == 3 && PHON(3)) {
            const int gw = vcu * 8 + wave, NGW = G * 8; LAS unsigned char* wl = lds + wave * 16384;
            const bf16_t* ds = (const bf16_t*)(ws + WS_DS); const float* gn = p.in[10] + l * 128;
            for (int t = gw; t < 2048; t += NGW) { int ln = lane; asm volatile("" : "+v"(ln)); const int u = t >> 1; gla3_task<64>(act, ds, gn, u, (u >> 2) * 64, u & 3, t & 1, wl, ln); }
            for (int t = gw; t < 32; t += NGW) { int ln = lane; asm volatile("" : "+v"(ln)); gla3_task<32>(act, ds, gn, 1024 + t, SEQ + 32 * (t >> 2), t & 3, 0, wl, ln); }
            const bf16_t* pmt = (const bf16_t*)(ws + WS_PMT); const float* psc = p.in[12] + l * 512;
            for (int t = NGW - 1 - gw; t < 520 * 4; t += NGW) { int ln = lane; asm volatile("" : "+v"(ln)); const int tt = t >> 2, g = t & 3; const bool sm = tt >= 512;
                const int row0 = sm ? SEQ + 32 * (tt - 512) : 32 * tt, pos0 = sm ? 2048 : 32 * tt; const float* hist = sm ? p.in[2] + (size_t)((l * 8 + (tt - 512)) * 15) * 512 : nullptr;
                if (g == 0) pool_task<0>(act, hist, pmt, psc, row0, pos0, wl, ln); else if (g == 1) pool_task<1>(act, hist, pmt, psc, row0, pos0, wl, ln);
                else if (g == 2) pool_task<2>(act, hist, pmt, psc, row0, pos0, wl, ln); else pool_task<3>(act, hist, pmt, psc, row0, pos0, wl, ln); }
        } else if (sub == 4 && PHON(4)) {
            SchedMerge S{G, bx}; EpiMerge E{act, ss};
            pg8::gemm_phase<EpiMerge, SchedMerge, true, APITCH, 1024>(lds, (const char*)ws, S, E, tid);
            LAS float* red = (LAS float*)lds;
            for (int T = vcu; T < 256; T += G) { const int rb = T >> 4, cb = T & 15, row0 = SEQ + 16 * rb, col0 = 64 * cb, row = row0 + (tid >> 5), col = col0 + 2 * (tid & 31);
                const float rs = row_rstd_full(ss, row); f32x2 m2 = {0.f, 0.f};
#pragma unroll
                for (int g = 0; g < 3; ++g) { f32x4 acc[4]; const int yc = g == 0 ? C_YA : g == 1 ? C_YB : C_YC;
                    small_tile_partial<4>(act + (size_t)row0 * APITCH + C_XB, APITCH, wbase + W_G / 2 + (size_t)(g * 1024 + col0) * 1024, 1024, wave, lane, acc);
                    const f32x2 gv = small_tile_reduce(red, acc, wave, lane, tid);
                    small_tile_partial<2>(act + (size_t)row0 * APITCH + yc, APITCH, wbase + W_B / 2 + (size_t)(g * 1024 + col0) * 1024, 1024, wave, lane, acc);
                    const f32x2 bv = small_tile_reduce(red, acc, wave, lane, tid);
                    m2[0] += fast_sigmoid(gv[0] * rs) * bv[0]; m2[1] += fast_sigmoid(gv[1] * rs) * bv[1]; }
                *(unsigned*)(act + (size_t)row * APITCH + C_M + col) = pk2(m2[0], m2[1]); }
        } else if ((sub == 5 || sub == 7) && PHON(5)) {
            const bool fo = sub == 7;
            const float* resp = (l == 0 && !fo) ? p.in[0] : p.out;
            EpiRes E{resp, p.out, act, ss};
            if (!fo) { typedef SchedDense<64, 4, false, (unsigned)(WS_ACT + C_M * 2), (unsigned)(WS_W + W_O), 16, 2048u> SD; SD S{G, bx}; pg8::gemm_phase<EpiRes, SD, true, APITCH, 1024>(lds, (const char*)ws, S, E, tid); }
            else { typedef SchedDense<64, 4, false, (unsigned)(WS_ACT + C_HID * 2), (unsigned)(WS_W + W_FO), 44, 5632u> SF; SF S{G, bx}; pg8::gemm_phase<EpiRes, SF, true, APITCH, 2816>(lds, (const char*)ws, S, E, tid); }
            LAS float* red = (LAS float*)lds;
            for (int T = vcu; T < 256; T += G) { const int rb = T >> 4, cb = T & 15, row0 = SEQ + 16 * rb, col0 = 64 * cb, row = row0 + (tid >> 5), col = col0 + 2 * (tid & 31);
                f32x4 acc[4];
                if (!fo) small_tile_partial<4>(act + (size_t)row0 * APITCH + C_M, APITCH, wbase + W_O / 2 + (size_t)col0 * 1024, 1024, wave, lane, acc);
                else small_tile_partial<11>(act + (size_t)row0 * APITCH + C_HID, APITCH, wbase + W_FO / 2 + (size_t)col0 * 2816, 2816, wave, lane, acc);
                const f32x2 v = small_tile_reduce(red, acc, wave, lane, tid);
                const float* rp = (l == 0 && !fo) ? p.in[1] + (size_t)(row - SEQ) * DM + col : p.out + (size_t)row * DM + col;
                const f32x2 x = *(const f32x2*)rp + v; *(f32x2*)(p.out + (size_t)row * DM + col) = x;
                *(unsigned*)(act + (size_t)row * APITCH + C_XB + col) = pk2(x[0], x[1]);
                float q = x[0] * x[0] + x[1] * x[1];
#pragma unroll
                for (int o = 1; o < 32; o <<= 1) q += __shfl_xor(q, o);
                if ((tid & 31) == 0) ss[(size_t)row * 16 + cb] = q; }
        } else if (sub == 6 && PHON(6)) {
            typedef SchedDense<64, 22, true, (unsigned)(WS_ACT + C_XB * 2), (unsigned)(WS_W + W_FI), 16, 2048u> SE;
            SE S{G, bx}; EpiE E{act, ss};
            pg8::gemm_phase<EpiE, SE, true, APITCH, 1024>(lds, (const char*)ws, S, E, tid);
        } else if (sub == 8 && l == 0) { if (PHON(9)) phase_wconv(p, 1, lds, tid, wave, lane, vcu, G); }
        else if (sub == 8 && PHON(8)) {
            const float* fg = p.in[19]; const int gw = vcu * 8 + wave, NGW = G * 8;
            for (int m = gw; m < MROWS; m += NGW) { const float rs = row_rstd_full(ss, m); float* xr = p.out + (size_t)m * DM;
#pragma unroll
                for (int j = 0; j < 4; ++j) { const f32x4 v = *(const f32x4*)(xr + 256 * j + 4 * lane), g = *(const f32x4*)(fg + 256 * j + 4 * lane); *(f32x4*)(xr + 256 * j + 4 * lane) = v * rs * g; } }
        }
        if (ph + 1 < p.ph_hi) xcd_barrier(bar);
    }
}

extern "C" void kernel_launch(void* const* d_in, const int* in_sizes, int n_in, void* d_out, int out_size, void* d_ws, size_t ws_size, hipStream_t stream) {
    static int grid = 0;
    if (grid == 0) {
        if (n_in != 20 || out_size != (int)O_TOTAL || ws_size < WS_END) { fprintf(stderr, "kernel_launch: unexpected problem (n_in %d out %d ws %zu)\n", n_in, out_size, ws_size); grid = -1; return; }
        int dev = 0, cus = 0, per_cu = 0;
        if (hipGetDevice(&dev) != hipSuccess || hipDeviceGetAttribute(&cus, hipDeviceAttributeMultiprocessorCount, dev) != hipSuccess) { grid = -1; return; }
        if (hipFuncSetAttribute((const void*)mk_fwd, hipFuncAttributeMaxDynamicSharedMemorySize, LDS_BYTES) != hipSuccess) { fprintf(stderr, "kernel_launch: hipFuncSetAttribute failed\n"); grid = -1; return; }
        if (hipOccupancyMaxActiveBlocksPerMultiprocessor(&per_cu, (const void*)mk_fwd, 512, LDS_BYTES) != hipSuccess || per_cu < 1) { fprintf(stderr, "kernel_launch: occupancy query says %d\n", per_cu); per_cu = 1; }
        (void)hipGetLastError();
        grid = cus;
    }
    if (grid < 0) return;
    (void)hipMemsetAsync((char*)d_ws + WS_CTL, 0, CTL_BYTES, stream);
    Params a{};
    for (int i = 0; i < 20; ++i) a.in[i] = (const float*)d_in[i];
    a.out = (float*)d_out; a.ws = (unsigned char*)d_ws;
#if MK_ONE_LAUNCH
    a.ph_lo = 0; a.ph_hi = NPHASE;
    hipLaunchKernelGGL(mk_fwd, dim3(grid), dim3(512), LDS_BYTES, stream, a);
#else
    for (int ph = 0; ph < NPHASE; ++ph) { a.ph_lo = ph; a.ph_hi = ph + 1; hipLaunchKernelGGL(mk_fwd, dim3(grid), dim3(512), LDS_BYTES, stream, a); }
#endif
}
```

```cpp
#include <hip/hip_runtime.h>
#include <hip/hip_bf16.h>
#include <cstdio>
#include <cstdint>

#ifndef MK_ONE_LAUNCH
#define MK_ONE_LAUNCH 1
#endif
#ifndef PH_MASK
#define PH_MASK 0x3ff
#endif
#define PHON(i) (((PH_MASK) >> (i)) & 1)
#ifndef REP_WCONV
#define REP_WCONV 1
#endif
#ifndef REP_PA
#define REP_PA 1
#endif
#ifndef REP_PC
#define REP_PC 1
#endif
#ifndef REP_PE
#define REP_PE 1
#endif
#ifndef REP_BAR
#define REP_BAR 1
#endif

#define LAS __attribute__((address_space(3)))
#define GAS __attribute__((address_space(1)))
typedef unsigned short bf16_t;
typedef short bf16x8 __attribute__((ext_vector_type(8)));
typedef short s16x4 __attribute__((ext_vector_type(4)));
typedef float f32x4 __attribute__((ext_vector_type(4)));
typedef float f32x2 __attribute__((ext_vector_type(2)));
typedef float f32x16 __attribute__((ext_vector_type(16)));
typedef unsigned u32x4 __attribute__((ext_vector_type(4)));
typedef unsigned u32x2 __attribute__((ext_vector_type(2)));
typedef GAS unsigned gu32;

constexpr int DM = 1024, SEQ = 16384, NSB = 8, NST = 32, MROWS = SEQ + NSB * NST;
constexpr int NPAN = MROWS / 256;
constexpr int DIN = 6672, DFF = 2816;
constexpr float EPS = 1e-6f;
constexpr float LOG2E = 1.4426950408889634f;
constexpr int APITCH = 4864;
constexpr int C_UA = 0, C_QB = 512, C_KB = 768, C_VB = 1024, C_RB = 1536, C_Z = 2048, C_QC = 2304, C_KC = 2816, C_VC = 3328, C_XB = 3840;
constexpr int C_M = 0;
constexpr int C_YA = C_KC, C_YB = C_RB, C_YC = C_QC;
constexpr int C_HID = 0;
__host__ __device__ constexpr int gscr_col(int pn) { return pn == 0 ? 1024 : pn == 1 ? 1280 : pn == 2 ? 2048 : 3328; }
constexpr size_t MiB = 1u << 20;
constexpr size_t WS_CTL = 0, CTL_BYTES = 1 * MiB;
constexpr size_t WS_SS = 1 * MiB;
constexpr size_t WS_AN = 3 * MiB;
constexpr size_t WS_BIAS = 3 * MiB + 512 * 1024;
constexpr size_t WS_W2T = WS_BIAS + 16384;
constexpr size_t WS_PMT = WS_W2T + 16384;
constexpr size_t WS_W = 4 * MiB;
constexpr size_t W_IN = 0, W_G = W_IN + (size_t)3840 * 1024 * 2, W_B = W_G + (size_t)3072 * 1024 * 2, W_O = W_B + (size_t)3072 * 1024 * 2,
                 W_FI = W_O + (size_t)1024 * 1024 * 2, W_FO = W_FI + (size_t)5632 * 1024 * 2, W_END = W_FO + (size_t)1024 * 2816 * 2;
static_assert(W_END <= 38 * MiB, "weights");
constexpr size_t WS_KVS = 42 * MiB;
constexpr size_t WS_DS = 50 * MiB;
constexpr int NGU = 1024 + 32;
constexpr size_t WS_ACT = 67 * MiB;
constexpr size_t WS_END = WS_ACT + (size_t)MROWS * APITCH * 2;
static_assert(WS_DS + (size_t)NGU * 16384 <= WS_ACT && WS_END <= 224 * MiB, "ws map");
constexpr size_t O_Y = 0, O_POOLP = 17039360, O_POOLS = 17054720, O_GLAP = 17177600, O_GLAS = 17243136, O_KP = 17767424, O_KS = 18291712, O_VP = 18553856, O_VS = 19078144, O_TOTAL = 19340288;
constexpr int RING_BYTES = 131072, LDS_BIAS = 131072, LDS_WSF = 131072 + 8448, LDS_MISC = 144 * 1024 - 256, LDS_BYTES = 147456;

struct Params {
    const float* in[20];
    float* out;
    unsigned char* ws;
    int ph_lo, ph_hi;
};

__device__ __forceinline__ unsigned f2bf(float f) { unsigned u = __builtin_bit_cast(unsigned, f); return (u + 0x7fffu + ((u >> 16) & 1u)) >> 16; }
__device__ __forceinline__ unsigned pk2(float lo, float hi) { typedef __bf16 b2 __attribute__((ext_vector_type(2))); f32x2 v = {lo, hi}; b2 b = __builtin_convertvector(v, b2); return __builtin_bit_cast(unsigned, b); }
__device__ __forceinline__ float bf2f(unsigned short h) { return __builtin_bit_cast(float, (unsigned)h << 16); }
__device__ __forceinline__ float bflo(unsigned w) { return __builtin_bit_cast(float, w << 16); }
__device__ __forceinline__ float bfhi(unsigned w) { return __builtin_bit_cast(float, w & 0xffff0000u); }
__device__ __forceinline__ int crow(int r, int hi) { return (r & 3) + 8 * (r >> 2) + 4 * hi; }
__device__ __forceinline__ float fast_sigmoid(float x) { return __builtin_amdgcn_rcpf(1.0f + __builtin_amdgcn_exp2f(-x * LOG2E)); }
#define VM_WAIT() asm volatile("s_waitcnt vmcnt(0)" ::: "memory")
#define LGKM_WAIT() asm volatile("s_waitcnt lgkmcnt(0)" ::: "memory")
#define SBAR() __builtin_amdgcn_sched_barrier(0)
__device__ __forceinline__ s16x4 vtr(const LAS unsigned char* p) { typedef short v4 __attribute__((ext_vector_type(4))); return __builtin_bit_cast(s16x4, __builtin_amdgcn_ds_read_tr16_b64_v4i16((LAS v4*)p)); }
__device__ __forceinline__ bf16x8 cat8(s16x4 a, s16x4 b) { return (bf16x8){a[0], a[1], a[2], a[3], b[0], b[1], b[2], b[3]}; }
__device__ __forceinline__ void dma16(const void* gsrc, LAS unsigned char* dst) { __builtin_amdgcn_global_load_lds((const unsigned*)gsrc, (LAS unsigned*)dst, 16, 0, 0); }
__device__ __forceinline__ float row_rstd_full(const float* ss, int row) {
    const f32x4* p = (const f32x4*)(ss + (size_t)row * 16); f32x4 a = p[0], b = p[1], c = p[2], d = p[3];
    const float s = ((a[0] + a[1]) + (a[2] + a[3])) + ((b[0] + b[1]) + (b[2] + b[3])) + ((c[0] + c[1]) + (c[2] + c[3])) + ((d[0] + d[1]) + (d[2] + d[3]));
    return __builtin_amdgcn_rsqf(s * (1.0f / DM) + EPS);
}

namespace pg8 {
constexpr int BM = 256, BK = 64, HALF = 128, HTB = HALF * BK * 2, STAGE_BYTES = 8 * HTB, NXCD = 8, WGM = 8;
__host__ __device__ __forceinline__ int lds_byte(int r, int c) { const int st = (r >> 4) * 2 + (c >> 5), rr = r & 15, cc = c & 31, ob = rr * 64 + cc * 2; return st * 1024 + (ob ^ (((ob >> 9) & 1) << 5)); }
__host__ __device__ __forceinline__ void stage_rc(int b, int& R, int& C) { const int st = b / 1024, sb = b % 1024, swz = sb ^ (((sb >> 9) & 1) << 5); R = (st >> 1) * 16 + swz / 64; C = (st & 1) * 32 + (swz % 64) / 2; }
__host__ __device__ __forceinline__ int perm32(int rho) { const int n = rho >> 4, i = rho & 15; return 8 * (i >> 2) + 4 * n + (i & 3); }

struct Unit { unsigned A, B; int nt, pm, pn, kind; };
template <int nM, int nN, bool EXTRA>
__device__ __forceinline__ bool tile_of(int L, int& pm, int& pn) {
    constexpr int nwg = nM * nN; static_assert(nM % 8 == 0, "nM");
    if (L >= nwg) { if (EXTRA && L < nwg + nN) { pm = nM; pn = L - nwg; return true; } return false; }
    int wgid = L; { constexpr int q = nwg / NXCD, r = nwg % NXCD; const int xcd = wgid % NXCD, off = wgid / NXCD; wgid = (xcd < r ? xcd * (q + 1) : r * (q + 1) + (xcd - r) * q) + off; }
    constexpr int nig = WGM * nN; const int gid = wgid / nig, rem = wgid - gid * nig;
    pm = gid * WGM + (rem & (WGM - 1)); pn = rem / WGM; return true;
}

template <class Epi, class Sched, bool ALIGN_EPI, int lda, int ldb>
__device__ __forceinline__ void gemm_phase(LAS unsigned char* lds, const char* wsb, const Sched& S, const Epi& E, const int tid) {
    const int wid = __builtin_amdgcn_readfirstlane(tid >> 6), lane = tid & 63, wr = wid >> 2, wc = wid & 3, fr = lane & 15, fq = lane >> 4;
    unsigned voffA[2], voffB[2];
#pragma unroll
    for (int i = 0; i < 2; ++i) { int R, C; stage_rc(tid * 16 + i * 8192, R, C); const int Rb = Epi::PERM ? ((R & ~31) + perm32(R & 31)) : R;
        voffA[i] = (unsigned)(R * lda + C) * 2u; voffB[i] = (unsigned)(Rb * ldb + C) * 2u; }
    const size_t kstep = (size_t)(BK * 2);
    const size_t hstepA = (size_t)HALF * lda * 2, hstepB = (size_t)HALF * ldb * 2;
    const unsigned ldsw = (unsigned)wid * 1024u;
    const int aoff = lds_byte(wr * 64 + fr, fq * 8), boff = lds_byte(wc * 32 + fr, fq * 8);
#define PG8_SA(b, h) (((b) * 2 + (h)) * HTB)
#define PG8_SB(b, h) ((4 + (b) * 2 + (h)) * HTB)
#define PG8_STAGE(bufoff, gbase, voff) do { _Pragma("unroll") for (int _i = 0; _i < 2; ++_i) \
        __builtin_amdgcn_global_load_lds((const unsigned*)((const char*)(gbase) + (voff)[_i]), (LAS unsigned*)(lds + (bufoff) + ldsw + _i * 8192), 16, 0, 0); } while (0)
#define PG8_LDA(dst, b, h) do { _Pragma("unroll") for (int m = 0; m < 4; ++m) _Pragma("unroll") for (int k = 0; k < 2; ++k) dst[m][k] = *(const LAS bf16x8*)(lds + PG8_SA(b, h) + aoff + m * 2048 + k * 1024); } while (0)
#define PG8_LDB(dst, b, h) do { _Pragma("unroll") for (int n = 0; n < 2; ++n) _Pragma("unroll") for (int k = 0; k < 2; ++k) dst[n][k] = *(const LAS bf16x8*)(lds + PG8_SB(b, h) + boff + n * 2048 + k * 1024); } while (0)
#define PG8_MMA(ai, bj, At, Bt) do { __builtin_amdgcn_s_setprio(1); _Pragma("unroll") for (int m = 0; m < 4; ++m) _Pragma("unroll") for (int n = 0; n < 2; ++n) _Pragma("unroll") for (int k = 0; k < 2; ++k) \
        acc[ai][bj][m][n] = __builtin_amdgcn_mfma_f32_16x16x32_bf16(Bt[n][k], At[m][k], acc[ai][bj][m][n], 0, 0, 0); __builtin_amdgcn_s_setprio(0); } while (0)
#define PG8_WAIT_V(n) asm volatile("s_waitcnt vmcnt(" #n ")" ::: "memory")
#define PG8_WAIT_L(n) asm volatile("s_waitcnt lgkmcnt(" #n ")" ::: "memory")
#define PG8_BAR __builtin_amdgcn_s_barrier()
#define PG8_SCHED __builtin_amdgcn_sched_barrier(0)
    Unit cur, nxt; int ui = 0;
    if (!S.next(0, cur)) return;
    f32x4 acc[2][2][4][2];
#pragma unroll
    for (int a = 0; a < 2; ++a)
#pragma unroll
        for (int b = 0; b < 2; ++b)
#pragma unroll
            for (int m = 0; m < 4; ++m)
#pragma unroll
                for (int n = 0; n < 2; ++n) acc[a][b][m][n] = (f32x4){0.f, 0.f, 0.f, 0.f};
    bf16x8 At[4][2], B0[2][2], B1[2][2];
    const char* cA = wsb + cur.A; const char* cB = wsb + cur.B;
    PG8_STAGE(PG8_SB(0, 0), cB, voffB); PG8_STAGE(PG8_SB(0, 1), cB + hstepB, voffB); PG8_STAGE(PG8_SA(0, 0), cA, voffA); PG8_STAGE(PG8_SA(0, 1), cA + hstepA, voffA);
    if (wr == 1) PG8_BAR;
    PG8_WAIT_V(2); PG8_BAR;
    PG8_STAGE(PG8_SB(1, 0), cB + kstep, voffB); PG8_STAGE(PG8_SA(1, 0), cA + kstep, voffA); PG8_STAGE(PG8_SB(1, 1), cB + hstepB + kstep, voffB);
    PG8_WAIT_V(6); PG8_BAR;
    for (;;) {
        const bool has_next = S.next(ui + 1, nxt);
        const char* nA = has_next ? wsb + nxt.A : cA; const char* nB = has_next ? wsb + nxt.B : cB;
        const int nt = cur.nt;
        for (int t = 0; t < nt; t += 2) {
            const bool last = (t == nt - 2);
            const char* a1 = cA + (size_t)(t + 1) * kstep;
            const char* a2 = last ? nA : cA + (size_t)(t + 2) * kstep; const char* b2 = last ? nB : cB + (size_t)(t + 2) * kstep;
            const char* a3 = a2 + kstep; const char* b3 = b2 + kstep;
            PG8_LDB(B0, 0, 0); PG8_LDB(B1, 0, 1); PG8_SCHED; PG8_LDA(At, 0, 0); PG8_STAGE(PG8_SA(1, 1), a1 + hstepA, voffA);
            PG8_WAIT_V(8); PG8_WAIT_L(0); PG8_BAR; PG8_MMA(0, 0, At, B0); PG8_MMA(0, 1, At, B1); PG8_BAR; PG8_SCHED;
            PG8_LDA(At, 0, 1); PG8_STAGE(PG8_SB(0, 0), b2, voffB); PG8_STAGE(PG8_SB(0, 1), b2 + hstepB, voffB); PG8_STAGE(PG8_SA(0, 0), a2, voffA);
            PG8_WAIT_V(8); PG8_WAIT_L(0); PG8_BAR; PG8_MMA(1, 0, At, B0); PG8_MMA(1, 1, At, B1); PG8_BAR; PG8_SCHED;
            PG8_LDB(B0, 1, 0); PG8_LDB(B1, 1, 1); PG8_SCHED; PG8_LDA(At, 1, 0); PG8_STAGE(PG8_SA(0, 1), a2 + hstepA, voffA);
            PG8_WAIT_V(8); PG8_WAIT_L(0); PG8_BAR; PG8_MMA(0, 0, At, B0); PG8_MMA(0, 1, At, B1); PG8_BAR; PG8_SCHED;
            PG8_LDA(At, 1, 1); PG8_STAGE(PG8_SB(1, 0), b3, voffB); PG8_STAGE(PG8_SB(1, 1), b3 + hstepB, voffB); PG8_STAGE(PG8_SA(1, 0), a3, voffA);
            PG8_WAIT_V(8); PG8_WAIT_L(0); PG8_BAR; PG8_MMA(1, 0, At, B0); PG8_MMA(1, 1, At, B1); PG8_BAR; PG8_SCHED;
        }
        if constexpr (ALIGN_EPI) { if (wr == 0) PG8_BAR; }
        E(acc, cur, wr, wc, fr, fq);
        if (!has_next) break;
#pragma unroll
        for (int a = 0; a < 2; ++a)
#pragma unroll
            for (int b = 0; b < 2; ++b)
#pragma unroll
                for (int m = 0; m < 4; ++m)
#pragma unroll
                    for (int n = 0; n < 2; ++n) acc[a][b][m][n] = (f32x4){0.f, 0.f, 0.f, 0.f};
        cur = nxt; cA = nA; cB = nB; ++ui;
        if constexpr (ALIGN_EPI) { if (wr == 1) PG8_BAR; }
    }
    PG8_WAIT_V(0);
    if constexpr (!ALIGN_EPI) { if (wr == 0) PG8_BAR; }
    PG8_BAR;
#undef PG8_SA
#undef PG8_SB
#undef PG8_STAGE
#undef PG8_LDA
#undef PG8_LDB
#undef PG8_MMA
#undef PG8_WAIT_V
#undef PG8_WAIT_L
#undef PG8_BAR
#undef PG8_SCHED
}
}

using pg8::Unit;
template <int nM, int nN, bool EXTRA, unsigned ABASE, unsigned WBASE, int NT, unsigned WROWB>
struct SchedDense {
    int G, c;
    __device__ __forceinline__ bool next(int i, Unit& u) const {
        int pm, pn; if (!pg8::tile_of<nM, nN, EXTRA>(i * G + c, pm, pn)) return false;
        u.pm = pm; u.pn = pn; u.kind = 0; u.nt = NT; u.A = ABASE + (unsigned)pm * (256u * APITCH * 2u); u.B = WBASE + (unsigned)pn * (256u * WROWB); return true; }
};
struct SchedMerge {
    int G, c;
    __device__ __forceinline__ bool next(int i, Unit& u) const {
        const int su = i / 6, sub = i - su * 6; int pm, pn; if (!pg8::tile_of<64, 4, false>(su * G + c, pm, pn)) return false;
        const int g = sub >> 1; u.pm = pm; u.pn = pn; u.kind = sub;
        const unsigned arow = (unsigned)WS_ACT + (unsigned)pm * (256u * APITCH * 2u), brow = (unsigned)(g * 1024 + pn * 256) * 2048u;
        if ((sub & 1) == 0) { u.nt = 16; u.A = arow + C_XB * 2; u.B = (unsigned)(WS_W + W_G) + brow; }
        else { const int yc = g == 0 ? C_YA : g == 1 ? C_YB : C_YC; u.nt = 8; u.A = arow + yc * 2; u.B = (unsigned)(WS_W + W_B) + brow; }
        return true; }
};

__device__ __forceinline__ float row_rstd_q(const float* ss, int row, int fq) {
    const f32x4 a = *(const f32x4*)(ss + (size_t)row * 16 + 4 * fq); float s = (a[0] + a[1]) + (a[2] + a[3]);
    s += __shfl_xor(s, 16); s += __shfl_xor(s, 32); return __builtin_amdgcn_rsqf(s * (1.0f / DM) + EPS);
}
struct EpiA {
    static constexpr bool PERM = true;
    bf16_t* act; const float* ss;
    __device__ __forceinline__ void operator()(const f32x4 (&acc)[2][2][4][2], const Unit& u, int wr, int wc, int fr, int fq) const {
        const int row0 = u.pm * 256 + wr * 64 + fr, col0 = u.pn * 256 + wc * 32 + 8 * fq;
#pragma unroll
        for (int ai = 0; ai < 2; ++ai)
#pragma unroll
            for (int m = 0; m < 4; ++m) { const int row = row0 + ai * 128 + m * 16; const float rs = row_rstd_q(ss, row, fq); bf16_t* rowp = act + (size_t)row * APITCH + col0;
#pragma unroll
                for (int bj = 0; bj < 2; ++bj) { const f32x4 v0 = acc[ai][bj][m][0] * rs, v1 = acc[ai][bj][m][1] * rs;
                    u32x4 w; w.x = pk2(v0[0], v0[1]); w.y = pk2(v0[2], v0[3]); w.z = pk2(v1[0], v1[1]); w.w = pk2(v1[2], v1[3]); *(u32x4*)(rowp + bj * 128) = w; } }
    }
};
struct EpiE {
    static constexpr bool PERM = true;
    bf16_t* act; const float* ss;
    __device__ __forceinline__ void operator()(const f32x4 (&acc)[2][2][4][2], const Unit& u, int wr, int wc, int fr, int fq) const {
        const int row0 = u.pm * 256 + wr * 64 + fr, col0 = C_HID + u.pn * 128 + wc * 32 + 8 * fq;
#pragma unroll
        for (int ai = 0; ai < 2; ++ai)
#pragma unroll
            for (int m = 0; m < 4; ++m) { const int row = row0 + ai * 128 + m * 16; const float rs = row_rstd_q(ss, row, fq);
                float h[8];
#pragma unroll
                for (int n = 0; n < 2; ++n)
#pragma unroll
                    for (int e = 0; e < 4; ++e) { const float a = acc[ai][0][m][n][e] * rs, g = acc[ai][1][m][n][e] * rs; h[n * 4 + e] = a * fast_sigmoid(a) * g; }
                u32x4 w; w.x = pk2(h[0], h[1]); w.y = pk2(h[2], h[3]); w.z = pk2(h[4], h[5]); w.w = pk2(h[6], h[7]); *(u32x4*)(act + (size_t)row * APITCH + col0) = w; }
    }
};
struct EpiRes {
    static constexpr bool PERM = false;
    const float* res; float* out; bf16_t* act; float* ss;
    __device__ __forceinline__ void operator()(const f32x4 (&acc)[2][2][4][2], const Unit& u, int wr, int wc, int fr, int fq) const {
        const int row0 = u.pm * 256 + wr * 64 + fr, col0 = u.pn * 256 + wc * 32 + 4 * fq;
#pragma unroll
        for (int ai = 0; ai < 2; ++ai)
#pragma unroll
            for (int m = 0; m < 4; ++m) { const int row = row0 + ai * 128 + m * 16; float q = 0.f;
#pragma unroll
                for (int bj = 0; bj < 2; ++bj)
#pragma unroll
                    for (int n = 0; n < 2; ++n) { const int c = col0 + bj * 128 + n * 16; const f32x4 x = *(const f32x4*)(res + (size_t)row * DM + c) + acc[ai][bj][m][n];
                        *(f32x4*)(out + (size_t)row * DM + c) = x; q += (x[0] * x[0] + x[1] * x[1]) + (x[2] * x[2] + x[3] * x[3]);
                        u32x2 w; w.x = pk2(x[0], x[1]); w.y = pk2(x[2], x[3]); *(u32x2*)(act + (size_t)row * APITCH + C_XB + c) = w; }
                q += __shfl_xor(q, 16); q += __shfl_xor(q, 32);
                if (fq == 0) ss[(size_t)row * 16 + 4 * u.pn + wc] = q; }
    }
};
struct EpiMerge {
    static constexpr bool PERM = true;
    bf16_t* act; const float* ss;
    __device__ __forceinline__ void operator()(const f32x4 (&acc)[2][2][4][2], const Unit& u, int wr, int wc, int fr, int fq) const {
        const int row0 = u.pm * 256 + wr * 64 + fr, cin = wc * 32 + 8 * fq, gcol = gscr_col(u.pn) + cin, mcol = C_M + u.pn * 256 + cin;
        if ((u.kind & 1) == 0) {
#pragma unroll
            for (int ai = 0; ai < 2; ++ai)
#pragma unroll
                for (int m = 0; m < 4; ++m) { const int row = row0 + ai * 128 + m * 16; const float rs = row_rstd_q(ss, row, fq); bf16_t* rowp = act + (size_t)row * APITCH + gcol;
#pragma unroll
                    for (int bj = 0; bj < 2; ++bj) { f32x4 v0 = acc[ai][bj][m][0] * rs, v1 = acc[ai][bj][m][1] * rs;
#pragma unroll
                        for (int e = 0; e < 4; ++e) { v0[e] = fast_sigmoid(v0[e]); v1[e] = fast_sigmoid(v1[e]); }
                        u32x4 w; w.x = pk2(v0[0], v0[1]); w.y = pk2(v0[2], v0[3]); w.z = pk2(v1[0], v1[1]); w.w = pk2(v1[2], v1[3]); *(u32x4*)(rowp + bj * 128) = w; } }
        } else {
            const bool first = (u.kind == 1);
#pragma unroll
            for (int ai = 0; ai < 2; ++ai)
#pragma unroll
                for (int m = 0; m < 4; ++m) { const int row = row0 + ai * 128 + m * 16; bf16_t* rowp = act + (size_t)row * APITCH;
#pragma unroll
                    for (int bj = 0; bj < 2; ++bj) { const u32x4 gw = *(const u32x4*)(rowp + gcol + bj * 128); u32x4 mo = (u32x4){0u, 0u, 0u, 0u}; if (!first) mo = *(const u32x4*)(rowp + mcol + bj * 128);
                        const f32x4 a0 = acc[ai][bj][m][0], a1 = acc[ai][bj][m][1]; float r[8];
                        r[0] = a0[0] * bflo(gw.x) + bflo(mo.x); r[1] = a0[1] * bfhi(gw.x) + bfhi(mo.x); r[2] = a0[2] * bflo(gw.y) + bflo(mo.y); r[3] = a0[3] * bfhi(gw.y) + bfhi(mo.y);
                        r[4] = a1[0] * bflo(gw.z) + bflo(mo.z); r[5] = a1[1] * bfhi(gw.z) + bfhi(mo.z); r[6] = a1[2] * bflo(gw.w) + bflo(mo.w); r[7] = a1[3] * bfhi(gw.w) + bfhi(mo.w);
                        u32x4 w; w.x = pk2(r[0], r[1]); w.y = pk2(r[2], r[3]); w.z = pk2(r[4], r[5]); w.w = pk2(r[6], r[7]); *(u32x4*)(rowp + mcol + bj * 128) = w; } }
        }
    }
};

template <int KSTEPS>
__device__ __forceinline__ void small_tile_partial(const bf16_t* A, int lda, const bf16_t* Bt, int ldb, int wave, int lane, f32x4 (&acc)[4]) {
    const int kk0 = wave * KSTEPS * 32 + 8 * (lane >> 4); const bf16_t* ap = A + (size_t)(lane & 15) * lda + kk0; const bf16_t* bp = Bt + (size_t)(lane & 15) * ldb + kk0;
#pragma unroll
    for (int j = 0; j < 4; ++j) acc[j] = (f32x4){0.f, 0.f, 0.f, 0.f};
#pragma unroll
    for (int s = 0; s < KSTEPS; ++s) { const bf16x8 a = *(const bf16x8*)(ap + 32 * s);
#pragma unroll
        for (int j = 0; j < 4; ++j) { const bf16x8 b = *(const bf16x8*)(bp + (size_t)(16 * j) * ldb + 32 * s); acc[j] = __builtin_amdgcn_mfma_f32_16x16x32_bf16(a, b, acc[j], 0, 0, 0); } }
}
__device__ __forceinline__ f32x2 small_tile_reduce(LAS float* red, const f32x4 (&acc)[4], int wave, int lane, int tid) {
#pragma unroll
    for (int j = 0; j < 4; ++j)
#pragma unroll
        for (int r = 0; r < 4; ++r) red[(wave * 16 + 4 * (lane >> 4) + r) * 68 + 16 * j + (lane & 15)] = acc[j][r];
    __syncthreads();
    const int row = tid >> 5, c2 = 2 * (tid & 31); f32x2 s = {0.f, 0.f};
#pragma unroll
    for (int w = 0; w < 8; ++w) { const f32x2 v = *(const LAS f32x2*)(red + (w * 16 + row) * 68 + c2); s += v; }
    __syncthreads();
    return s;
}

constexpr float ATT_THR = 8.0f;
template <bool SAMP>
__device__ __forceinline__ void attn_task(bf16_t* act, const bf16_t* kvs, int cb, int h, int qb0, LAS unsigned char* vbuf, LAS float* wsf, const LAS float* tab, int lane) {
    constexpr int NQB = 1;
    const int r32 = lane & 31, hi = lane >> 5;
    const int nt = SAMP ? 9 : ((cb < 8 ? cb : 8) + 1);
    const int qrow0 = SAMP ? SEQ + 32 * cb : 64 * cb + 32 * qb0;
    const int vp0 = ((lane >> 4) & 1) * 32 + (lane & 3) * 8 + (4 * hi + ((lane & 15) >> 2)) * 64;
    bf16x8 qr[NQB][4];
#pragma unroll
    for (int qb = 0; qb < NQB; ++qb)
#pragma unroll
        for (int j = 0; j < 4; ++j) qr[qb][j] = *(const bf16x8*)(act + (size_t)(qrow0 + 32 * qb + r32) * APITCH + C_QC + h * 64 + 16 * j + 8 * hi);
    float mhat[NQB], lsum[NQB]; f32x16 o[NQB][2];
#pragma unroll
    for (int qb = 0; qb < NQB; ++qb) { mhat[qb] = 0.f; lsum[qb] = 0.f;
#pragma unroll
        for (int r = 0; r < 16; ++r) { o[qb][0][r] = 0.f; o[qb][1][r] = 0.f; } }
    const float bconst = tab[256];
#define ATT_TILE(t, kp, vp, pitch) do { if (SAMP && (t) < 8) { const size_t off_ = ((size_t)(cb * 512 + 64 * (t)) * 512 + h * 64) * 2; kp = (const char*)kvs + off_; vp = (const char*)kvs + (size_t)8 * 512 * 512 * 2 + off_; pitch = 1024; } \
        else { const int row_ = SAMP ? SEQ + 32 * cb : 64 * (cb - (nt - 1) + (t)); kp = (const char*)(act + (size_t)row_ * APITCH + C_KC + h * 64); vp = (const char*)(act + (size_t)row_ * APITCH + C_VC + h * 64); pitch = (size_t)APITCH * 2; } } while (0)
#define ATT_VDMA(vp, pitch, buf) do { _Pragma("unroll") for (int p_ = 0; p_ < 8; ++p_) dma16((vp) + (size_t)(16 * (p_ & 3) + (lane >> 2)) * (pitch) + ((p_ >> 2) * 32 + (lane & 3) * 8) * 2, (buf) + p_ * 1024); } while (0)
#define ATT_KLOAD(kp, pitch) do { _Pragma("unroll") for (int j_ = 0; j_ < 4; ++j_) { kf[2 * j_] = *(const bf16x8*)((kp) + (size_t)r32 * (pitch) + (16 * j_ + 8 * hi) * 2); kf[2 * j_ + 1] = *(const bf16x8*)((kp) + (size_t)(32 + r32) * (pitch) + (16 * j_ + 8 * hi) * 2); } } while (0)
    bf16x8 kf[8];
    { const char* kp; const char* vp; size_t pitch; ATT_TILE(0, kp, vp, pitch); LGKM_WAIT(); ATT_VDMA(vp, pitch, vbuf); ATT_KLOAD(kp, pitch); }
    for (int t = 0; t < nt; ++t) {
        const int delta = nt - 1 - t; const bool half = SAMP && (t == 8);
        LAS unsigned char* vcur = vbuf + (t & 1) * 8192;
        VM_WAIT();
        const char* kpn = nullptr; const char* vpn = nullptr; size_t pitchn = 0;
        if (t + 1 < nt) { ATT_TILE(t + 1, kpn, vpn, pitchn); LGKM_WAIT(); ATT_VDMA(vpn, pitchn, vbuf + ((t + 1) & 1) * 8192); }
#pragma unroll
        for (int qb = 0; qb < NQB; ++qb) {
            f32x16 c0, c1;
            if (delta >= 3) { const float cbv = bconst - mhat[qb];
#pragma unroll
                for (int r = 0; r < 16; ++r) { c0[r] = cbv; c1[r] = cbv; } }
            else { const int base = 64 * delta + 32 * (qb0 + qb) + r32 + 128;
#pragma unroll
                for (int r = 0; r < 16; ++r) { const int i0 = base - crow(r, hi), i1 = i0 - 32; c0[r] = tab[i0 < 256 ? i0 : 256] - mhat[qb]; c1[r] = tab[i1 < 256 ? i1 : 256] - mhat[qb]; } }
#pragma unroll
            for (int j = 0; j < 4; ++j) { c0 = __builtin_amdgcn_mfma_f32_32x32x16_bf16(kf[2 * j], qr[qb][j], c0, 0, 0, 0); if (!half) c1 = __builtin_amdgcn_mfma_f32_32x32x16_bf16(kf[2 * j + 1], qr[qb][j], c1, 0, 0, 0); }
            if (qb == NQB - 1 && t + 1 < nt) { asm volatile("" ::: "memory"); ATT_KLOAD(kpn, pitchn); }
            float rm = c0[0];
#pragma unroll
            for (int r = 1; r < 16; ++r) rm = fmaxf(rm, c0[r]);
            if (!half) {
#pragma unroll
                for (int r = 0; r < 16; ++r) rm = fmaxf(rm, c1[r]); }
            rm = fmaxf(rm, __shfl_xor(rm, 32));
            if (t == 0) { mhat[qb] += rm;
#pragma unroll
                for (int r = 0; r < 16; ++r) { c0[r] -= rm; c1[r] -= rm; } }
            else if (__any(rm > ATT_THR)) { const float dl = fmaxf(rm, 0.f); mhat[qb] += dl;
#pragma unroll
                for (int r = 0; r < 16; ++r) { c0[r] -= dl; c1[r] -= dl; }
                const float f = __builtin_amdgcn_exp2f(-dl); lsum[qb] *= f; if (hi == 0) wsf[r32] = f;
#pragma unroll
                for (int r = 0; r < 16; ++r) { const float fr_ = wsf[crow(r, hi)]; o[qb][0][r] *= fr_; o[qb][1][r] *= fr_; } }
            float ps = 0.f;
#pragma unroll
            for (int r = 0; r < 16; ++r) { c0[r] = __builtin_amdgcn_exp2f(c0[r]); ps += c0[r]; }
            if (!half) {
#pragma unroll
                for (int r = 0; r < 16; ++r) { c1[r] = __builtin_amdgcn_exp2f(c1[r]); ps += c1[r]; } }
            lsum[qb] += ps;
            u32x4 pw[4];
            pw[0] = (u32x4){pk2(c0[0], c0[1]), pk2(c0[2], c0[3]), pk2(c0[4], c0[5]), pk2(c0[6], c0[7])};
            pw[1] = (u32x4){pk2(c0[8], c0[9]), pk2(c0[10], c0[11]), pk2(c0[12], c0[13]), pk2(c0[14], c0[15])};
            pw[2] = (u32x4){pk2(c1[0], c1[1]), pk2(c1[2], c1[3]), pk2(c1[4], c1[5]), pk2(c1[6], c1[7])};
            pw[3] = (u32x4){pk2(c1[8], c1[9]), pk2(c1[10], c1[11]), pk2(c1[12], c1[13]), pk2(c1[14], c1[15])};
#pragma unroll
            for (int d0 = 0; d0 < 2; ++d0)
#pragma unroll
                for (int ks = 0; ks < 4; ++ks) { if (half && ks >= 2) continue;
                    const bf16x8 vf = cat8(vtr(vcur + d0 * 4096 + ks * 1024 + vp0), vtr(vcur + d0 * 4096 + ks * 1024 + vp0 + 512));
                    o[qb][d0] = __builtin_amdgcn_mfma_f32_32x32x16_bf16(__builtin_bit_cast(bf16x8, pw[ks]), vf, o[qb][d0], 0, 0, 0); }
        }
    }
#undef ATT_TILE
#undef ATT_VDMA
#undef ATT_KLOAD
    LAS bf16_t* stg = (LAS bf16_t*)vbuf;
#pragma unroll
    for (int qb = 0; qb < NQB; ++qb) {
        float lt = lsum[qb]; lt += __shfl_xor(lt, 32);
        if (hi == 0) wsf[32 + r32] = lt;
#pragma unroll
        for (int r = 0; r < 16; ++r) { const float rl = __builtin_amdgcn_rcpf(wsf[32 + crow(r, hi)]); const int orow = crow(r, hi);
            stg[orow * 64 + r32] = (bf16_t)f2bf(o[qb][0][r] * rl); stg[orow * 64 + 32 + r32] = (bf16_t)f2bf(o[qb][1][r] * rl); }
#pragma unroll
        for (int i = 0; i < 4; ++i) { const int row = i * 8 + (lane >> 3), ch = lane & 7; const u32x4 v = *(const LAS u32x4*)(stg + row * 64 + ch * 8);
            *(u32x4*)(act + (size_t)(qrow0 + 32 * qb + row) * APITCH + C_YC + h * 64 + ch * 8) = v; }
        LGKM_WAIT();
    }
}

__device__ __forceinline__ float log_sigmoid_f(float x) { const float ax = fabsf(x); return fminf(x, 0.f) - 0.6931471805599453f * __builtin_amdgcn_logf(1.0f + __builtin_amdgcn_exp2f(-ax * LOG2E)); }
template <int L>
__device__ __forceinline__ void gla1_unit(bf16_t* act, const bf16_t* w2t, const float* bgate, float* an, bf16_t* ds, int u, int tok0, int h, int parity, LAS unsigned char* lds, int tid, int wave, int lane) {
    constexpr int NTB = L / 32, NKS = L / 16;
    const int r32 = lane & 31, hi = lane >> 5;
    LAS float* Ep = (LAS float*)lds; LAS float* Em = (LAS float*)(lds + 16384); LAS unsigned char* kimg = lds + 32768; LAS unsigned char* vimg = lds + 40960 + parity * 16384; LAS float* totl = (LAS float*)(lds + 73728);
    const int vp0 = ((lane >> 4) & 1) * 32 + (lane & 3) * 8 + (4 * hi + ((lane & 15) >> 2)) * 64;
    float b[16]; const int tb = wave >> 1, db = wave & 1;
    if (wave < 2 * NTB) {
        const bf16x8 A = *(const bf16x8*)(act + (size_t)(tok0 + 32 * tb + r32) * APITCH + C_Z + 8 * hi);
        const bf16x8 B = *(const bf16x8*)(w2t + (h * 64 + 32 * db + r32) * 16 + 8 * hi);
        const float bg = bgate[h * 64 + 32 * db + r32]; f32x16 X;
#pragma unroll
        for (int r = 0; r < 16; ++r) X[r] = bg;
        X = __builtin_amdgcn_mfma_f32_32x32x16_bf16(A, B, X, 0, 0, 0);
        float la[16], seg[4], oth[4];
#pragma unroll
        for (int r = 0; r < 16; ++r) la[r] = log_sigmoid_f(X[r]) * 0.0625f;
#pragma unroll
        for (int q = 0; q < 4; ++q) { seg[q] = (la[4 * q] + la[4 * q + 1]) + (la[4 * q + 2] + la[4 * q + 3]); oth[q] = __shfl_xor(seg[q], 32); }
        float run = 0.f;
#pragma unroll
        for (int q = 0; q < 4; ++q) { float st = run + (hi ? oth[q] : 0.f);
#pragma unroll
            for (int i = 0; i < 4; ++i) { st += la[4 * q + i]; b[4 * q + i] = st; }
            run += seg[q] + oth[q]; }
        if (NTB == 2 && tb == 0 && hi == 0) totl[db * 32 + r32] = run;
    } else if (wave >= 4) {
        const int eb = wave - 4;
#pragma unroll
        for (int ks = 0; ks < NKS; ++ks) dma16(act + (size_t)(tok0 + 16 * ks + (lane >> 2)) * APITCH + C_VB + h * 128 + 32 * eb + (lane & 3) * 8, vimg + (eb * 4 + ks) * 1024);
        VM_WAIT();
    }
    __syncthreads();
    if (wave < 2 * NTB) {
        if (NTB == 2 && tb == 1) { const float carry = totl[db * 32 + r32];
#pragma unroll
            for (int r = 0; r < 16; ++r) b[r] += carry; }
#pragma unroll
        for (int r = 0; r < 16; ++r) { const int tok = 32 * tb + crow(r, hi); const float bl = b[r] * LOG2E; Ep[tok * 64 + 32 * db + r32] = __builtin_amdgcn_exp2f(bl); Em[tok * 64 + 32 * db + r32] = __builtin_amdgcn_exp2f(-bl); }
        if (tb == NTB - 1 && hi == 1) an[(size_t)u * 64 + 32 * db + r32] = __builtin_amdgcn_exp2f(b[15] * LOG2E);
    }
    __syncthreads();
    if (tid < L * 8) {
        const int tok = tid >> 3, c8 = tid & 7; bf16_t* qp = act + (size_t)(tok0 + tok) * APITCH + C_QB + h * 64 + 8 * c8; bf16_t* kp = act + (size_t)(tok0 + tok) * APITCH + C_KB + h * 64 + 8 * c8;
        const u32x4 qv = *(const u32x4*)qp, kv = *(const u32x4*)kp;
        const f32x4 e0 = *(const LAS f32x4*)(Ep + tok * 64 + 8 * c8), e1 = *(const LAS f32x4*)(Ep + tok * 64 + 8 * c8 + 4), m0 = *(const LAS f32x4*)(Em + tok * 64 + 8 * c8), m1 = *(const LAS f32x4*)(Em + tok * 64 + 8 * c8 + 4);
        u32x4 qo, ko;
        qo.x = pk2(bflo(qv.x) * e0[0], bfhi(qv.x) * e0[1]); qo.y = pk2(bflo(qv.y) * e0[2], bfhi(qv.y) * e0[3]); qo.z = pk2(bflo(qv.z) * e1[0], bfhi(qv.z) * e1[1]); qo.w = pk2(bflo(qv.w) * e1[2], bfhi(qv.w) * e1[3]);
        ko.x = pk2(bflo(kv.x) * m0[0], bfhi(kv.x) * m0[1]); ko.y = pk2(bflo(kv.y) * m0[2], bfhi(kv.y) * m0[3]); ko.z = pk2(bflo(kv.z) * m1[0], bfhi(kv.z) * m1[1]); ko.w = pk2(bflo(kv.w) * m1[2], bfhi(kv.w) * m1[3]);
        *(u32x4*)qp = qo; *(u32x4*)kp = ko;
        *(LAS u32x4*)(kimg + ((c8 >> 2) * 4 + (tok >> 4)) * 1024 + (tok & 15) * 64 + (c8 & 3) * 16) = ko;
    }
    __syncthreads();
    {
        const int eb = wave & 3, db2 = wave >> 2; f32x16 acc;
#pragma unroll
        for (int r = 0; r < 16; ++r) acc[r] = 0.f;
#pragma unroll
        for (int ks = 0; ks < NKS; ++ks) { const bf16x8 va = cat8(vtr(vimg + (eb * 4 + ks) * 1024 + vp0), vtr(vimg + (eb * 4 + ks) * 1024 + vp0 + 512));
            const bf16x8 kb = cat8(vtr(kimg + (db2 * 4 + ks) * 1024 + vp0), vtr(kimg + (db2 * 4 + ks) * 1024 + vp0 + 512));
            acc = __builtin_amdgcn_mfma_f32_32x32x16_bf16(va, kb, acc, 0, 0, 0); }
        bf16_t* dp = ds + (size_t)u * 8192 + 32 * db2 + r32;
#pragma unroll
        for (int r = 0; r < 16; ++r) dp[(32 * eb + crow(r, hi)) * 64] = (bf16_t)f2bf(acc[r]);
    }
}
template <int L>
__device__ __forceinline__ void gla3_task(bf16_t* act, const bf16_t* ds, const float* gn, int u, int tok0, int h, int ib, LAS unsigned char* vimg, int lane) {
    constexpr int NKS = L / 16;
    const int r32 = lane & 31, hi = lane >> 5;
    const int vp0 = ((lane >> 4) & 1) * 32 + (lane & 3) * 8 + (4 * hi + ((lane & 15) >> 2)) * 64;
    LGKM_WAIT();
#pragma unroll
    for (int eb = 0; eb < 4; ++eb)
#pragma unroll
        for (int ks = 0; ks < NKS; ++ks) dma16(act + (size_t)(tok0 + 16 * ks + (lane >> 2)) * APITCH + C_VB + h * 128 + 32 * eb + (lane & 3) * 8, vimg + (eb * 4 + ks) * 1024);
    bf16x8 qf[4];
#pragma unroll
    for (int s = 0; s < 4; ++s) qf[s] = *(const bf16x8*)(act + (size_t)(tok0 + 32 * ib + r32) * APITCH + C_QB + h * 64 + 16 * s + 8 * hi);
    f32x16 acc[4];
#pragma unroll
    for (int eb = 0; eb < 4; ++eb)
#pragma unroll
        for (int r = 0; r < 16; ++r) acc[eb][r] = 0.f;
    const bf16_t* sg = ds + (size_t)u * 8192;
#pragma unroll
    for (int eb = 0; eb < 4; ++eb) { asm volatile("" ::: "memory");
#pragma unroll
        for (int s = 0; s < 4; ++s) { const bf16x8 sa = *(const bf16x8*)(sg + (32 * eb + r32) * 64 + 16 * s + 8 * hi); acc[eb] = __builtin_amdgcn_mfma_f32_32x32x16_bf16(sa, qf[s], acc[eb], 0, 0, 0); } }
    VM_WAIT();
    for (int jb = 0; jb <= ib; ++jb) {
        f32x16 X;
#pragma unroll
        for (int r = 0; r < 16; ++r) X[r] = 0.f;
        asm volatile("" ::: "memory");
#pragma unroll
        for (int s = 0; s < 4; ++s) { const bf16x8 kfr = *(const bf16x8*)(act + (size_t)(tok0 + 32 * jb + r32) * APITCH + C_KB + h * 64 + 16 * s + 8 * hi); X = __builtin_amdgcn_mfma_f32_32x32x16_bf16(kfr, qf[s], X, 0, 0, 0); }
        if (jb == ib) {
#pragma unroll
            for (int r = 0; r < 16; ++r) if (crow(r, hi) > r32) X[r] = 0.f; }
        const u32x4 x0 = (u32x4){pk2(X[0], X[1]), pk2(X[2], X[3]), pk2(X[4], X[5]), pk2(X[6], X[7])}, x1 = (u32x4){pk2(X[8], X[9]), pk2(X[10], X[11]), pk2(X[12], X[13]), pk2(X[14], X[15])};
#pragma unroll
        for (int eb = 0; eb < 4; ++eb)
#pragma unroll
            for (int s2 = 0; s2 < 2; ++s2) { asm volatile("" ::: "memory"); const int ks = 2 * jb + s2; const bf16x8 vf = cat8(vtr(vimg + (eb * 4 + ks) * 1024 + vp0), vtr(vimg + (eb * 4 + ks) * 1024 + vp0 + 512));
                acc[eb] = __builtin_amdgcn_mfma_f32_32x32x16_bf16(vf, __builtin_bit_cast(bf16x8, s2 ? x1 : x0), acc[eb], 0, 0, 0); }
    }
    float ssq = 0.f;
#pragma unroll
    for (int eb = 0; eb < 4; ++eb)
#pragma unroll
        for (int r = 0; r < 16; ++r) ssq += acc[eb][r] * acc[eb][r];
    ssq += __shfl_xor(ssq, 32);
    const float rs = __builtin_amdgcn_rsqf(ssq * (1.0f / 128.0f) + EPS);
    bf16_t* rowp = act + (size_t)(tok0 + 32 * ib + r32) * APITCH + C_RB + h * 128;
#pragma unroll
    for (int eb = 0; eb < 4; ++eb)
#pragma unroll
        for (int q = 0; q < 4; ++q) { asm volatile("" ::: "memory"); const int e0 = 32 * eb + 8 * q + 4 * hi; const f32x4 g = *(const f32x4*)(gn + e0); const u32x2 rv = *(const u32x2*)(rowp + e0);
            const float r0 = bflo(rv.x), r1 = bfhi(rv.x), r2 = bflo(rv.y), r3 = bfhi(rv.y);
            u32x2 w; w.x = pk2(acc[eb][4 * q] * rs * g[0] * r0 * fast_sigmoid(r0), acc[eb][4 * q + 1] * rs * g[1] * r1 * fast_sigmoid(r1));
            w.y = pk2(acc[eb][4 * q + 2] * rs * g[2] * r2 * fast_sigmoid(r2), acc[eb][4 * q + 3] * rs * g[3] * r3 * fast_sigmoid(r3)); *(u32x2*)(rowp + e0) = w; }
}

template <int GI>
__device__ __forceinline__ void pool_task(bf16_t* act, const float* hist  , const bf16_t* pmt, const float* pscale, int row0, int pos0, LAS unsigned char* ptile, int lane) {
    constexpr int W = 2 << GI;
    const int r32 = lane & 31, hi = lane >> 5;
    const int col = 128 * GI + 2 * lane;
    f32x2 uv[W - 1 + 32];
#pragma unroll
    for (int j = 0; j < W - 1 + 32; ++j) { const int t = j - (W - 1);
        if (t >= 0 || (hist == nullptr && row0 + t >= 0)) { const unsigned w = *(const unsigned*)(act + (size_t)(row0 + t) * APITCH + C_UA + col); uv[j] = (f32x2){bflo(w), bfhi(w)}; }
        else if (hist != nullptr) uv[j] = *(const f32x2*)(hist + (size_t)(15 + t) * 512 + col);
        else uv[j] = (f32x2){0.f, 0.f}; }
    f32x2 sum = {0.f, 0.f};
#pragma unroll
    for (int j = 0; j < W - 1; ++j) sum += uv[j];
    LGKM_WAIT();
#pragma unroll
    for (int t = 0; t < 32; ++t) { sum += uv[t + W - 1]; const int pos = pos0 + t; const float inv = 1.0f / (float)(pos + 1 < W ? pos + 1 : W);
        const f32x2 p = sum * inv - uv[t + W - 1]; *(LAS unsigned*)(ptile + (t * 136 + 2 * lane) * 2) = pk2(p[0], p[1]); sum -= uv[t]; }
    f32x16 acc[4];
#pragma unroll
    for (int db = 0; db < 4; ++db)
#pragma unroll
        for (int r = 0; r < 16; ++r) acc[db][r] = 0.f;
#pragma unroll
    for (int s = 0; s < 8; ++s) { asm volatile("" ::: "memory"); const bf16x8 pf = *(const LAS bf16x8*)(ptile + (r32 * 136 + 16 * s + 8 * hi) * 2);
#pragma unroll
        for (int db = 0; db < 4; ++db) { const bf16x8 mf = *(const bf16x8*)(pmt + (size_t)GI * 16384 + (32 * db + r32) * 128 + 16 * s + 8 * hi); acc[db] = __builtin_amdgcn_mfma_f32_32x32x16_bf16(mf, pf, acc[db], 0, 0, 0); } }
    bf16_t* rowp = act + (size_t)(row0 + r32) * APITCH + C_YA + 128 * GI;
#pragma unroll
    for (int db = 0; db < 4; ++db)
#pragma unroll
        for (int q = 0; q < 4; ++q) { asm volatile("" ::: "memory"); const int d0 = 32 * db + 8 * q + 4 * hi; const f32x4 sc = *(const f32x4*)(pscale + 128 * GI + d0);
            u32x2 w; w.x = pk2(acc[db][4 * q] * sc[0], acc[db][4 * q + 1] * sc[1]); w.y = pk2(acc[db][4 * q + 2] * sc[2], acc[db][4 * q + 3] * sc[3]); *(u32x2*)(rowp + d0) = w; }
}

#define XB_TMO      128
#define XB_XCNT(j)  (256  + 64 * (j))
#define XB_XSUB(j)  (1280 + 64 * (j))
#define XB_XGEN(j)  (2304 + 64 * (j))
#define XB_TOP      3328
#define XB_TOPGEN   3392
#define XCD_BAR_WORDS 3456
#define XB_SPIN_CAP (1u << 22)
__device__ __forceinline__ unsigned xb_ld(unsigned* p)              { return __hip_atomic_load(p, __ATOMIC_RELAXED, __HIP_MEMORY_SCOPE_AGENT); }
__device__ __forceinline__ unsigned xb_add(unsigned* p, unsigned v) { return __hip_atomic_fetch_add(p, v, __ATOMIC_RELAXED, __HIP_MEMORY_SCOPE_AGENT); }
__device__ __forceinline__ unsigned xb_xcc_id() { return (unsigned)__builtin_amdgcn_s_getreg((3 << 11) | 20) & 0xFu; }
#define XB_SPIN(cond, bar) do { unsigned _sp = 0; while (cond) { __builtin_amdgcn_s_sleep(1); \
    if ((++_sp & 255u) == 0u) { if (xb_ld(&(bar)[XB_TMO])) break; if (_sp > XB_SPIN_CAP) { atomicAdd(&(bar)[XB_TMO], 1u); break; } } } } while (0)
struct XcdBarrier { unsigned* bar; unsigned x; volatile LAS unsigned* st; };
__device__ __forceinline__ XcdBarrier xcd_barrier_post(unsigned* bar, volatile LAS unsigned* st) {
    XcdBarrier b; b.bar = bar; b.x = xb_xcc_id(); b.st = st;
    if (threadIdx.x == 0) (void)xb_add(&bar[XB_XCNT(b.x)], 1u);
    return b;
}
__device__ __forceinline__ void xcd_barrier_complete(unsigned* bar, unsigned x, unsigned& nloc, unsigned& nx) {
    const unsigned G = gridDim.x * gridDim.y * gridDim.z;
    unsigned sum, cnt, mine, sp = 0u;
    for (;;) {
        sum = 0u; cnt = 0u; mine = 0u;
#pragma unroll
        for (unsigned j = 0; j < 16; ++j) { const unsigned c = xb_ld(&bar[XB_XCNT(j)]); sum += c; cnt += (c > 0u) ? 1u : 0u; mine = (j == x) ? c : mine; }
        if (sum == G) break;
        __builtin_amdgcn_s_sleep(1);
        if ((++sp & 255u) == 0u) { if (xb_ld(&bar[XB_TMO])) break; if (sp > XB_SPIN_CAP) { atomicAdd(&bar[XB_TMO], 1u); break; } }
    }
    nloc = mine > 0u ? mine : 1u; nx = cnt > 0u ? cnt : 1u;
}
__device__ __forceinline__ void xcd_barrier(const XcdBarrier& b) {
    asm volatile("s_waitcnt vmcnt(0)" ::: "memory");
    __syncthreads();
    if (threadIdx.x == 0) {
        unsigned* bar = b.bar;
        __builtin_amdgcn_s_waitcnt(0);
        unsigned nloc = b.st[0], nx = b.st[1];
        if (nloc == 0u) { xcd_barrier_complete(bar, b.x, nloc, nx); b.st[0] = nloc; b.st[1] = nx; }
        const unsigned old = xb_add(&bar[XB_XSUB(b.x)], 1u);
        const unsigned gen = old / nloc;
        if (old + 1u == (gen + 1u) * nloc) {
            __builtin_amdgcn_fence(__ATOMIC_RELEASE, "agent");
            asm volatile("s_waitcnt vmcnt(0)" ::: "memory");
            const unsigned og = xb_add(&bar[XB_TOP], 1u);
            const unsigned tg = og / nx;
            if (og + 1u == (tg + 1u) * nx) xb_add(&bar[XB_TOPGEN], 1u);
            else XB_SPIN(xb_ld(&bar[XB_TOPGEN]) == tg, bar);
            __builtin_amdgcn_fence(__ATOMIC_ACQUIRE, "agent");
            xb_add(&bar[XB_XGEN(b.x)], 1u);
            asm volatile("s_waitcnt vmcnt(0)" ::: "memory");
        } else {
            XB_SPIN(xb_ld(&bar[XB_XGEN(b.x)]) == gen, bar);
            __builtin_amdgcn_fence(__ATOMIC_ACQUIRE, "agent");
            asm volatile("s_waitcnt vmcnt(0)" ::: "memory");
        }
    }
    __syncthreads();
}

__device__ __forceinline__ float wave_sum(float v) {
#pragma unroll
    for (int o = 1; o < 64; o <<= 1) v += __shfl_xor(v, o);
    return v;
}
__device__ __forceinline__ int src_col(int sel, int n) {
    if (sel == 1) return n < 2064 ? n : (n < 2304 ? -1 : n - 240);
    if (sel == 2) { const int pn = n >> 8, jj = n & 255; return jj < 128 ? 128 * pn + jj : 2816 + 128 * pn + (jj - 128); }
    return n;
}
__device__ __forceinline__ void tr_item(const float* W, int ldw, int sel, int coff, const float* gain, bf16_t* WT, int dpitch, int kb, int nb, LAS float* scr, int lane) {
    const int k0 = 64 * kb, n0 = 32 * nb, n4 = lane & 7, kr = lane >> 3;
    int sc[4];
#pragma unroll
    for (int e = 0; e < 4; ++e) sc[e] = src_col(sel, n0 + 4 * n4 + e);
    const bool vec = (sc[0] >= 0) && (sc[3] == sc[0] + 3) && (((coff + sc[0]) & 3) == 0) && ((ldw & 3) == 0);
    f32x4 v[8];
#pragma unroll
    for (int i = 0; i < 8; ++i) { const int kk = 8 * i + kr; const float* rp = W + (size_t)(k0 + kk) * ldw + coff;
        if (vec) v[i] = *(const f32x4*)(rp + sc[0]);
        else {
#pragma unroll
            for (int e = 0; e < 4; ++e) v[i][e] = sc[e] >= 0 ? rp[sc[e]] : 0.f; } }
    LGKM_WAIT();
#pragma unroll
    for (int i = 0; i < 8; ++i) { const int kk = 8 * i + kr; const float g = gain ? gain[k0 + kk] : 1.f;
#pragma unroll
        for (int e = 0; e < 4; ++e) scr[kk * 33 + 4 * n4 + e] = v[i][e] * g; }
    LGKM_WAIT(); asm volatile("" ::: "memory");
    const int c = lane & 7;
#pragma unroll
    for (int j = 0; j < 4; ++j) { const int n = (lane >> 3) + 8 * j; const LAS float* s = scr + (8 * c) * 33 + n; const int dn = n0 + n;
        float rsc = 1.f; if (sel == 1) rsc = (dn >= 512 && dn < 768) ? 0.125f : ((dn >= 2304 && dn < 2816) ? 0.125f * LOG2E : 1.f);
        u32x4 o; o.x = pk2(s[0 * 33] * rsc, s[1 * 33] * rsc); o.y = pk2(s[2 * 33] * rsc, s[3 * 33] * rsc); o.z = pk2(s[4 * 33] * rsc, s[5 * 33] * rsc); o.w = pk2(s[6 * 33] * rsc, s[7 * 33] * rsc);
        *(u32x4*)(WT + (size_t)dn * dpitch + k0 + 8 * c) = o; }
    LGKM_WAIT(); asm volatile("" ::: "memory");
}
__device__ __forceinline__ void phase_wconv(const Params& p, int l, LAS unsigned char* lds, int tid, int wave, int lane, int vcu, int G) {
    LAS float* scr = (LAS float*)(lds + wave * 16384);
    unsigned char* ws = p.ws; bf16_t* wbase = (bf16_t*)(ws + WS_W);
    const int gw = vcu * 8 + wave, NGW = G * 8;
    const float* w_in = p.in[7] + (size_t)l * DM * DIN; const float* ang = p.in[6] + l * DM; const float* fng = p.in[16] + l * DM;
    constexpr int I0 = 120 * 16, I1 = 96 * 16, I2 = 3 * 32 * 8, I3 = 32 * 16, I4 = 176 * 16, I5 = 32 * 44, I6 = 4 * 4 * 2, NIT = I0 + I1 + I2 + I3 + I4 + I5 + I6;
    for (int it = gw; it < NIT; it += NGW) {
        int r = it;
        if (r < I0) { tr_item(w_in, DIN, 1, 0, ang, wbase + W_IN / 2, 1024, r % 16, r / 16, scr, lane); continue; } r -= I0;
        if (r < I1) { tr_item(w_in, DIN, 0, 3600, ang, wbase + W_G / 2, 1024, r % 16, r / 16, scr, lane); continue; } r -= I1;
        if (r < I2) { const int g = r / 256, rr = r % 256; tr_item(p.in[14] + (size_t)(l * 3 + g) * 512 * 1024, 1024, 0, 0, nullptr, wbase + W_B / 2 + (size_t)g * 1024 * 1024, 1024, rr % 8, rr / 8, scr, lane); continue; } r -= I2;
        if (r < I3) { tr_item(p.in[15] + (size_t)l * 1024 * 1024, 1024, 0, 0, nullptr, wbase + W_O / 2, 1024, r % 16, r / 16, scr, lane); continue; } r -= I3;
        if (r < I4) { tr_item(p.in[17] + (size_t)l * 1024 * 5632, 5632, 2, 0, fng, wbase + W_FI / 2, 1024, r % 16, r / 16, scr, lane); continue; } r -= I4;
        if (r < I5) { tr_item(p.in[18] + (size_t)l * 2816 * 1024, 1024, 0, 0, nullptr, wbase + W_FO / 2, 2816, r % 44, r / 44, scr, lane); continue; } r -= I5;
        { const int g = r / 8, rr = r % 8; tr_item(p.in[11] + (size_t)(l * 4 + g) * 128 * 128, 128, 0, 0, nullptr, (bf16_t*)(ws + WS_PMT) + (size_t)g * 16384, 128, rr % 2, rr / 2, scr, lane); }
    }
    const int gt = vcu * 512 + tid, NGT = G * 512;
    for (int i = gt; i < 4096; i += NGT) { const int col = i >> 4, k = i & 15; ((bf16_t*)(ws + WS_W2T))[i] = (bf16_t)f2bf(p.in[8][(size_t)l * 16 * 256 + k * 256 + col]); }
    for (int i = gt; i < 8 * 260; i += NGT) { const int h = i / 260, j = i % 260; ((float*)(ws + WS_BIAS))[i] = j < 257 ? p.in[13][(size_t)(l * 8 + h) * 257 + j] * LOG2E : 0.f; }
    { const float* ck = p.in[4] + (size_t)l * 2097152; const float* cv = p.in[5] + (size_t)l * 2097152; bf16_t* kd = (bf16_t*)(ws + WS_KVS);
        for (int i = gt; i < 2 * 262144; i += NGT) { const int which = i >= 262144, j = which ? i - 262144 : i; const float* s = (which ? cv : ck) + (size_t)j * 8; const f32x4 a = *(const f32x4*)s, b = *(const f32x4*)(s + 4);
            u32x4 o; o.x = pk2(a[0], a[1]); o.y = pk2(a[2], a[3]); o.z = pk2(b[0], b[1]); o.w = pk2(b[2], b[3]); *(u32x4*)(kd + (size_t)which * 2097152 + (size_t)j * 8) = o; } }
    if (l == 0) {
        bf16_t* act = (bf16_t*)(ws + WS_ACT); float* ss = (float*)(ws + WS_SS);
        for (int m = gw; m < MROWS; m += NGW) { const float* xr = m < SEQ ? p.in[0] + (size_t)m * DM : p.in[1] + (size_t)(m - SEQ) * DM; float q = 0.f;
#pragma unroll
            for (int j = 0; j < 4; ++j) { const f32x4 v = *(const f32x4*)(xr + 256 * j + 4 * lane); q += (v[0] * v[0] + v[1] * v[1]) + (v[2] * v[2] + v[3] * v[3]);
                u32x2 w; w.x = pk2(v[0], v[1]); w.y = pk2(v[2], v[3]); *(u32x2*)(act + (size_t)m * APITCH + C_XB + 256 * j + 4 * lane) = w; }
            q = wave_sum(q); if (lane < 16) ss[(size_t)m * 16 + lane] = lane == 0 ? q : 0.f; }
    }
}

__device__ __forceinline__ void phase_scan(const Params& p, int l, int tid, int wave, int lane, int vcu, int G) {
    unsigned char* ws = p.ws; bf16_t* ds = (bf16_t*)(ws + WS_DS); const float* an = (const float*)(ws + WS_AN);
    if (wave < 2) {
        for (int wv = vcu * 2 + wave; wv < 512; wv += G * 2) {
            const int el = wv * 64 + lane, h = el >> 13, idx = el & 8191, d = idx & 63, e = idx >> 6; float S = 0.f;
            bf16_t* dsp = ds + (size_t)h * 8192 + idx; const float* anp = an + h * 64 + d;
            unsigned short dq[2][16]; float aq[2][16];
#pragma unroll
            for (int j = 0; j < 16; ++j) { dq[0][j] = dsp[(size_t)j * 32768]; aq[0][j] = anp[(size_t)j * 256]; }
#pragma unroll 1
            for (int n0 = 0; n0 < 256; n0 += 32) {
#pragma unroll
                for (int j = 0; j < 16; ++j) { dq[1][j] = dsp[(size_t)(n0 + 16 + j) * 32768]; aq[1][j] = anp[(size_t)(n0 + 16 + j) * 256]; }
#pragma unroll
                for (int j = 0; j < 16; ++j) { dsp[(size_t)(n0 + j) * 32768] = (bf16_t)f2bf(S); S = aq[0][j] * (S + bf2f(dq[0][j])); }
                if (n0 + 32 < 256) {
#pragma unroll
                    for (int j = 0; j < 16; ++j) { dq[0][j] = dsp[(size_t)(n0 + 32 + j) * 32768]; aq[0][j] = anp[(size_t)(n0 + 32 + j) * 256]; } }
#pragma unroll
                for (int j = 0; j < 16; ++j) { dsp[(size_t)(n0 + 16 + j) * 32768] = (bf16_t)f2bf(S); S = aq[1][j] * (S + bf2f(dq[1][j])); }
            }
            p.out[O_GLAP + (size_t)l * 32768 + (size_t)h * 8192 + d * 128 + e] = S;
        }
    } else {
        for (int wv = vcu * 6 + (wave - 2); wv < 32 * 128; wv += G * 6) {
            const int el = wv * 64 + lane, ub = el >> 13, idx = el & 8191, d = idx & 63, e = idx >> 6, u = 1024 + ub;
            const float s0 = p.in[3][(size_t)l * 262144 + (size_t)ub * 8192 + d * 128 + e]; const float dv = bf2f(ds[(size_t)u * 8192 + idx]);
            ds[(size_t)u * 8192 + idx] = (bf16_t)f2bf(s0);
            p.out[O_GLAS + (size_t)l * 262144 + (size_t)ub * 8192 + d * 128 + e] = an[(size_t)u * 64 + d] * (s0 + dv);
        }
    }
}

__device__ __forceinline__ void copy8(const bf16_t* s, float* d) { const u32x4 v = *(const u32x4*)s; *(f32x4*)d = (f32x4){bflo(v.x), bfhi(v.x), bflo(v.y), bfhi(v.y)}; *(f32x4*)(d + 4) = (f32x4){bflo(v.z), bfhi(v.z), bflo(v.w), bfhi(v.w)}; }
__device__ __forceinline__ void phase_copies(const Params& p, int l, int tid, int vcu, int G) {
    const bf16_t* act = (const bf16_t*)(p.ws + WS_ACT); float* out = p.out;
    const int gt = vcu * 512 + tid, NGT = G * 512;
    constexpr int NKP = 512 * 64, NKS_ = 256 * 64, NPP = 15 * 64, NPS = 8 * 15 * 64, NTOT = 2 * NKP + 2 * NKS_ + NPP + NPS;
    for (int i = gt; i < NTOT; i += NGT) {
        int r = i;
        if (r < 2 * NKP) { const int v = r >= NKP; if (v) r -= NKP; const int row = r >> 6, c8 = r & 63; copy8(act + (size_t)(SEQ - 512 + row) * APITCH + (v ? C_VC : C_KC) + 8 * c8, out + (v ? O_VP : O_KP) + (size_t)l * 262144 + (size_t)row * 512 + 8 * c8); continue; } r -= 2 * NKP;
        if (r < 2 * NKS_) { const int v = r >= NKS_; if (v) r -= NKS_; const int row = r >> 6, c8 = r & 63; copy8(act + (size_t)(SEQ + row) * APITCH + (v ? C_VC : C_KC) + 8 * c8, out + (v ? O_VS : O_KS) + (size_t)l * 131072 + (size_t)row * 512 + 8 * c8); continue; } r -= 2 * NKS_;
        if (r < NPP) { const int row = r >> 6, c8 = r & 63; copy8(act + (size_t)(SEQ - 15 + row) * APITCH + C_UA + 8 * c8, out + O_POOLP + (size_t)l * 7680 + (size_t)row * 512 + 8 * c8); continue; } r -= NPP;
        { const int b = r / (15 * 64), rr = r % (15 * 64), row = rr >> 6, c8 = rr & 63; copy8(act + (size_t)(SEQ + 32 * b + 17 + row) * APITCH + C_UA + 8 * c8, out + O_POOLS + (size_t)l * 61440 + (size_t)(b * 15 + row) * 512 + 8 * c8); }
    }
}

constexpr int CW_BAR = 4096;
constexpr int NPHASE = 19;

__global__ void __launch_bounds__(512, 2) mk_fwd(Params p) {
    extern __shared__ __attribute__((aligned(16))) unsigned char lds_raw[];
    LAS unsigned char* lds = (LAS unsigned char*)lds_raw;
    const int tid0 = threadIdx.x;
    const int G = gridDim.x; const int bx = blockIdx.x; const int vcu = (G % 8 == 0) ? (bx % 8) * (G / 8) + bx / 8 : bx;
    volatile LAS unsigned* MISC = (volatile LAS unsigned*)(lds + LDS_MISC);
    if (tid0 < 64) MISC[tid0] = 0u;
    __syncthreads();
    unsigned char* ws = p.ws;
    unsigned* ctl = (unsigned*)(ws + WS_CTL);
    bf16_t* act = (bf16_t*)(ws + WS_ACT); float* ss = (float*)(ws + WS_SS); bf16_t* wbase = (bf16_t*)(ws + WS_W);
    XcdBarrier bar; bar.bar = ctl + CW_BAR; bar.x = 0; bar.st = nullptr;
    if (p.ph_hi - p.ph_lo > 1) bar = xcd_barrier_post(ctl + CW_BAR, MISC + 8);

    for (int ph = p.ph_lo; ph < p.ph_hi; ++ph) {
        int tid = tid0; asm volatile("" : "+v"(tid));
        const int lane = tid & 63, wave = __builtin_amdgcn_readfirstlane(tid >> 6);
        const int l = ph == 0 ? 0 : (ph - 1) / 9, sub = ph == 0 ? -1 : (ph - 1) % 9;
        if (ph == 0) { if (PHON(9)) for (int rep = 0; rep < REP_WCONV; ++rep) { int t2 = tid; asm volatile("" : "+v"(t2)); phase_wconv(p, 0, lds, t2, wave, t2 & 63, vcu, G); } }
        else if (sub == 0 && PHON(0)) {
            typedef SchedDense<64, 15, true, (unsigned)(WS_ACT + C_XB * 2), (unsigned)(WS_W + W_IN), 16, 2048u> SA;
            SA S{G, bx}; EpiA E{act, ss};
            for (int rep = 0; rep < REP_PA; ++rep) { int t2 = tid; asm volatile("" : "+v"(t2)); pg8::gemm_phase<EpiA, SA, true, APITCH, 1024>(lds, (const char*)ws, S, E, t2); }
        } else if (sub == 1 && PHON(1)) {
            const float* bsrc = (const float*)(ws + WS_BIAS); LAS float* tab = (LAS float*)(lds + LDS_BIAS);
            for (int i = tid; i < 8 * 260; i += 512) tab[i] = bsrc[i];
            __syncthreads();
            LAS unsigned char* vbuf = lds + wave * 16384; LAS float* wsf = (LAS float*)(lds + LDS_WSF) + wave * 128;
            const bf16_t* kvs = (const bf16_t*)(ws + WS_KVS);
            for (int c = vcu; c < 256; c += G) { int ln = lane; asm volatile("" : "+v"(ln)); attn_task<false>(act, kvs, c, wave, 0, vbuf, wsf, tab + wave * 260, ln); asm volatile("" : "+v"(ln)); attn_task<false>(act, kvs, c, wave, 1, vbuf, wsf, tab + wave * 260, ln); }
            for (int b = 0; b < 8; ++b) if ((G - 1 - b) % G == vcu) { int ln = lane; asm volatile("" : "+v"(ln)); attn_task<true>(act, kvs, b, wave, 0, vbuf, wsf, tab + wave * 260, ln); }
            VM_WAIT(); LGKM_WAIT();
            __syncthreads();
            const bf16_t* w2t = (const bf16_t*)(ws + WS_W2T); const float* bgate = p.in[9] + l * 256; float* an = (float*)(ws + WS_AN); bf16_t* ds = (bf16_t*)(ws + WS_DS);
            int cnt = 0;
            for (int u = vcu; u < 1024; u += G) { gla1_unit<64>(act, w2t, bgate, an, ds, u, (u >> 2) * 64, u & 3, cnt & 1, lds, tid, wave, lane); ++cnt; }
            for (int su = vcu; su < 32; su += G) { gla1_unit<32>(act, w2t, bgate, an, ds, 1024 + su, SEQ + 32 * (su >> 2), su & 3, cnt & 1, lds, tid, wave, lane); ++cnt; }
            phase_copies(p, l, tid, vcu, G);
        } else if (sub == 2 && PHON(2)) phase_scan(p, l, tid, wave, lane, vcu, G);
        else if (sub == 3 && PHON(3)) {
            const int gw = vcu * 8 + wave, NGW = G * 8; LAS unsigned char* wl = lds + wave * 16384;
            const bf16_t* ds = (const bf16_t*)(ws + WS_DS); const float* gn = p.in[10] + l * 128;
            for (int t = gw; t < 2048; t += NGW) { int ln = lane; asm volatile("" : "+v"(ln)); const int u = t >> 1; gla3_task<64>(act, ds, gn, u, (u >> 2) * 64, u & 3, t & 1, wl, ln); }
            for (int t = gw; t < 32; t += NGW) { int ln = lane; asm volatile("" : "+v"(ln)); gla3_task<32>(act, ds, gn, 1024 + t, SEQ + 32 * (t >> 2), t & 3, 0, wl, ln); }
            const bf16_t* pmt = (const bf16_t*)(ws + WS_PMT); const float* psc = p.in[12] + l * 512;
            for (int t = NGW - 1 - gw; t < 520 * 4; t += NGW) { int ln = lane; asm volatile("" : "+v"(ln)); const int tt = t >> 2, g = t & 3; const bool sm = tt >= 512;
                const int row0 = sm ? SEQ + 32 * (tt - 512) : 32 * tt, pos0 = sm ? 2048 : 32 * tt; const float* hist = sm ? p.in[2] + (size_t)((l * 8 + (tt - 512)) * 15) * 512 : nullptr;
                if (g == 0) pool_task<0>(act, hist, pmt, psc, row0, pos0, wl, ln); else if (g == 1) pool_task<1>(act, hist, pmt, psc, row0, pos0, wl, ln);
                else if (g == 2) pool_task<2>(act, hist, pmt, psc, row0, pos0, wl, ln); else pool_task<3>(act, hist, pmt, psc, row0, pos0, wl, ln); }
        } else if (sub == 4 && PHON(4)) {
            SchedMerge S{G, bx}; EpiMerge E{act, ss};
            for (int rep = 0; rep < REP_PC; ++rep) { int t2 = tid; asm volatile("" : "+v"(t2)); pg8::gemm_phase<EpiMerge, SchedMerge, true, APITCH, 1024>(lds, (const char*)ws, S, E, t2); }
            LAS float* red = (LAS float*)lds;
            for (int T = vcu; T < 256; T += G) { const int rb = T >> 4, cb = T & 15, row0 = SEQ + 16 * rb, col0 = 64 * cb, row = row0 + (tid >> 5), col = col0 + 2 * (tid & 31);
                const float rs = row_rstd_full(ss, row); f32x2 m2 = {0.f, 0.f};
#pragma unroll
                for (int g = 0; g < 3; ++g) { f32x4 acc[4]; const int yc = g == 0 ? C_YA : g == 1 ? C_YB : C_YC;
                    small_tile_partial<4>(act + (size_t)row0 * APITCH + C_XB, APITCH, wbase + W_G / 2 + (size_t)(g * 1024 + col0) * 1024, 1024, wave, lane, acc);
                    const f32x2 gv = small_tile_reduce(red, acc, wave, lane, tid);
                    small_tile_partial<2>(act + (size_t)row0 * APITCH + yc, APITCH, wbase + W_B / 2 + (size_t)(g * 1024 + col0) * 1024, 1024, wave, lane, acc);
                    const f32x2 bv = small_tile_reduce(red, acc, wave, lane, tid);
                    m2[0] += fast_sigmoid(gv[0] * rs) * bv[0]; m2[1] += fast_sigmoid(gv[1] * rs) * bv[1]; }
                *(unsigned*)(act + (size_t)row * APITCH + C_M + col) = pk2(m2[0], m2[1]); }
        } else if ((sub == 5 || sub == 7) && PHON(5)) {
            const bool fo = sub == 7;
            const float* resp = (l == 0 && !fo) ? p.in[0] : p.out;
            EpiRes E{resp, p.out, act, ss};
            if (!fo) { typedef SchedDense<64, 4, false, (unsigned)(WS_ACT + C_M * 2), (unsigned)(WS_W + W_O), 16, 2048u> SD; SD S{G, bx}; pg8::gemm_phase<EpiRes, SD, true, APITCH, 1024>(lds, (const char*)ws, S, E, tid); }
            else { typedef SchedDense<64, 4, false, (unsigned)(WS_ACT + C_HID * 2), (unsigned)(WS_W + W_FO), 44, 5632u> SF; SF S{G, bx}; pg8::gemm_phase<EpiRes, SF, true, APITCH, 2816>(lds, (const char*)ws, S, E, tid); }
            LAS float* red = (LAS float*)lds;
            for (int T = vcu; T < 256; T += G) { const int rb = T >> 4, cb = T & 15, row0 = SEQ + 16 * rb, col0 = 64 * cb, row = row0 + (tid >> 5), col = col0 + 2 * (tid & 31);
                f32x4 acc[4];
                if (!fo) small_tile_partial<4>(act + (size_t)row0 * APITCH + C_M, APITCH, wbase + W_O / 2 + (size_t)col0 * 1024, 1024, wave, lane, acc);
                else small_tile_partial<11>(act + (size_t)row0 * APITCH + C_HID, APITCH, wbase + W_FO / 2 + (size_t)col0 * 2816, 2816, wave, lane, acc);
                const f32x2 v = small_tile_reduce(red, acc, wave, lane, tid);
                const float* rp = (l == 0 && !fo) ? p.in[1] + (size_t)(row - SEQ) * DM + col : p.out + (size_t)row * DM + col;
                const f32x2 x = *(const f32x2*)rp + v; *(f32x2*)(p.out + (size_t)row * DM + col) = x;
                *(unsigned*)(act + (size_t)row * APITCH + C_XB + col) = pk2(x[0], x[1]);
                float q = x[0] * x[0] + x[1] * x[1];
#pragma unroll
                for (int o = 1; o < 32; o <<= 1) q += __shfl_xor(q, o);
                if ((tid & 31) == 0) ss[(size_t)row * 16 + cb] = q; }
        } else if (sub == 6 && PHON(6)) {
            typedef SchedDense<64, 22, true, (unsigned)(WS_ACT + C_XB * 2), (unsigned)(WS_W + W_FI), 16, 2048u> SE;
            SE S{G, bx}; EpiE E{act, ss};
            for (int rep = 0; rep < REP_PE; ++rep) { int t2 = tid; asm volatile("" : "+v"(t2)); pg8::gemm_phase<EpiE, SE, true, APITCH, 1024>(lds, (const char*)ws, S, E, t2); }
        } else if (sub == 8 && l == 0) { if (PHON(9)) for (int rep = 0; rep < REP_WCONV; ++rep) { int t2 = tid; asm volatile("" : "+v"(t2)); phase_wconv(p, 1, lds, t2, wave, t2 & 63, vcu, G); } }
        else if (sub == 8 && PHON(8)) {
            const float* fg = p.in[19]; const int gw = vcu * 8 + wave, NGW = G * 8;
            for (int m = gw; m < MROWS; m += NGW) { const float rs = row_rstd_full(ss, m); float* xr = p.out + (size_t)m * DM;
#pragma unroll
                for (int j = 0; j < 4; ++j) { const f32x4 v = *(const f32x4*)(xr + 256 * j + 4 * lane), g = *(const f32x4*)(fg + 256 * j + 4 * lane); *(f32x4*)(xr + 256 * j + 4 * lane) = v * rs * g; } }
        }
        if (ph + 1 < p.ph_hi) for (int rep = 0; rep < REP_BAR; ++rep) xcd_barrier(bar);
    }
}

extern "C" void kernel_launch(void* const* d_in, const int* in_sizes, int n_in, void* d_out, int out_size, void* d_ws, size_t ws_size, hipStream_t stream) {
    static int grid = 0;
    if (grid == 0) {
        if (n_in != 20 || out_size != (int)O_TOTAL || ws_size < WS_END) { fprintf(stderr, "kernel_launch: unexpected problem (n_in %d out %d ws %zu)\n", n_in, out_size, ws_size); grid = -1; return; }
        int dev = 0, cus = 0, per_cu = 0;
        if (hipGetDevice(&dev) != hipSuccess || hipDeviceGetAttribute(&cus, hipDeviceAttributeMultiprocessorCount, dev) != hipSuccess) { grid = -1; return; }
        if (hipFuncSetAttribute((const void*)mk_fwd, hipFuncAttributeMaxDynamicSharedMemorySize, LDS_BYTES) != hipSuccess) { fprintf(stderr, "kernel_launch: hipFuncSetAttribute failed\n"); grid = -1; return; }
        if (hipOccupancyMaxActiveBlocksPerMultiprocessor(&per_cu, (const void*)mk_fwd, 512, LDS_BYTES) != hipSuccess || per_cu < 1) { fprintf(stderr, "kernel_launch: occupancy query says %d\n", per_cu); per_cu = 1; }
        (void)hipGetLastError();
        grid = cus;
    }
    if (grid < 0) return;
    (void)hipMemsetAsync((char*)d_ws + WS_CTL, 0, CTL_BYTES, stream);
    Params a{};
    for (int i = 0; i < 20; ++i) a.in[i] = (const float*)d_in[i];
    a.out = (float*)d_out; a.ws = (unsigned char*)d_ws;
#if MK_ONE_LAUNCH
    a.ph_lo = 0; a.ph_hi = NPHASE;
    hipLaunchKernelGGL(mk_fwd, dim3(grid), dim3(512), LDS_BYTES, stream, a);
#else
    for (int ph = 0; ph < NPHASE; ++ph) { a.ph_lo = ph; a.ph_hi = ph + 1; hipLaunchKernelGGL(mk_fwd, dim3(grid), dim3(512), LDS_BYTES, stream, a); }
#endif
}
```

```cpp
#include <hip/hip_runtime.h>
#include <hip/hip_bf16.h>
#include <cstdio>
#include <cstdint>

#ifndef MK_ONE_LAUNCH
#define MK_ONE_LAUNCH 1
#endif
#ifndef PH_MASK
#define PH_MASK 0x3ff
#endif
#define PHON(i) (((PH_MASK) >> (i)) & 1)
#ifndef TS_MASK
#define TS_MASK 0
#endif
#ifndef TS_BLK
#define TS_BLK 0
#endif
#ifndef SEC_PH
#define SEC_PH 0
#endif
#ifndef TS_SEC
#define TS_SEC 0
#endif
#define TSEC_B(id) do { if (TS_SEC == (id) && blockIdx.x == TS_BLK && threadIdx.x == 0) *(volatile LAS unsigned long long*)(lds + LDS_MISC + 128) = __builtin_amdgcn_s_memrealtime(); } while (0)
#define TSEC_E(id) do { if (TS_SEC == (id) && blockIdx.x == TS_BLK && threadIdx.x == 0) { volatile LAS unsigned long long* w_ = (volatile LAS unsigned long long*)(lds + LDS_MISC + 128); w_[1] += __builtin_amdgcn_s_memrealtime() - w_[0]; } } while (0)
#ifndef DBG_SKIP
#define DBG_SKIP 0
#endif
#define DSKIP(b) ((DBG_SKIP & (b)) && l == 1)
#ifndef REP_WCONV
#define REP_WCONV 1
#endif
#ifndef REP_PA
#define REP_PA 1
#endif
#ifndef REP_PC
#define REP_PC 1
#endif
#ifndef REP_PE
#define REP_PE 1
#endif
#ifndef REP_BAR
#define REP_BAR 1
#endif

#define LAS __attribute__((address_space(3)))
#define GAS __attribute__((address_space(1)))
typedef unsigned short bf16_t;
typedef short bf16x8 __attribute__((ext_vector_type(8)));
typedef short s16x4 __attribute__((ext_vector_type(4)));
typedef float f32x4 __attribute__((ext_vector_type(4)));
typedef float f32x2 __attribute__((ext_vector_type(2)));
typedef float f32x16 __attribute__((ext_vector_type(16)));
typedef unsigned u32x4 __attribute__((ext_vector_type(4)));
typedef unsigned u32x2 __attribute__((ext_vector_type(2)));
typedef GAS unsigned gu32;

constexpr int DM = 1024, SEQ = 16384, NSB = 8, NST = 32, MROWS = SEQ + NSB * NST;
constexpr int NPAN = MROWS / 256;
constexpr int DIN = 6672, DFF = 2816;
constexpr float EPS = 1e-6f;
constexpr float LOG2E = 1.4426950408889634f;
constexpr int APITCH = 4864;
constexpr int C_UA = 0, C_QB = 512, C_KB = 768, C_VB = 1024, C_RB = 1536, C_Z = 2048, C_QC = 2304, C_KC = 2816, C_VC = 3328, C_XB = 3840;
constexpr int C_M = 0;
constexpr int C_YA = C_KC, C_YB = C_RB, C_YC = C_QC;
constexpr int C_HID = 0;
constexpr size_t MiB = 1u << 20;
constexpr size_t WS_CTL = 0, CTL_BYTES = 1 * MiB;
constexpr size_t WS_SS = 1 * MiB;
constexpr size_t WS_AN = 3 * MiB;
constexpr size_t WS_BIAS = 3 * MiB + 512 * 1024;
constexpr size_t WS_W2T = WS_BIAS + 16384;
constexpr size_t WS_PMT = WS_W2T + 16384;
constexpr size_t WS_W = 4 * MiB;
constexpr size_t W_IN = 0, W_G = W_IN + (size_t)3840 * 1024 * 2, W_B = W_G + (size_t)3072 * 1024 * 2, W_O = W_B + (size_t)3072 * 1024 * 2,
                 W_FI = W_O + (size_t)1024 * 1024 * 2, W_FO = W_FI + (size_t)5632 * 1024 * 2, W_END = W_FO + (size_t)1024 * 2816 * 2;
static_assert(W_END <= 38 * MiB, "weights");
constexpr size_t WS_KVS = 42 * MiB;
constexpr size_t WS_DS = 50 * MiB;
constexpr int NGU = 1024 + 32;
constexpr size_t WS_ACT = 67 * MiB;
constexpr size_t WS_G = WS_ACT + (size_t)MROWS * APITCH * 2;
constexpr int GSPLIT = 43 * 256;
constexpr size_t WS_END = WS_G + (size_t)(MROWS - GSPLIT) * 3072 * 2;
static_assert(WS_DS + (size_t)NGU * 16384 <= WS_ACT && WS_END <= 256 * MiB && (size_t)GSPLIT * 3072 * 2 <= (size_t)MROWS * DM * 4, "ws map");
constexpr size_t O_Y = 0, O_POOLP = 17039360, O_POOLS = 17054720, O_GLAP = 17177600, O_GLAS = 17243136, O_KP = 17767424, O_KS = 18291712, O_VP = 18553856, O_VS = 19078144, O_TOTAL = 19340288;
constexpr int RING_BYTES = 131072, LDS_BIAS = 131072, LDS_WSF = 131072 + 8448, LDS_MISC = 144 * 1024 - 256, LDS_BYTES = 147456;

struct Params {
    const float* in[20];
    float* out;
    unsigned char* ws;
    int ph_lo, ph_hi;
};

__device__ __forceinline__ unsigned f2bf(float f) { unsigned u = __builtin_bit_cast(unsigned, f); return (u + 0x7fffu + ((u >> 16) & 1u)) >> 16; }
__device__ __forceinline__ unsigned pk2(float lo, float hi) { typedef __bf16 b2 __attribute__((ext_vector_type(2))); f32x2 v = {lo, hi}; b2 b = __builtin_convertvector(v, b2); return __builtin_bit_cast(unsigned, b); }
__device__ __forceinline__ float bf2f(unsigned short h) { return __builtin_bit_cast(float, (unsigned)h << 16); }
__device__ __forceinline__ float bflo(unsigned w) { return __builtin_bit_cast(float, w << 16); }
__device__ __forceinline__ float bfhi(unsigned w) { return __builtin_bit_cast(float, w & 0xffff0000u); }
__device__ __forceinline__ bf16_t* g_row(float* out, unsigned char* ws, int row) { return row < GSPLIT ? (bf16_t*)out + (size_t)row * 3072 : (bf16_t*)(ws + WS_G) + (size_t)(row - GSPLIT) * 3072; }
__device__ __forceinline__ int crow(int r, int hi) { return (r & 3) + 8 * (r >> 2) + 4 * hi; }
__device__ __forceinline__ float fast_sigmoid(float x) { return __builtin_amdgcn_rcpf(1.0f + __builtin_amdgcn_exp2f(-x * LOG2E)); }
#define VM_WAIT() asm volatile("s_waitcnt vmcnt(0)" ::: "memory")
#define LGKM_WAIT() asm volatile("s_waitcnt lgkmcnt(0)" ::: "memory")
#define SBAR() __builtin_amdgcn_sched_barrier(0)
__device__ __forceinline__ s16x4 vtr(const LAS unsigned char* p) { typedef short v4 __attribute__((ext_vector_type(4))); return __builtin_bit_cast(s16x4, __builtin_amdgcn_ds_read_tr16_b64_v4i16((LAS v4*)p)); }
__device__ __forceinline__ bf16x8 cat8(s16x4 a, s16x4 b) { return (bf16x8){a[0], a[1], a[2], a[3], b[0], b[1], b[2], b[3]}; }
__device__ __forceinline__ void dma16(const void* gsrc, LAS unsigned char* dst) { __builtin_amdgcn_global_load_lds((const unsigned*)gsrc, (LAS unsigned*)dst, 16, 0, 0); }
__device__ __forceinline__ float row_rstd_full(const float* ss, int row) {
    const f32x4* p = (const f32x4*)(ss + (size_t)row * 16); f32x4 a = p[0], b = p[1], c = p[2], d = p[3];
    const float s = ((a[0] + a[1]) + (a[2] + a[3])) + ((b[0] + b[1]) + (b[2] + b[3])) + ((c[0] + c[1]) + (c[2] + c[3])) + ((d[0] + d[1]) + (d[2] + d[3]));
    return __builtin_amdgcn_rsqf(s * (1.0f / DM) + EPS);
}

namespace pg8 {
constexpr int BM = 256, BK = 64, HALF = 128, HTB = HALF * BK * 2, STAGE_BYTES = 8 * HTB, NXCD = 8, WGM = 8;
__host__ __device__ __forceinline__ int lds_byte(int r, int c) { const int st = (r >> 4) * 2 + (c >> 5), rr = r & 15, cc = c & 31, ob = rr * 64 + cc * 2; return st * 1024 + (ob ^ (((ob >> 9) & 1) << 5)); }
__host__ __device__ __forceinline__ void stage_rc(int b, int& R, int& C) { const int st = b / 1024, sb = b % 1024, swz = sb ^ (((sb >> 9) & 1) << 5); R = (st >> 1) * 16 + swz / 64; C = (st & 1) * 32 + (swz % 64) / 2; }
__host__ __device__ __forceinline__ int perm32(int rho) { const int n = rho >> 4, i = rho & 15; return 8 * (i >> 2) + 4 * n + (i & 3); }

struct Unit { unsigned A, B; int nt, pm, pn, kind; };
template <int nM, int nN, bool EXTRA>
__device__ __forceinline__ bool tile_of(int L, int& pm, int& pn) {
    constexpr int nwg = nM * nN; static_assert(nM % 8 == 0, "nM");
    if (L >= nwg) { if (EXTRA && L < nwg + nN) { pm = nM; pn = L - nwg; return true; } return false; }
    int wgid = L; { constexpr int q = nwg / NXCD, r = nwg % NXCD; const int xcd = wgid % NXCD, off = wgid / NXCD; wgid = (xcd < r ? xcd * (q + 1) : r * (q + 1) + (xcd - r) * q) + off; }
    constexpr int nig = WGM * nN; const int gid = wgid / nig, rem = wgid - gid * nig;
    pm = gid * WGM + (rem & (WGM - 1)); pn = rem / WGM; return true;
}

template <class Epi, class Sched, bool ALIGN_EPI, int lda, int ldb>
__device__ __forceinline__ void gemm_phase(LAS unsigned char* lds, const char* wsb, const Sched& S, const Epi& E, const int tid) {
    const int wid = __builtin_amdgcn_readfirstlane(tid >> 6), lane = tid & 63, wr = wid >> 2, wc = wid & 3, fr = lane & 15, fq = lane >> 4;
    unsigned voffA[2], voffB[2];
#pragma unroll
    for (int i = 0; i < 2; ++i) { int R, C; stage_rc(tid * 16 + i * 8192, R, C); const int Rb = Epi::PERM ? ((R & ~31) + perm32(R & 31)) : R;
        voffA[i] = (unsigned)(R * lda + C) * 2u; voffB[i] = (unsigned)(Rb * ldb + C) * 2u; }
    const size_t kstep = (size_t)(BK * 2);
    const size_t hstepA = (size_t)HALF * lda * 2, hstepB = (size_t)HALF * ldb * 2;
    const unsigned ldsw = (unsigned)wid * 1024u;
    const int aoff = lds_byte(wr * 64 + fr, fq * 8), boff = lds_byte(wc * 32 + fr, fq * 8);
#define PG8_SA(b, h) (((b) * 2 + (h)) * HTB)
#define PG8_SB(b, h) ((4 + (b) * 2 + (h)) * HTB)
#define PG8_STAGE(bufoff, gbase, voff) do { _Pragma("unroll") for (int _i = 0; _i < 2; ++_i) \
        __builtin_amdgcn_global_load_lds((const unsigned*)((const char*)(gbase) + (voff)[_i]), (LAS unsigned*)(lds + (bufoff) + ldsw + _i * 8192), 16, 0, 0); } while (0)
#define PG8_LDA(dst, b, h) do { _Pragma("unroll") for (int m = 0; m < 4; ++m) _Pragma("unroll") for (int k = 0; k < 2; ++k) dst[m][k] = *(const LAS bf16x8*)(lds + PG8_SA(b, h) + aoff + m * 2048 + k * 1024); } while (0)
#define PG8_LDB(dst, b, h) do { _Pragma("unroll") for (int n = 0; n < 2; ++n) _Pragma("unroll") for (int k = 0; k < 2; ++k) dst[n][k] = *(const LAS bf16x8*)(lds + PG8_SB(b, h) + boff + n * 2048 + k * 1024); } while (0)
#define PG8_MMA(ai, bj, At, Bt) do { __builtin_amdgcn_s_setprio(1); _Pragma("unroll") for (int m = 0; m < 4; ++m) _Pragma("unroll") for (int n = 0; n < 2; ++n) _Pragma("unroll") for (int k = 0; k < 2; ++k) \
        acc[ai][bj][m][n] = __builtin_amdgcn_mfma_f32_16x16x32_bf16(Bt[n][k], At[m][k], acc[ai][bj][m][n], 0, 0, 0); __builtin_amdgcn_s_setprio(0); } while (0)
#define PG8_WAIT_V(n) asm volatile("s_waitcnt vmcnt(" #n ")" ::: "memory")
#define PG8_WAIT_L(n) asm volatile("s_waitcnt lgkmcnt(" #n ")" ::: "memory")
#define PG8_BAR __builtin_amdgcn_s_barrier()
#define PG8_SCHED __builtin_amdgcn_sched_barrier(0)
    Unit cur, nxt; int ui = 0;
    if (!S.next(0, cur)) return;
    f32x4 acc[2][2][4][2];
#pragma unroll
    for (int a = 0; a < 2; ++a)
#pragma unroll
        for (int b = 0; b < 2; ++b)
#pragma unroll
            for (int m = 0; m < 4; ++m)
#pragma unroll
                for (int n = 0; n < 2; ++n) acc[a][b][m][n] = (f32x4){0.f, 0.f, 0.f, 0.f};
    bf16x8 At[4][2], B0[2][2], B1[2][2];
    const char* cA = wsb + cur.A; const char* cB = wsb + cur.B;
    PG8_STAGE(PG8_SB(0, 0), cB, voffB); PG8_STAGE(PG8_SB(0, 1), cB + hstepB, voffB); PG8_STAGE(PG8_SA(0, 0), cA, voffA); PG8_STAGE(PG8_SA(0, 1), cA + hstepA, voffA);
    if (wr == 1) PG8_BAR;
    PG8_WAIT_V(2); PG8_BAR;
    PG8_STAGE(PG8_SB(1, 0), cB + kstep, voffB); PG8_STAGE(PG8_SA(1, 0), cA + kstep, voffA); PG8_STAGE(PG8_SB(1, 1), cB + hstepB + kstep, voffB);
    PG8_WAIT_V(6); PG8_BAR;
    for (;;) {
        const bool has_next = S.next(ui + 1, nxt);
        const char* nA = has_next ? wsb + nxt.A : cA; const char* nB = has_next ? wsb + nxt.B : cB;
        const int nt = cur.nt;
        for (int t = 0; t < nt; t += 2) {
            const bool last = (t == nt - 2);
            const char* a1 = cA + (size_t)(t + 1) * kstep;
            const char* a2 = last ? nA : cA + (size_t)(t + 2) * kstep; const char* b2 = last ? nB : cB + (size_t)(t + 2) * kstep;
            const char* a3 = a2 + kstep; const char* b3 = b2 + kstep;
            PG8_LDB(B0, 0, 0); PG8_LDB(B1, 0, 1); PG8_SCHED; PG8_LDA(At, 0, 0); PG8_STAGE(PG8_SA(1, 1), a1 + hstepA, voffA);
            PG8_WAIT_V(8); PG8_WAIT_L(0); PG8_BAR; PG8_MMA(0, 0, At, B0); PG8_MMA(0, 1, At, B1); PG8_BAR; PG8_SCHED;
            PG8_LDA(At, 0, 1); PG8_STAGE(PG8_SB(0, 0), b2, voffB); PG8_STAGE(PG8_SB(0, 1), b2 + hstepB, voffB); PG8_STAGE(PG8_SA(0, 0), a2, voffA);
            PG8_WAIT_V(8); PG8_WAIT_L(0); PG8_BAR; PG8_MMA(1, 0, At, B0); PG8_MMA(1, 1, At, B1); PG8_BAR; PG8_SCHED;
            PG8_LDB(B0, 1, 0); PG8_LDB(B1, 1, 1); PG8_SCHED; PG8_LDA(At, 1, 0); PG8_STAGE(PG8_SA(0, 1), a2 + hstepA, voffA);
            PG8_WAIT_V(8); PG8_WAIT_L(0); PG8_BAR; PG8_MMA(0, 0, At, B0); PG8_MMA(0, 1, At, B1); PG8_BAR; PG8_SCHED;
            PG8_LDA(At, 1, 1); PG8_STAGE(PG8_SB(1, 0), b3, voffB); PG8_STAGE(PG8_SB(1, 1), b3 + hstepB, voffB); PG8_STAGE(PG8_SA(1, 0), a3, voffA);
            PG8_WAIT_V(8); PG8_WAIT_L(0); PG8_BAR; PG8_MMA(1, 0, At, B0); PG8_MMA(1, 1, At, B1); PG8_BAR; PG8_SCHED;
        }
        if constexpr (ALIGN_EPI) { if (wr == 0) PG8_BAR; }
        E(acc, cur, wr, wc, fr, fq);
        if (!has_next) break;
#pragma unroll
        for (int a = 0; a < 2; ++a)
#pragma unroll
            for (int b = 0; b < 2; ++b)
#pragma unroll
                for (int m = 0; m < 4; ++m)
#pragma unroll
                    for (int n = 0; n < 2; ++n) acc[a][b][m][n] = (f32x4){0.f, 0.f, 0.f, 0.f};
        cur = nxt; cA = nA; cB = nB; ++ui;
        if constexpr (ALIGN_EPI) { if (wr == 1) PG8_BAR; }
    }
    PG8_WAIT_V(0);
    if constexpr (!ALIGN_EPI) { if (wr == 0) PG8_BAR; }
    PG8_BAR;
#undef PG8_SA
#undef PG8_SB
#undef PG8_STAGE
#undef PG8_LDA
#undef PG8_LDB
#undef PG8_MMA
#undef PG8_WAIT_V
#undef PG8_WAIT_L
#undef PG8_BAR
#undef PG8_SCHED
}
}

using pg8::Unit;
template <int nM, int nN, bool EXTRA, unsigned ABASE, unsigned WBASE, int NT, unsigned WROWB>
struct SchedDense {
    int G, c;
    __device__ __forceinline__ bool next(int i, Unit& u) const {
        int pm, pn; if (!pg8::tile_of<nM, nN, EXTRA>(i * G + c, pm, pn)) return false;
        u.pm = pm; u.pn = pn; u.kind = 0; u.nt = NT; u.A = ABASE + (unsigned)pm * (256u * APITCH * 2u); u.B = WBASE + (unsigned)pn * (256u * WROWB); return true; }
};
struct SchedMerge {
    int G, c;
    __device__ __forceinline__ bool next(int i, Unit& u) const {
        const int su = i / 3, g = i - su * 3; int pm, pn; if (!pg8::tile_of<64, 4, false>(su * G + c, pm, pn)) return false;
        u.pm = pm; u.pn = pn; u.kind = g; u.nt = 8;
        const int yc = g == 0 ? C_YA : g == 1 ? C_YB : C_YC;
        u.A = (unsigned)WS_ACT + (unsigned)pm * (256u * APITCH * 2u) + yc * 2; u.B = (unsigned)(WS_W + W_B) + (unsigned)(g * 1024 + pn * 256) * 2048u;
        return true; }
};

__device__ __forceinline__ float row_rstd_q(const float* ss, int row, int fq) {
    const f32x4 a = *(const f32x4*)(ss + (size_t)row * 16 + 4 * fq); float s = (a[0] + a[1]) + (a[2] + a[3]);
    s += __shfl_xor(s, 16); s += __shfl_xor(s, 32); return __builtin_amdgcn_rsqf(s * (1.0f / DM) + EPS);
}
struct EpiA {
    static constexpr bool PERM = true;
    bf16_t* act; const float* ss; float* out; unsigned char* ws;
    __device__ __forceinline__ void operator()(const f32x4 (&acc)[2][2][4][2], const Unit& u, int wr, int wc, int fr, int fq) const {
        const int row0 = u.pm * 256 + wr * 64 + fr; const bool gate = u.pn >= 15; const int col0 = (gate ? u.pn - 15 : u.pn) * 256 + wc * 32 + 8 * fq;
        float rsv[2][4];
#pragma unroll
        for (int ai = 0; ai < 2; ++ai)
#pragma unroll
            for (int m = 0; m < 4; ++m) rsv[ai][m] = row_rstd_q(ss, row0 + ai * 128 + m * 16, fq);
#pragma unroll
        for (int ai = 0; ai < 2; ++ai)
#pragma unroll
            for (int m = 0; m < 4; ++m) { const int row = row0 + ai * 128 + m * 16; const float rs = rsv[ai][m]; bf16_t* rowp = (gate ? g_row(out, ws, row) : act + (size_t)row * APITCH) + col0;
#pragma unroll
                for (int bj = 0; bj < 2; ++bj) { f32x4 v0 = acc[ai][bj][m][0] * rs, v1 = acc[ai][bj][m][1] * rs;
                    if (gate) {
#pragma unroll
                        for (int e = 0; e < 4; ++e) { v0[e] = fast_sigmoid(v0[e]); v1[e] = fast_sigmoid(v1[e]); } }
                    u32x4 w; w.x = pk2(v0[0], v0[1]); w.y = pk2(v0[2], v0[3]); w.z = pk2(v1[0], v1[1]); w.w = pk2(v1[2], v1[3]); *(u32x4*)(rowp + bj * 128) = w; } }
    }
};
struct EpiE {
    static constexpr bool PERM = true;
    bf16_t* act; const float* ss;
    __device__ __forceinline__ void operator()(const f32x4 (&acc)[2][2][4][2], const Unit& u, int wr, int wc, int fr, int fq) const {
        const int row0 = u.pm * 256 + wr * 64 + fr, col0 = C_HID + u.pn * 128 + wc * 32 + 8 * fq;
        float rsv[2][4];
#pragma unroll
        for (int ai = 0; ai < 2; ++ai)
#pragma unroll
            for (int m = 0; m < 4; ++m) rsv[ai][m] = row_rstd_q(ss, row0 + ai * 128 + m * 16, fq);
#pragma unroll
        for (int ai = 0; ai < 2; ++ai)
#pragma unroll
            for (int m = 0; m < 4; ++m) { const int row = row0 + ai * 128 + m * 16; const float rs = rsv[ai][m];
                float h[8];
#pragma unroll
                for (int n = 0; n < 2; ++n)
#pragma unroll
                    for (int e = 0; e < 4; ++e) { const float a = acc[ai][0][m][n][e] * rs, g = acc[ai][1][m][n][e] * rs; h[n * 4 + e] = a * fast_sigmoid(a) * g; }
                u32x4 w; w.x = pk2(h[0], h[1]); w.y = pk2(h[2], h[3]); w.z = pk2(h[4], h[5]); w.w = pk2(h[6], h[7]); *(u32x4*)(act + (size_t)row * APITCH + col0) = w; }
    }
};
template <bool F32OUT>
struct EpiRes {
    static constexpr bool PERM = false;
    float* out; bf16_t* act; float* ss;
    __device__ __forceinline__ void operator()(const f32x4 (&acc)[2][2][4][2], const Unit& u, int wr, int wc, int fr, int fq) const {
        const int row0 = u.pm * 256 + wr * 64 + fr, col0 = u.pn * 256 + wc * 32 + 4 * fq;
#pragma unroll
        for (int ai = 0; ai < 2; ++ai) {
            u32x2 rv[4][2][2];
#pragma unroll
            for (int m = 0; m < 4; ++m)
#pragma unroll
                for (int bj = 0; bj < 2; ++bj)
#pragma unroll
                    for (int n = 0; n < 2; ++n) rv[m][bj][n] = *(const u32x2*)(act + (size_t)(row0 + ai * 128 + m * 16) * APITCH + C_XB + col0 + bj * 128 + n * 16);
            asm volatile("" ::: "memory");
#pragma unroll
            for (int m = 0; m < 4; ++m) { const int row = row0 + ai * 128 + m * 16; float q = 0.f;
#pragma unroll
                for (int bj = 0; bj < 2; ++bj)
#pragma unroll
                    for (int n = 0; n < 2; ++n) { const int c = col0 + bj * 128 + n * 16; const u32x2 r2 = rv[m][bj][n];
                        const f32x4 x = (f32x4){bflo(r2.x), bfhi(r2.x), bflo(r2.y), bfhi(r2.y)} + acc[ai][bj][m][n];
                        if (F32OUT) *(f32x4*)(out + (size_t)row * DM + c) = x;
                        q += (x[0] * x[0] + x[1] * x[1]) + (x[2] * x[2] + x[3] * x[3]);
                        u32x2 w; w.x = pk2(x[0], x[1]); w.y = pk2(x[2], x[3]); *(u32x2*)(act + (size_t)row * APITCH + C_XB + c) = w; }
                q += __shfl_xor(q, 16); q += __shfl_xor(q, 32);
                if (fq == 0) ss[(size_t)row * 16 + 4 * u.pn + wc] = q; }
            asm volatile("" ::: "memory");
        }
    }
};
struct EpiMerge {
    static constexpr bool PERM = true;
    bf16_t* act; float* out; unsigned char* ws;
    __device__ __forceinline__ void operator()(const f32x4 (&acc)[2][2][4][2], const Unit& u, int wr, int wc, int fr, int fq) const {
        const int row0 = u.pm * 256 + wr * 64 + fr, cin = wc * 32 + 8 * fq, gcol = u.kind * 1024 + u.pn * 256 + cin, mcol = C_M + u.pn * 256 + cin;
        const bool first = (u.kind == 0);
#pragma unroll
        for (int ai = 0; ai < 2; ++ai) {
            u32x4 gw[4][2], mo[4][2];
#pragma unroll
            for (int m = 0; m < 4; ++m)
#pragma unroll
                for (int bj = 0; bj < 2; ++bj) { const int row = row0 + ai * 128 + m * 16; gw[m][bj] = *(const u32x4*)(g_row(out, ws, row) + gcol + bj * 128);
                    mo[m][bj] = (u32x4){0u, 0u, 0u, 0u}; if (!first) mo[m][bj] = *(const u32x4*)(act + (size_t)row * APITCH + mcol + bj * 128); }
            asm volatile("" ::: "memory");
#pragma unroll
            for (int m = 0; m < 4; ++m) { bf16_t* rowp = act + (size_t)(row0 + ai * 128 + m * 16) * APITCH;
#pragma unroll
                for (int bj = 0; bj < 2; ++bj) { const u32x4 g4 = gw[m][bj], m4 = mo[m][bj];
                    const f32x4 a0 = acc[ai][bj][m][0], a1 = acc[ai][bj][m][1]; float r[8];
                    r[0] = a0[0] * bflo(g4.x) + bflo(m4.x); r[1] = a0[1] * bfhi(g4.x) + bfhi(m4.x); r[2] = a0[2] * bflo(g4.y) + bflo(m4.y); r[3] = a0[3] * bfhi(g4.y) + bfhi(m4.y);
                    r[4] = a1[0] * bflo(g4.z) + bflo(m4.z); r[5] = a1[1] * bfhi(g4.z) + bfhi(m4.z); r[6] = a1[2] * bflo(g4.w) + bflo(m4.w); r[7] = a1[3] * bfhi(g4.w) + bfhi(m4.w);
                    u32x4 w; w.x = pk2(r[0], r[1]); w.y = pk2(r[2], r[3]); w.z = pk2(r[4], r[5]); w.w = pk2(r[6], r[7]); *(u32x4*)(rowp + mcol + bj * 128) = w; } }
            asm volatile("" ::: "memory");
        }
    }
};

template <int KSTEPS>
__device__ __forceinline__ void small_tile_partial(const bf16_t* A, int lda, const bf16_t* Bt, int ldb, int wave, int lane, f32x4 (&acc)[4]) {
    const int kk0 = wave * KSTEPS * 32 + 8 * (lane >> 4); const bf16_t* ap = A + (size_t)(lane & 15) * lda + kk0; const bf16_t* bp = Bt + (size_t)(lane & 15) * ldb + kk0;
#pragma unroll
    for (int j = 0; j < 4; ++j) acc[j] = (f32x4){0.f, 0.f, 0.f, 0.f};
#pragma unroll
    for (int s = 0; s < KSTEPS; ++s) { const bf16x8 a = *(const bf16x8*)(ap + 32 * s);
#pragma unroll
        for (int j = 0; j < 4; ++j) { const bf16x8 b = *(const bf16x8*)(bp + (size_t)(16 * j) * ldb + 32 * s); acc[j] = __builtin_amdgcn_mfma_f32_16x16x32_bf16(a, b, acc[j], 0, 0, 0); } }
}
__device__ __forceinline__ f32x2 small_tile_reduce(LAS float* red, const f32x4 (&acc)[4], int wave, int lane, int tid) {
#pragma unroll
    for (int j = 0; j < 4; ++j)
#pragma unroll
        for (int r = 0; r < 4; ++r) red[(wave * 16 + 4 * (lane >> 4) + r) * 68 + 16 * j + (lane & 15)] = acc[j][r];
    __syncthreads();
    const int row = tid >> 5, c2 = 2 * (tid & 31); f32x2 s = {0.f, 0.f};
#pragma unroll
    for (int w = 0; w < 8; ++w) { const f32x2 v = *(const LAS f32x2*)(red + (w * 16 + row) * 68 + c2); s += v; }
    __syncthreads();
    return s;
}

__device__ __forceinline__ void small_tile_reduce3(LAS float* red, const f32x4 (&acc)[3][4], int wave, int lane, int tid, f32x2 (&out)[3]) {
#pragma unroll
    for (int g = 0; g < 3; ++g)
#pragma unroll
        for (int j = 0; j < 4; ++j)
#pragma unroll
            for (int r = 0; r < 4; ++r) red[g * 8704 + (wave * 16 + 4 * (lane >> 4) + r) * 68 + 16 * j + (lane & 15)] = acc[g][j][r];
    __syncthreads();
    const int row = tid >> 5, c2 = 2 * (tid & 31);
#pragma unroll
    for (int g = 0; g < 3; ++g) { f32x2 s = {0.f, 0.f};
#pragma unroll
        for (int w = 0; w < 8; ++w) { const f32x2 v = *(const LAS f32x2*)(red + g * 8704 + (w * 16 + row) * 68 + c2); s += v; }
        out[g] = s; }
    __syncthreads();
}

constexpr float ATT_THR = 8.0f;
template <bool SAMP>
__device__ __forceinline__ void attn_task(bf16_t* act, const bf16_t* kvs, int cb, int h, int qb0, LAS unsigned char* vbuf, LAS float* wsf, const LAS float* tab, int lane) {
    constexpr int NQB = 1;
    const int r32 = lane & 31, hi = lane >> 5;
    const int nt = SAMP ? 9 : ((cb < 8 ? cb : 8) + 1);
    const int qrow0 = SAMP ? SEQ + 32 * cb : 64 * cb + 32 * qb0;
    const int vp0 = ((lane >> 4) & 1) * 32 + (lane & 3) * 8 + (4 * hi + ((lane & 15) >> 2)) * 64;
    bf16x8 qr[NQB][4];
#pragma unroll
    for (int qb = 0; qb < NQB; ++qb)
#pragma unroll
        for (int j = 0; j < 4; ++j) qr[qb][j] = *(const bf16x8*)(act + (size_t)(qrow0 + 32 * qb + r32) * APITCH + C_QC + h * 64 + 16 * j + 8 * hi);
    float mhat[NQB], lsum[NQB]; f32x16 o[NQB][2];
#pragma unroll
    for (int qb = 0; qb < NQB; ++qb) { mhat[qb] = 0.f; lsum[qb] = 0.f;
#pragma unroll
        for (int r = 0; r < 16; ++r) { o[qb][0][r] = 0.f; o[qb][1][r] = 0.f; } }
    const float bconst = tab[256];
#define ATT_TILE(t, kp, vp, pitch) do { if (SAMP && (t) < 8) { const size_t off_ = ((size_t)(cb * 512 + 64 * (t)) * 512 + h * 64) * 2; kp = (const char*)kvs + off_; vp = (const char*)kvs + (size_t)8 * 512 * 512 * 2 + off_; pitch = 1024; } \
        else { const int row_ = SAMP ? SEQ + 32 * cb : 64 * (cb - (nt - 1) + (t)); kp = (const char*)(act + (size_t)row_ * APITCH + C_KC + h * 64); vp = (const char*)(act + (size_t)row_ * APITCH + C_VC + h * 64); pitch = (size_t)APITCH * 2; } } while (0)
#define ATT_VDMA(vp, pitch, buf) do { _Pragma("unroll") for (int p_ = 0; p_ < 8; ++p_) dma16((vp) + (size_t)(16 * (p_ & 3) + (lane >> 2)) * (pitch) + ((p_ >> 2) * 32 + (lane & 3) * 8) * 2, (buf) + p_ * 1024); } while (0)
#define ATT_KLOAD(kf, kp, pitch) do { _Pragma("unroll") for (int j_ = 0; j_ < 4; ++j_) { kf[2 * j_] = *(const bf16x8*)((kp) + (size_t)r32 * (pitch) + (16 * j_ + 8 * hi) * 2); kf[2 * j_ + 1] = *(const bf16x8*)((kp) + (size_t)(32 + r32) * (pitch) + (16 * j_ + 8 * hi) * 2); } } while (0)
    bf16x8 kf[8], kn[8];
    { const char* kp; const char* vp; size_t pitch; ATT_TILE(0, kp, vp, pitch); LGKM_WAIT(); ATT_VDMA(vp, pitch, vbuf); ATT_KLOAD(kn, kp, pitch); }
    for (int t = 0; t < nt; ++t) {
        const int delta = nt - 1 - t; const bool half = SAMP && (t == 8);
        LAS unsigned char* vcur = vbuf + (t & 1) * 8192;
        VM_WAIT();
#pragma unroll
        for (int j = 0; j < 8; ++j) kf[j] = kn[j];
        asm volatile("" ::: "memory");
        if (t + 1 < nt) { const char* kpn; const char* vpn; size_t pitchn; ATT_TILE(t + 1, kpn, vpn, pitchn); LGKM_WAIT(); ATT_VDMA(vpn, pitchn, vbuf + ((t + 1) & 1) * 8192); ATT_KLOAD(kn, kpn, pitchn); }
#pragma unroll
        for (int qb = 0; qb < NQB; ++qb) {
            f32x16 c0, c1;
            if (delta >= 3) { const float cbv = bconst - mhat[qb];
#pragma unroll
                for (int r = 0; r < 16; ++r) { c0[r] = cbv; c1[r] = cbv; } }
            else { const int base = 64 * delta + 32 * (qb0 + qb) + r32 + 128;
#pragma unroll
                for (int r = 0; r < 16; ++r) { const int i0 = base - crow(r, hi), i1 = i0 - 32; c0[r] = tab[i0 < 256 ? i0 : 256] - mhat[qb]; c1[r] = tab[i1 < 256 ? i1 : 256] - mhat[qb]; } }
#pragma unroll
            for (int j = 0; j < 4; ++j) { c0 = __builtin_amdgcn_mfma_f32_32x32x16_bf16(kf[2 * j], qr[qb][j], c0, 0, 0, 0); if (!half) c1 = __builtin_amdgcn_mfma_f32_32x32x16_bf16(kf[2 * j + 1], qr[qb][j], c1, 0, 0, 0); }
            float rm = c0[0];
#pragma unroll
            for (int r = 1; r < 16; ++r) rm = fmaxf(rm, c0[r]);
            if (!half) {
#pragma unroll
                for (int r = 0; r < 16; ++r) rm = fmaxf(rm, c1[r]); }
            rm = fmaxf(rm, __shfl_xor(rm, 32));
            if (t == 0) { mhat[qb] += rm;
#pragma unroll
                for (int r = 0; r < 16; ++r) { c0[r] -= rm; c1[r] -= rm; } }
            else if (__any(rm > ATT_THR)) { const float dl = fmaxf(rm, 0.f); mhat[qb] += dl;
#pragma unroll
                for (int r = 0; r < 16; ++r) { c0[r] -= dl; c1[r] -= dl; }
                const float f = __builtin_amdgcn_exp2f(-dl); lsum[qb] *= f; if (hi == 0) wsf[r32] = f;
#pragma unroll
                for (int r = 0; r < 16; ++r) { const float fr_ = wsf[crow(r, hi)]; o[qb][0][r] *= fr_; o[qb][1][r] *= fr_; } }
            float ps = 0.f;
#pragma unroll
            for (int r = 0; r < 16; ++r) { c0[r] = __builtin_amdgcn_exp2f(c0[r]); ps += c0[r]; }
            if (!half) {
#pragma unroll
                for (int r = 0; r < 16; ++r) { c1[r] = __builtin_amdgcn_exp2f(c1[r]); ps += c1[r]; } }
            lsum[qb] += ps;
            u32x4 pw[4];
            pw[0] = (u32x4){pk2(c0[0], c0[1]), pk2(c0[2], c0[3]), pk2(c0[4], c0[5]), pk2(c0[6], c0[7])};
            pw[1] = (u32x4){pk2(c0[8], c0[9]), pk2(c0[10], c0[11]), pk2(c0[12], c0[13]), pk2(c0[14], c0[15])};
            pw[2] = (u32x4){pk2(c1[0], c1[1]), pk2(c1[2], c1[3]), pk2(c1[4], c1[5]), pk2(c1[6], c1[7])};
            pw[3] = (u32x4){pk2(c1[8], c1[9]), pk2(c1[10], c1[11]), pk2(c1[12], c1[13]), pk2(c1[14], c1[15])};
#pragma unroll
            for (int d0 = 0; d0 < 2; ++d0)
#pragma unroll
                for (int ks = 0; ks < 4; ++ks) { if (half && ks >= 2) continue;
                    const bf16x8 vf = cat8(vtr(vcur + d0 * 4096 + ks * 1024 + vp0), vtr(vcur + d0 * 4096 + ks * 1024 + vp0 + 512));
                    o[qb][d0] = __builtin_amdgcn_mfma_f32_32x32x16_bf16(__builtin_bit_cast(bf16x8, pw[ks]), vf, o[qb][d0], 0, 0, 0); }
        }
    }
#undef ATT_TILE
#undef ATT_VDMA
#undef ATT_KLOAD
    LAS bf16_t* stg = (LAS bf16_t*)vbuf;
#pragma unroll
    for (int qb = 0; qb < NQB; ++qb) {
        float lt = lsum[qb]; lt += __shfl_xor(lt, 32);
        if (hi == 0) wsf[32 + r32] = lt;
#pragma unroll
        for (int r = 0; r < 16; ++r) { const float rl = __builtin_amdgcn_rcpf(wsf[32 + crow(r, hi)]); const int orow = crow(r, hi);
            stg[orow * 64 + r32] = (bf16_t)f2bf(o[qb][0][r] * rl); stg[orow * 64 + 32 + r32] = (bf16_t)f2bf(o[qb][1][r] * rl); }
#pragma unroll
        for (int i = 0; i < 4; ++i) { const int row = i * 8 + (lane >> 3), ch = lane & 7; const u32x4 v = *(const LAS u32x4*)(stg + row * 64 + ch * 8);
            *(u32x4*)(act + (size_t)(qrow0 + 32 * qb + row) * APITCH + C_YC + h * 64 + ch * 8) = v; }
        LGKM_WAIT();
    }
}

__device__ __forceinline__ void attn_unit_wg(bf16_t* act, int h, int c0, LAS unsigned char* ring, LAS unsigned char* stage, LAS float* wsf, const LAS float* tab, int wave, int lane) {
    const int r32 = lane & 31, hi = lane >> 5, pr = wave >> 1, qb0 = wave & 1;
    const int qrow0 = 64 * (c0 + pr) + 32 * qb0;
    const int vp0 = ((lane >> 4) & 1) * 32 + (lane & 3) * 8 + (4 * hi + ((lane & 15) >> 2)) * 64;
    bf16x8 qr[4];
#pragma unroll
    for (int j = 0; j < 4; ++j) qr[j] = *(const bf16x8*)(act + (size_t)(qrow0 + r32) * APITCH + C_QC + h * 64 + 16 * j + 8 * hi);
    float mhat = 0.f, lsum = 0.f; f32x16 o[2];
#pragma unroll
    for (int r = 0; r < 16; ++r) { o[0][r] = 0.f; o[1][r] = 0.f; }
    const float bconst = tab[256];
    const int smin = c0 >= 8 ? 0 : 8 - c0;
    const bf16_t* ksrc = act + (size_t)(64 * (c0 - 8) + lane) * APITCH + C_KC + h * 64 + wave * 8;
    const bf16_t* vsrc = act + (size_t)(64 * (c0 - 8) + 16 * (wave & 3) + (lane >> 2)) * APITCH + C_VC + h * 64 + (wave >> 2) * 32 + (lane & 3) * 8;
#define AW_DMA(s_) do { LAS unsigned char* sl_ = ring + ((s_) & 1) * 16384; dma16(ksrc + (size_t)(s_) * 64 * APITCH, sl_ + wave * 1024); dma16(vsrc + (size_t)(s_) * 64 * APITCH, sl_ + 8192 + wave * 1024); } while (0)
    asm volatile("s_waitcnt lgkmcnt(0)" ::: "memory"); __builtin_amdgcn_s_barrier();
    AW_DMA(smin);
    for (int s = smin; s < 12; ++s) {
        asm volatile("s_waitcnt vmcnt(0) lgkmcnt(0)" ::: "memory"); __builtin_amdgcn_s_barrier(); asm volatile("" ::: "memory");
        if (s + 1 < 12) AW_DMA(s + 1);
        if (s < pr || s > pr + 8) continue;
        const int delta = pr + 8 - s; const bool first = (s == (pr > smin ? pr : smin));
        const LAS unsigned char* kb = ring + (s & 1) * 16384 + hi * 1024 + r32 * 16; const LAS unsigned char* vcur = ring + (s & 1) * 16384 + 8192;
        f32x16 c0v, c1v;
        if (delta >= 3) { const float cbv = bconst - mhat;
#pragma unroll
            for (int r = 0; r < 16; ++r) { c0v[r] = cbv; c1v[r] = cbv; } }
        else { const int base = 64 * delta + 32 * qb0 + r32 + 128;
#pragma unroll
            for (int r = 0; r < 16; ++r) { const int i0 = base - crow(r, hi), i1 = i0 - 32; c0v[r] = tab[i0 < 256 ? i0 : 256] - mhat; c1v[r] = tab[i1 < 256 ? i1 : 256] - mhat; } }
#pragma unroll
        for (int j = 0; j < 4; ++j) { const bf16x8 k0 = *(const LAS bf16x8*)(kb + j * 2048), k1 = *(const LAS bf16x8*)(kb + j * 2048 + 512);
            c0v = __builtin_amdgcn_mfma_f32_32x32x16_bf16(k0, qr[j], c0v, 0, 0, 0); c1v = __builtin_amdgcn_mfma_f32_32x32x16_bf16(k1, qr[j], c1v, 0, 0, 0); }
        float rm = c0v[0];
#pragma unroll
        for (int r = 1; r < 16; ++r) rm = fmaxf(rm, c0v[r]);
#pragma unroll
        for (int r = 0; r < 16; ++r) rm = fmaxf(rm, c1v[r]);
        rm = fmaxf(rm, __shfl_xor(rm, 32));
        if (first) { mhat += rm;
#pragma unroll
            for (int r = 0; r < 16; ++r) { c0v[r] -= rm; c1v[r] -= rm; } }
        else if (__any(rm > ATT_THR)) { const float dl = fmaxf(rm, 0.f); mhat += dl;
#pragma unroll
            for (int r = 0; r < 16; ++r) { c0v[r] -= dl; c1v[r] -= dl; }
            const float f = __builtin_amdgcn_exp2f(-dl); lsum *= f; if (hi == 0) wsf[r32] = f;
#pragma unroll
            for (int r = 0; r < 16; ++r) { const float fr_ = wsf[crow(r, hi)]; o[0][r] *= fr_; o[1][r] *= fr_; } }
        float ps = 0.f;
#pragma unroll
        for (int r = 0; r < 16; ++r) { c0v[r] = __builtin_amdgcn_exp2f(c0v[r]); ps += c0v[r]; }
#pragma unroll
        for (int r = 0; r < 16; ++r) { c1v[r] = __builtin_amdgcn_exp2f(c1v[r]); ps += c1v[r]; }
        lsum += ps;
        u32x4 pw[4];
        pw[0] = (u32x4){pk2(c0v[0], c0v[1]), pk2(c0v[2], c0v[3]), pk2(c0v[4], c0v[5]), pk2(c0v[6], c0v[7])};
        pw[1] = (u32x4){pk2(c0v[8], c0v[9]), pk2(c0v[10], c0v[11]), pk2(c0v[12], c0v[13]), pk2(c0v[14], c0v[15])};
        pw[2] = (u32x4){pk2(c1v[0], c1v[1]), pk2(c1v[2], c1v[3]), pk2(c1v[4], c1v[5]), pk2(c1v[6], c1v[7])};
        pw[3] = (u32x4){pk2(c1v[8], c1v[9]), pk2(c1v[10], c1v[11]), pk2(c1v[12], c1v[13]), pk2(c1v[14], c1v[15])};
#pragma unroll
        for (int d0 = 0; d0 < 2; ++d0)
#pragma unroll
            for (int ks = 0; ks < 4; ++ks) { const bf16x8 vf = cat8(vtr(vcur + d0 * 4096 + ks * 1024 + vp0), vtr(vcur + d0 * 4096 + ks * 1024 + vp0 + 512));
                o[d0] = __builtin_amdgcn_mfma_f32_32x32x16_bf16(__builtin_bit_cast(bf16x8, pw[ks]), vf, o[d0], 0, 0, 0); }
    }
#undef AW_DMA
    LAS bf16_t* stg = (LAS bf16_t*)stage;
    float lt = lsum; lt += __shfl_xor(lt, 32);
    if (hi == 0) wsf[32 + r32] = lt;
#pragma unroll
    for (int r = 0; r < 16; ++r) { const float rl = __builtin_amdgcn_rcpf(wsf[32 + crow(r, hi)]); const int orow = crow(r, hi);
        stg[orow * 64 + r32] = (bf16_t)f2bf(o[0][r] * rl); stg[orow * 64 + 32 + r32] = (bf16_t)f2bf(o[1][r] * rl); }
#pragma unroll
    for (int i = 0; i < 4; ++i) { const int row = i * 8 + (lane >> 3), ch = lane & 7; const u32x4 v = *(const LAS u32x4*)(stg + row * 64 + ch * 8);
        *(u32x4*)(act + (size_t)(qrow0 + row) * APITCH + C_YC + h * 64 + ch * 8) = v; }
    LGKM_WAIT();
}

__device__ __forceinline__ void attn_sample_wg(bf16_t* act, const bf16_t* kvs, int b, int h, LAS unsigned char* lds, LAS float* wsfall, const LAS float* tab, int tid, int wave, int lane) {
    const int r32 = lane & 31, hi = lane >> 5;
    const int vp0 = ((lane >> 4) & 1) * 32 + (lane & 3) * 8 + (4 * hi + ((lane & 15) >> 2)) * 64;
    LAS unsigned char* vbuf = lds + wave * 16384; LAS float* po = (LAS float*)(lds + wave * 16384 + 8192); LAS float* ml = wsfall;
    const int qrow0 = SEQ + 32 * b;
    bf16x8 qr[4];
#pragma unroll
    for (int j = 0; j < 4; ++j) qr[j] = *(const bf16x8*)(act + (size_t)(qrow0 + r32) * APITCH + C_QC + h * 64 + 16 * j + 8 * hi);
    float mhat = 0.f, lsum = 0.f; f32x16 o[2];
#pragma unroll
    for (int r = 0; r < 16; ++r) { o[0][r] = 0.f; o[1][r] = 0.f; }
    const float bconst = tab[256];
    asm volatile("s_waitcnt lgkmcnt(0)" ::: "memory"); __builtin_amdgcn_s_barrier();
    for (int t = wave; t < 9; t += 8) {
        const bool half = (t == 8); const int delta = 8 - t;
        const char* kp; const char* vp; size_t pitch;
        if (t < 8) { const size_t off_ = ((size_t)(b * 512 + 64 * t) * 512 + h * 64) * 2; kp = (const char*)kvs + off_; vp = (const char*)kvs + (size_t)8 * 512 * 512 * 2 + off_; pitch = 1024; }
        else { kp = (const char*)(act + (size_t)qrow0 * APITCH + C_KC + h * 64); vp = (const char*)(act + (size_t)qrow0 * APITCH + C_VC + h * 64); pitch = (size_t)APITCH * 2; }
        LGKM_WAIT();
#pragma unroll
        for (int p_ = 0; p_ < 8; ++p_) dma16(vp + (size_t)(16 * (p_ & 3) + (lane >> 2)) * pitch + ((p_ >> 2) * 32 + (lane & 3) * 8) * 2, vbuf + p_ * 1024);
        bf16x8 kf[8];
#pragma unroll
        for (int j = 0; j < 4; ++j) { kf[2 * j] = *(const bf16x8*)(kp + (size_t)r32 * pitch + (16 * j + 8 * hi) * 2); kf[2 * j + 1] = *(const bf16x8*)(kp + (size_t)(32 + r32) * pitch + (16 * j + 8 * hi) * 2); }
        VM_WAIT();
        f32x16 c0v, c1v;
        if (delta >= 3) { const float cbv = bconst - mhat;
#pragma unroll
            for (int r = 0; r < 16; ++r) { c0v[r] = cbv; c1v[r] = cbv; } }
        else { const int base = 64 * delta + r32 + 128;
#pragma unroll
            for (int r = 0; r < 16; ++r) { const int i0 = base - crow(r, hi), i1 = i0 - 32; c0v[r] = tab[i0 < 256 ? i0 : 256] - mhat; c1v[r] = tab[i1 < 256 ? i1 : 256] - mhat; } }
#pragma unroll
        for (int j = 0; j < 4; ++j) { c0v = __builtin_amdgcn_mfma_f32_32x32x16_bf16(kf[2 * j], qr[j], c0v, 0, 0, 0); if (!half) c1v = __builtin_amdgcn_mfma_f32_32x32x16_bf16(kf[2 * j + 1], qr[j], c1v, 0, 0, 0); }
        float rm = c0v[0];
#pragma unroll
        for (int r = 1; r < 16; ++r) rm = fmaxf(rm, c0v[r]);
        if (!half) {
#pragma unroll
            for (int r = 0; r < 16; ++r) rm = fmaxf(rm, c1v[r]); }
        rm = fmaxf(rm, __shfl_xor(rm, 32));
        if (t == wave) { mhat += rm;
#pragma unroll
            for (int r = 0; r < 16; ++r) { c0v[r] -= rm; c1v[r] -= rm; } }
        else { const float dl = fmaxf(rm, 0.f); mhat += dl;
#pragma unroll
            for (int r = 0; r < 16; ++r) { c0v[r] -= dl; c1v[r] -= dl; }
            const float f = __builtin_amdgcn_exp2f(-dl); lsum *= f; if (hi == 0) ml[512 + r32] = f;
#pragma unroll
            for (int r = 0; r < 16; ++r) { const float fr_ = ml[512 + crow(r, hi)]; o[0][r] *= fr_; o[1][r] *= fr_; } }
        float ps = 0.f;
#pragma unroll
        for (int r = 0; r < 16; ++r) { c0v[r] = __builtin_amdgcn_exp2f(c0v[r]); ps += c0v[r]; }
        if (!half) {
#pragma unroll
            for (int r = 0; r < 16; ++r) { c1v[r] = __builtin_amdgcn_exp2f(c1v[r]); ps += c1v[r]; } }
        lsum += ps;
        u32x4 pw[4];
        pw[0] = (u32x4){pk2(c0v[0], c0v[1]), pk2(c0v[2], c0v[3]), pk2(c0v[4], c0v[5]), pk2(c0v[6], c0v[7])};
        pw[1] = (u32x4){pk2(c0v[8], c0v[9]), pk2(c0v[10], c0v[11]), pk2(c0v[12], c0v[13]), pk2(c0v[14], c0v[15])};
        pw[2] = (u32x4){pk2(c1v[0], c1v[1]), pk2(c1v[2], c1v[3]), pk2(c1v[4], c1v[5]), pk2(c1v[6], c1v[7])};
        pw[3] = (u32x4){pk2(c1v[8], c1v[9]), pk2(c1v[10], c1v[11]), pk2(c1v[12], c1v[13]), pk2(c1v[14], c1v[15])};
#pragma unroll
        for (int d0 = 0; d0 < 2; ++d0)
#pragma unroll
            for (int ks = 0; ks < 4; ++ks) { if (half && ks >= 2) continue;
                const bf16x8 vf = cat8(vtr(vbuf + d0 * 4096 + ks * 1024 + vp0), vtr(vbuf + d0 * 4096 + ks * 1024 + vp0 + 512));
                o[d0] = __builtin_amdgcn_mfma_f32_32x32x16_bf16(__builtin_bit_cast(bf16x8, pw[ks]), vf, o[d0], 0, 0, 0); }
    }
    { float lt = lsum; lt += __shfl_xor(lt, 32); if (hi == 0) { ml[(wave * 2) * 32 + r32] = mhat; ml[(wave * 2 + 1) * 32 + r32] = lt; }
#pragma unroll
        for (int r = 0; r < 16; ++r) { const int q = crow(r, hi); po[q * 64 + r32] = o[0][r]; po[q * 64 + 32 + r32] = o[1][r]; } }
    __syncthreads();
    { const int q = tid >> 4, d4 = (tid & 15) * 4; float M = ml[q];
#pragma unroll
        for (int w = 1; w < 8; ++w) M = fmaxf(M, ml[(w * 2) * 32 + q]);
        float L = 0.f; f32x4 acc = {0.f, 0.f, 0.f, 0.f};
#pragma unroll
        for (int w = 0; w < 8; ++w) { const float sc = __builtin_amdgcn_exp2f(ml[(w * 2) * 32 + q] - M); L += ml[(w * 2 + 1) * 32 + q] * sc; const f32x4 v = *(const LAS f32x4*)(lds + w * 16384 + 8192 + (q * 64 + d4) * 4); acc += v * sc; }
        const float rl = __builtin_amdgcn_rcpf(L);
        u32x2 wv; wv.x = pk2(acc[0] * rl, acc[1] * rl); wv.y = pk2(acc[2] * rl, acc[3] * rl);
        *(u32x2*)(act + (size_t)(qrow0 + q) * APITCH + C_YC + h * 64 + d4) = wv; }
}

__device__ __forceinline__ float log_sigmoid_f(float x) { const float ax = fabsf(x); return fminf(x, 0.f) - 0.6931471805599453f * __builtin_amdgcn_logf(1.0f + __builtin_amdgcn_exp2f(-ax * LOG2E)); }
template <int L>
__device__ __forceinline__ void gla1_unit(bf16_t* act, const bf16_t* w2t, const float* bgate, float* an, bf16_t* ds, int u, int tok0, int h, int parity, LAS unsigned char* lds, int tid, int wave, int lane, const float* s0  , float* sout  ) {
    constexpr int NTB = L / 32, NKS = L / 16;
    const int r32 = lane & 31, hi = lane >> 5;
    LAS float* Ep = (LAS float*)lds; LAS float* Em = (LAS float*)(lds + 16384); LAS unsigned char* kimg = lds + 32768; LAS unsigned char* vimg = lds + 40960 + parity * 16384; LAS float* totl = (LAS float*)(lds + 73728);
    const int vp0 = ((lane >> 4) & 1) * 32 + (lane & 3) * 8 + (4 * hi + ((lane & 15) >> 2)) * 64;
    TSEC_B(1); TSEC_B(5);
    float b[16]; const int tb = wave >> 1, db = wave & 1;
    const int tok2 = tid >> 3, c82 = tid & 7; bf16_t* qp = act + (size_t)(tok0 + tok2) * APITCH + C_QB + h * 64 + 8 * c82; bf16_t* kp = act + (size_t)(tok0 + tok2) * APITCH + C_KB + h * 64 + 8 * c82;
    u32x4 qv = (u32x4){0u, 0u, 0u, 0u}, kv = qv; if (tid < L * 8) { qv = *(const u32x4*)qp; kv = *(const u32x4*)kp; }
    if (wave < 2 * NTB) {
        const bf16x8 A = *(const bf16x8*)(act + (size_t)(tok0 + 32 * tb + r32) * APITCH + C_Z + 8 * hi);
        const bf16x8 B = *(const bf16x8*)(w2t + (h * 64 + 32 * db + r32) * 16 + 8 * hi);
        const float bg = bgate[h * 64 + 32 * db + r32]; f32x16 X;
#pragma unroll
        for (int r = 0; r < 16; ++r) X[r] = bg;
        X = __builtin_amdgcn_mfma_f32_32x32x16_bf16(A, B, X, 0, 0, 0);
        float la[16], seg[4], oth[4];
#pragma unroll
        for (int r = 0; r < 16; ++r) la[r] = log_sigmoid_f(X[r]) * 0.0625f;
#pragma unroll
        for (int q = 0; q < 4; ++q) { seg[q] = (la[4 * q] + la[4 * q + 1]) + (la[4 * q + 2] + la[4 * q + 3]); oth[q] = __shfl_xor(seg[q], 32); }
        float run = 0.f;
#pragma unroll
        for (int q = 0; q < 4; ++q) { float st = run + (hi ? oth[q] : 0.f);
#pragma unroll
            for (int i = 0; i < 4; ++i) { st += la[4 * q + i]; b[4 * q + i] = st; }
            run += seg[q] + oth[q]; }
        if (NTB == 2 && tb == 0 && hi == 0) totl[db * 32 + r32] = run;
    } else if (wave >= 4) {
        const int eb = wave - 4;
#pragma unroll
        for (int ks = 0; ks < NKS; ++ks) dma16(act + (size_t)(tok0 + 16 * ks + (lane >> 2)) * APITCH + C_VB + h * 128 + 32 * eb + (lane & 3) * 8, vimg + (eb * 4 + ks) * 1024);
        VM_WAIT();
    }
    __syncthreads();
    TSEC_E(1); TSEC_B(2);
    if (wave < 2 * NTB) {
        if (NTB == 2 && tb == 1) { const float carry = totl[db * 32 + r32];
#pragma unroll
            for (int r = 0; r < 16; ++r) b[r] += carry; }
#pragma unroll
        for (int r = 0; r < 16; ++r) { const int tok = 32 * tb + crow(r, hi); const float bl = b[r] * LOG2E; Ep[tok * 64 + 32 * db + r32] = __builtin_amdgcn_exp2f(bl); Em[tok * 64 + 32 * db + r32] = __builtin_amdgcn_exp2f(-bl); }
        if (tb == NTB - 1 && hi == 1) an[(size_t)u * 64 + 32 * db + r32] = __builtin_amdgcn_exp2f(b[15] * LOG2E);
    }
    __syncthreads();
    TSEC_E(2); TSEC_B(3);
    if (tid < L * 8) {
        const int tok = tok2, c8 = c82;
        const f32x4 e0 = *(const LAS f32x4*)(Ep + tok * 64 + 8 * c8), e1 = *(const LAS f32x4*)(Ep + tok * 64 + 8 * c8 + 4), m0 = *(const LAS f32x4*)(Em + tok * 64 + 8 * c8), m1 = *(const LAS f32x4*)(Em + tok * 64 + 8 * c8 + 4);
        u32x4 qo, ko;
        qo.x = pk2(bflo(qv.x) * e0[0], bfhi(qv.x) * e0[1]); qo.y = pk2(bflo(qv.y) * e0[2], bfhi(qv.y) * e0[3]); qo.z = pk2(bflo(qv.z) * e1[0], bfhi(qv.z) * e1[1]); qo.w = pk2(bflo(qv.w) * e1[2], bfhi(qv.w) * e1[3]);
        ko.x = pk2(bflo(kv.x) * m0[0], bfhi(kv.x) * m0[1]); ko.y = pk2(bflo(kv.y) * m0[2], bfhi(kv.y) * m0[3]); ko.z = pk2(bflo(kv.z) * m1[0], bfhi(kv.z) * m1[1]); ko.w = pk2(bflo(kv.w) * m1[2], bfhi(kv.w) * m1[3]);
        *(u32x4*)qp = qo; *(u32x4*)kp = ko;
        *(LAS u32x4*)(kimg + ((c8 >> 2) * 4 + (tok >> 4)) * 1024 + (tok & 15) * 64 + (c8 & 3) * 16) = ko;
    }
    __syncthreads();
    TSEC_E(3); TSEC_B(4);
    {
        const int eb = wave & 3, db2 = wave >> 2; f32x16 acc;
#pragma unroll
        for (int r = 0; r < 16; ++r) acc[r] = 0.f;
#pragma unroll
        for (int ks = 0; ks < NKS; ++ks) { const bf16x8 va = cat8(vtr(vimg + (eb * 4 + ks) * 1024 + vp0), vtr(vimg + (eb * 4 + ks) * 1024 + vp0 + 512));
            const bf16x8 kb = cat8(vtr(kimg + (db2 * 4 + ks) * 1024 + vp0), vtr(kimg + (db2 * 4 + ks) * 1024 + vp0 + 512));
            acc = __builtin_amdgcn_mfma_f32_32x32x16_bf16(va, kb, acc, 0, 0, 0); }
        bf16_t* dp = ds + (size_t)u * 8192 + 32 * db2 + r32;
        if (L == 32) {
            const int d = 32 * db2 + r32; const float a = Ep[(L - 1) * 64 + d]; float sv[16];
#pragma unroll
            for (int r = 0; r < 16; ++r) sv[r] = s0[(size_t)d * 128 + 32 * eb + crow(r, hi)];
#pragma unroll
            for (int r = 0; r < 16; ++r) { const int e = 32 * eb + crow(r, hi); dp[e * 64] = (bf16_t)f2bf(sv[r]); sout[(size_t)d * 128 + e] = a * (sv[r] + acc[r]); }
        } else {
#pragma unroll
            for (int r = 0; r < 16; ++r) dp[(32 * eb + crow(r, hi)) * 64] = (bf16_t)f2bf(acc[r]); }
    }
    TSEC_E(4); TSEC_E(5);
}
template <int L>
__device__ __forceinline__ void gla3_task(bf16_t* act, const bf16_t* ds, const float* gn, int u, int tok0, int h, int ib, LAS unsigned char* vimg, int lane) {
    constexpr int NKS = L / 16;
    const int r32 = lane & 31, hi = lane >> 5;
    const int vp0 = ((lane >> 4) & 1) * 32 + (lane & 3) * 8 + (4 * hi + ((lane & 15) >> 2)) * 64;
    LGKM_WAIT();
#pragma unroll
    for (int eb = 0; eb < 4; ++eb)
#pragma unroll
        for (int ks = 0; ks < NKS; ++ks) dma16(act + (size_t)(tok0 + 16 * ks + (lane >> 2)) * APITCH + C_VB + h * 128 + 32 * eb + (lane & 3) * 8, vimg + (eb * 4 + ks) * 1024);
    bf16x8 qf[4], sa[4][4], kfr[2][4];
#pragma unroll
    for (int s = 0; s < 4; ++s) qf[s] = *(const bf16x8*)(act + (size_t)(tok0 + 32 * ib + r32) * APITCH + C_QB + h * 64 + 16 * s + 8 * hi);
    const bf16_t* sg = ds + (size_t)u * 8192;
#pragma unroll
    for (int eb = 0; eb < 4; ++eb)
#pragma unroll
        for (int s = 0; s < 4; ++s) sa[eb][s] = *(const bf16x8*)(sg + (32 * eb + r32) * 64 + 16 * s + 8 * hi);
#pragma unroll
    for (int jb = 0; jb < 2; ++jb)
#pragma unroll
        for (int s = 0; s < 4; ++s) kfr[jb][s] = *(const bf16x8*)(act + (size_t)(tok0 + 32 * (jb <= ib ? jb : 0) + r32) * APITCH + C_KB + h * 64 + 16 * s + 8 * hi);
    VM_WAIT();
    f32x16 acc[4];
#pragma unroll
    for (int eb = 0; eb < 4; ++eb)
#pragma unroll
        for (int r = 0; r < 16; ++r) acc[eb][r] = 0.f;
#pragma unroll
    for (int eb = 0; eb < 4; ++eb)
#pragma unroll
        for (int s = 0; s < 4; ++s) acc[eb] = __builtin_amdgcn_mfma_f32_32x32x16_bf16(sa[eb][s], qf[s], acc[eb], 0, 0, 0);
    bf16_t* rowp = act + (size_t)(tok0 + 32 * ib + r32) * APITCH + C_RB + h * 128;
    u32x2 rv[4][4]; f32x4 gv[4][4];
#pragma unroll
    for (int eb = 0; eb < 4; ++eb)
#pragma unroll
        for (int q = 0; q < 4; ++q) { const int e0 = 32 * eb + 8 * q + 4 * hi; rv[eb][q] = *(const u32x2*)(rowp + e0); gv[eb][q] = *(const f32x4*)(gn + e0); }
#pragma unroll
    for (int jb = 0; jb < 2; ++jb) {
        if (jb > ib) break;
        f32x16 X;
#pragma unroll
        for (int r = 0; r < 16; ++r) X[r] = 0.f;
#pragma unroll
        for (int s = 0; s < 4; ++s) X = __builtin_amdgcn_mfma_f32_32x32x16_bf16(kfr[jb][s], qf[s], X, 0, 0, 0);
        if (jb == ib) {
#pragma unroll
            for (int r = 0; r < 16; ++r) if (crow(r, hi) > r32) X[r] = 0.f; }
        const u32x4 x0 = (u32x4){pk2(X[0], X[1]), pk2(X[2], X[3]), pk2(X[4], X[5]), pk2(X[6], X[7])}, x1 = (u32x4){pk2(X[8], X[9]), pk2(X[10], X[11]), pk2(X[12], X[13]), pk2(X[14], X[15])};
#pragma unroll
        for (int eb = 0; eb < 4; ++eb)
#pragma unroll
            for (int s2 = 0; s2 < 2; ++s2) { const int ks = 2 * jb + s2; const bf16x8 vf = cat8(vtr(vimg + (eb * 4 + ks) * 1024 + vp0), vtr(vimg + (eb * 4 + ks) * 1024 + vp0 + 512));
                acc[eb] = __builtin_amdgcn_mfma_f32_32x32x16_bf16(vf, __builtin_bit_cast(bf16x8, s2 ? x1 : x0), acc[eb], 0, 0, 0); }
    }
    float ssq = 0.f;
#pragma unroll
    for (int eb = 0; eb < 4; ++eb)
#pragma unroll
        for (int r = 0; r < 16; ++r) ssq += acc[eb][r] * acc[eb][r];
    ssq += __shfl_xor(ssq, 32);
    const float rs = __builtin_amdgcn_rsqf(ssq * (1.0f / 128.0f) + EPS);
#pragma unroll
    for (int eb = 0; eb < 4; ++eb)
#pragma unroll
        for (int q = 0; q < 4; ++q) { const int e0 = 32 * eb + 8 * q + 4 * hi; const f32x4 g = gv[eb][q];
            const float r0 = bflo(rv[eb][q].x), r1 = bfhi(rv[eb][q].x), r2 = bflo(rv[eb][q].y), r3 = bfhi(rv[eb][q].y);
            u32x2 w; w.x = pk2(acc[eb][4 * q] * rs * g[0] * r0 * fast_sigmoid(r0), acc[eb][4 * q + 1] * rs * g[1] * r1 * fast_sigmoid(r1));
            w.y = pk2(acc[eb][4 * q + 2] * rs * g[2] * r2 * fast_sigmoid(r2), acc[eb][4 * q + 3] * rs * g[3] * r3 * fast_sigmoid(r3)); *(u32x2*)(rowp + e0) = w; }
}

template <int GI>
__device__ __forceinline__ void pool_task(bf16_t* act, const float* hist  , const bf16_t* pmt, const float* pscale, int row0, int pos0, LAS unsigned char* ptile, int lane) {
    constexpr int W = 2 << GI;
    const int r32 = lane & 31, hi = lane >> 5;
    const int col = 128 * GI + 2 * lane;
    f32x2 uv[W - 1 + 32];
    if (hist != nullptr) {
#pragma unroll
        for (int j = 0; j < W - 1; ++j) uv[j] = *(const f32x2*)(hist + (size_t)(15 + j - (W - 1)) * 512 + col);
    } else {
        unsigned hw[W - 1];
#pragma unroll
        for (int j = 0; j < W - 1; ++j) { const int r = row0 + j - (W - 1); hw[j] = *(const unsigned*)(act + (size_t)(r < 0 ? 0 : r) * APITCH + C_UA + col); }
#pragma unroll
        for (int j = 0; j < W - 1; ++j) { const bool ok = row0 + j - (W - 1) >= 0; uv[j] = (f32x2){ok ? bflo(hw[j]) : 0.f, ok ? bfhi(hw[j]) : 0.f}; }
    }
    {
        unsigned cw[32];
#pragma unroll
        for (int t = 0; t < 32; ++t) cw[t] = *(const unsigned*)(act + (size_t)(row0 + t) * APITCH + C_UA + col);
#pragma unroll
        for (int t = 0; t < 32; ++t) uv[W - 1 + t] = (f32x2){bflo(cw[t]), bfhi(cw[t])};
    }
    f32x2 sum = {0.f, 0.f};
#pragma unroll
    for (int j = 0; j < W - 1; ++j) sum += uv[j];
    LGKM_WAIT();
#pragma unroll
    for (int t = 0; t < 32; ++t) { sum += uv[t + W - 1]; const int pos = pos0 + t; const float inv = 1.0f / (float)(pos + 1 < W ? pos + 1 : W);
        const f32x2 p = sum * inv - uv[t + W - 1]; *(LAS unsigned*)(ptile + (t * 136 + 2 * lane) * 2) = pk2(p[0], p[1]); sum -= uv[t]; }
    f32x16 acc[4];
#pragma unroll
    for (int db = 0; db < 4; ++db)
#pragma unroll
        for (int r = 0; r < 16; ++r) acc[db][r] = 0.f;
#pragma unroll
    for (int sh = 0; sh < 2; ++sh) {
        bf16x8 mf[4][4];
#pragma unroll
        for (int s = 0; s < 4; ++s)
#pragma unroll
            for (int db = 0; db < 4; ++db) mf[s][db] = *(const bf16x8*)(pmt + (size_t)GI * 16384 + (32 * db + r32) * 128 + 16 * (4 * sh + s) + 8 * hi);
        asm volatile("" ::: "memory");
#pragma unroll
        for (int s = 0; s < 4; ++s) { const bf16x8 pf = *(const LAS bf16x8*)(ptile + (r32 * 136 + 16 * (4 * sh + s) + 8 * hi) * 2);
#pragma unroll
            for (int db = 0; db < 4; ++db) acc[db] = __builtin_amdgcn_mfma_f32_32x32x16_bf16(mf[s][db], pf, acc[db], 0, 0, 0); }
    }
    bf16_t* rowp = act + (size_t)(row0 + r32) * APITCH + C_YA + 128 * GI;
    f32x4 sc[4][4];
#pragma unroll
    for (int db = 0; db < 4; ++db)
#pragma unroll
        for (int q = 0; q < 4; ++q) sc[db][q] = *(const f32x4*)(pscale + 128 * GI + 32 * db + 8 * q + 4 * hi);
#pragma unroll
    for (int db = 0; db < 4; ++db)
#pragma unroll
        for (int q = 0; q < 4; ++q) { const int d0 = 32 * db + 8 * q + 4 * hi;
            u32x2 w; w.x = pk2(acc[db][4 * q] * sc[db][q][0], acc[db][4 * q + 1] * sc[db][q][1]); w.y = pk2(acc[db][4 * q + 2] * sc[db][q][2], acc[db][4 * q + 3] * sc[db][q][3]); *(u32x2*)(rowp + d0) = w; }
}

#define XB_TMO      128
#define XB_XCNT(j)  (256  + 64 * (j))
#define XB_XSUB(j)  (1280 + 64 * (j))
#define XB_XGEN(j)  (2304 + 64 * (j))
#define XB_TOP      3328
#define XB_TOPGEN   3392
#define XCD_BAR_WORDS 3456
#define XB_SPIN_CAP (1u << 22)
__device__ __forceinline__ unsigned xb_ld(unsigned* p)              { return __hip_atomic_load(p, __ATOMIC_RELAXED, __HIP_MEMORY_SCOPE_AGENT); }
__device__ __forceinline__ unsigned xb_add(unsigned* p, unsigned v) { return __hip_atomic_fetch_add(p, v, __ATOMIC_RELAXED, __HIP_MEMORY_SCOPE_AGENT); }
__device__ __forceinline__ unsigned xb_xcc_id() { return (unsigned)__builtin_amdgcn_s_getreg((3 << 11) | 20) & 0xFu; }
#define XB_SPIN(cond, bar) do { unsigned _sp = 0; while (cond) { __builtin_amdgcn_s_sleep(1); \
    if ((++_sp & 255u) == 0u) { if (xb_ld(&(bar)[XB_TMO])) break; if (_sp > XB_SPIN_CAP) { atomicAdd(&(bar)[XB_TMO], 1u); break; } } } } while (0)
struct XcdBarrier { unsigned* bar; unsigned x; volatile LAS unsigned* st; };
__device__ __forceinline__ XcdBarrier xcd_barrier_post(unsigned* bar, volatile LAS unsigned* st) {
    XcdBarrier b; b.bar = bar; b.x = xb_xcc_id(); b.st = st;
    if (threadIdx.x == 0) (void)xb_add(&bar[XB_XCNT(b.x)], 1u);
    return b;
}
__device__ __forceinline__ void xcd_barrier_complete(unsigned* bar, unsigned x, unsigned& nloc, unsigned& nx) {
    const unsigned G = gridDim.x * gridDim.y * gridDim.z;
    unsigned sum, cnt, mine, sp = 0u;
    for (;;) {
        sum = 0u; cnt = 0u; mine = 0u;
#pragma unroll
        for (unsigned j = 0; j < 16; ++j) { const unsigned c = xb_ld(&bar[XB_XCNT(j)]); sum += c; cnt += (c > 0u) ? 1u : 0u; mine = (j == x) ? c : mine; }
        if (sum == G) break;
        __builtin_amdgcn_s_sleep(1);
        if ((++sp & 255u) == 0u) { if (xb_ld(&bar[XB_TMO])) break; if (sp > XB_SPIN_CAP) { atomicAdd(&bar[XB_TMO], 1u); break; } }
    }
    nloc = mine > 0u ? mine : 1u; nx = cnt > 0u ? cnt : 1u;
}
__device__ __forceinline__ void xcd_barrier(const XcdBarrier& b) {
    asm volatile("s_waitcnt vmcnt(0)" ::: "memory");
    __syncthreads();
    if (threadIdx.x == 0) {
        unsigned* bar = b.bar;
        __builtin_amdgcn_s_waitcnt(0);
        unsigned nloc = b.st[0], nx = b.st[1];
        if (nloc == 0u) { xcd_barrier_complete(bar, b.x, nloc, nx); b.st[0] = nloc; b.st[1] = nx; }
        const unsigned old = xb_add(&bar[XB_XSUB(b.x)], 1u);
        const unsigned gen = old / nloc;
        if (old + 1u == (gen + 1u) * nloc) {
            __builtin_amdgcn_fence(__ATOMIC_RELEASE, "agent");
            asm volatile("s_waitcnt vmcnt(0)" ::: "memory");
            const unsigned og = xb_add(&bar[XB_TOP], 1u);
            const unsigned tg = og / nx;
            if (og + 1u == (tg + 1u) * nx) xb_add(&bar[XB_TOPGEN], 1u);
            else XB_SPIN(xb_ld(&bar[XB_TOPGEN]) == tg, bar);
            __builtin_amdgcn_fence(__ATOMIC_ACQUIRE, "agent");
            xb_add(&bar[XB_XGEN(b.x)], 1u);
            asm volatile("s_waitcnt vmcnt(0)" ::: "memory");
        } else {
            XB_SPIN(xb_ld(&bar[XB_XGEN(b.x)]) == gen, bar);
            __builtin_amdgcn_fence(__ATOMIC_ACQUIRE, "agent");
            asm volatile("s_waitcnt vmcnt(0)" ::: "memory");
        }
    }
    __syncthreads();
}

__device__ __forceinline__ float wave_sum(float v) {
#pragma unroll
    for (int o = 1; o < 64; o <<= 1) v += __shfl_xor(v, o);
    return v;
}
__device__ __forceinline__ int src_col(int sel, int n) {
    if (sel == 1) return n < 2064 ? n : (n < 2304 ? -1 : n - 240);
    if (sel == 2) { const int pn = n >> 8, jj = n & 255; return jj < 128 ? 128 * pn + jj : 2816 + 128 * pn + (jj - 128); }
    return n;
}
__device__ __forceinline__ void tr_item(const float* W, int ldw, int sel, int coff, const float* gain, bf16_t* WT, int dpitch, int kb, int nb, LAS float* scr, int lane) {
    const int k0 = 64 * kb, n0 = 32 * nb, n4 = lane & 7, kr = lane >> 3;
    int sc[4];
#pragma unroll
    for (int e = 0; e < 4; ++e) sc[e] = src_col(sel, n0 + 4 * n4 + e);
    const bool vec = (sc[0] >= 0) && (sc[3] == sc[0] + 3) && (((coff + sc[0]) & 3) == 0) && ((ldw & 3) == 0);
    f32x4 v[8];
#pragma unroll
    for (int i = 0; i < 8; ++i) { const int kk = 8 * i + kr; const float* rp = W + (size_t)(k0 + kk) * ldw + coff;
        if (vec) v[i] = *(const f32x4*)(rp + sc[0]);
        else {
#pragma unroll
            for (int e = 0; e < 4; ++e) v[i][e] = sc[e] >= 0 ? rp[sc[e]] : 0.f; } }
    LGKM_WAIT();
#pragma unroll
    for (int i = 0; i < 8; ++i) { const int kk = 8 * i + kr; const float g = gain ? gain[k0 + kk] : 1.f;
#pragma unroll
        for (int e = 0; e < 4; ++e) scr[kk * 33 + 4 * n4 + e] = v[i][e] * g; }
    LGKM_WAIT(); asm volatile("" ::: "memory");
    const int c = lane & 7;
#pragma unroll
    for (int j = 0; j < 4; ++j) { const int n = (lane >> 3) + 8 * j; const LAS float* s = scr + (8 * c) * 33 + n; const int dn = n0 + n;
        float rsc = 1.f; if (sel == 1) rsc = (dn >= 512 && dn < 768) ? 0.125f : ((dn >= 2304 && dn < 2816) ? 0.125f * LOG2E : 1.f);
        u32x4 o; o.x = pk2(s[0 * 33] * rsc, s[1 * 33] * rsc); o.y = pk2(s[2 * 33] * rsc, s[3 * 33] * rsc); o.z = pk2(s[4 * 33] * rsc, s[5 * 33] * rsc); o.w = pk2(s[6 * 33] * rsc, s[7 * 33] * rsc);
        *(u32x4*)(WT + (size_t)dn * dpitch + k0 + 8 * c) = o; }
    LGKM_WAIT(); asm volatile("" ::: "memory");
}
__device__ __forceinline__ void phase_wconv(const Params& p, int l, LAS unsigned char* lds, int tid, int wave, int lane, int vcu, int G) {
    LAS float* scr = (LAS float*)(lds + wave * 16384);
    unsigned char* ws = p.ws; bf16_t* wbase = (bf16_t*)(ws + WS_W);
    const int gw = vcu * 8 + wave, NGW = G * 8;
    const float* w_in = p.in[7] + (size_t)l * DM * DIN; const float* ang = p.in[6] + l * DM; const float* fng = p.in[16] + l * DM;
    constexpr int I0 = 120 * 16, I1 = 96 * 16, I2 = 3 * 32 * 8, I3 = 32 * 16, I4 = 176 * 16, I5 = 32 * 44, I6 = 4 * 4 * 2, NIT = I0 + I1 + I2 + I3 + I4 + I5 + I6;
    for (int it = gw; it < NIT; it += NGW) {
        int r = it;
        if (r < I0) { tr_item(w_in, DIN, 1, 0, ang, wbase + W_IN / 2, 1024, r % 16, r / 16, scr, lane); continue; } r -= I0;
        if (r < I1) { tr_item(w_in, DIN, 0, 3600, ang, wbase + W_G / 2, 1024, r % 16, r / 16, scr, lane); continue; } r -= I1;
        if (r < I2) { const int g = r / 256, rr = r % 256; tr_item(p.in[14] + (size_t)(l * 3 + g) * 512 * 1024, 1024, 0, 0, nullptr, wbase + W_B / 2 + (size_t)g * 1024 * 1024, 1024, rr % 8, rr / 8, scr, lane); continue; } r -= I2;
        if (r < I3) { tr_item(p.in[15] + (size_t)l * 1024 * 1024, 1024, 0, 0, nullptr, wbase + W_O / 2, 1024, r % 16, r / 16, scr, lane); continue; } r -= I3;
        if (r < I4) { tr_item(p.in[17] + (size_t)l * 1024 * 5632, 5632, 2, 0, fng, wbase + W_FI / 2, 1024, r % 16, r / 16, scr, lane); continue; } r -= I4;
        if (r < I5) { tr_item(p.in[18] + (size_t)l * 2816 * 1024, 1024, 0, 0, nullptr, wbase + W_FO / 2, 2816, r % 44, r / 44, scr, lane); continue; } r -= I5;
        { const int g = r / 8, rr = r % 8; tr_item(p.in[11] + (size_t)(l * 4 + g) * 128 * 128, 128, 0, 0, nullptr, (bf16_t*)(ws + WS_PMT) + (size_t)g * 16384, 128, rr % 2, rr / 2, scr, lane); }
    }
    const int gt = vcu * 512 + tid, NGT = G * 512;
    for (int i = gt; i < 4096; i += NGT) { const int col = i >> 4, k = i & 15; ((bf16_t*)(ws + WS_W2T))[i] = (bf16_t)f2bf(p.in[8][(size_t)l * 16 * 256 + k * 256 + col]); }
    for (int i = gt; i < 8 * 260; i += NGT) { const int h = i / 260, j = i % 260; ((float*)(ws + WS_BIAS))[i] = j < 257 ? p.in[13][(size_t)(l * 8 + h) * 257 + j] * LOG2E : 0.f; }
    { const float* ck = p.in[4] + (size_t)l * 2097152; const float* cv = p.in[5] + (size_t)l * 2097152; bf16_t* kd = (bf16_t*)(ws + WS_KVS);
        for (int i = gt; i < 2 * 262144; i += NGT) { const int which = i >= 262144, j = which ? i - 262144 : i; const float* s = (which ? cv : ck) + (size_t)j * 8; const f32x4 a = *(const f32x4*)s, b = *(const f32x4*)(s + 4);
            u32x4 o; o.x = pk2(a[0], a[1]); o.y = pk2(a[2], a[3]); o.z = pk2(b[0], b[1]); o.w = pk2(b[2], b[3]); *(u32x4*)(kd + (size_t)which * 2097152 + (size_t)j * 8) = o; } }
    if (l == 0) {
        bf16_t* act = (bf16_t*)(ws + WS_ACT); float* ss = (float*)(ws + WS_SS);
        for (int m = gw; m < MROWS; m += NGW) { const float* xr = m < SEQ ? p.in[0] + (size_t)m * DM : p.in[1] + (size_t)(m - SEQ) * DM; float q = 0.f;
#pragma unroll
            for (int j = 0; j < 4; ++j) { const f32x4 v = *(const f32x4*)(xr + 256 * j + 4 * lane); q += (v[0] * v[0] + v[1] * v[1]) + (v[2] * v[2] + v[3] * v[3]);
                u32x2 w; w.x = pk2(v[0], v[1]); w.y = pk2(v[2], v[3]); *(u32x2*)(act + (size_t)m * APITCH + C_XB + 256 * j + 4 * lane) = w; }
            q = wave_sum(q); if (lane < 16) ss[(size_t)m * 16 + lane] = lane == 0 ? q : 0.f; }
    }
}

__device__ __forceinline__ void phase_scan(const Params& p, int l, LAS unsigned char* lds, int tid, int vcu, int G) {
    unsigned char* ws = p.ws; bf16_t* ds = (bf16_t*)(ws + WS_DS); const float* an = (const float*)(ws + WS_AN);
    LAS float* xa = (LAS float*)lds;
    LAS float* xb = xa + 512;
    for (int blk = vcu; blk < 512; blk += G) {
        const int seg = tid >> 6, el = blk * 64 + (tid & 63), h = el >> 13, idx = el & 8191, d = idx & 63, e = idx >> 6;
        bf16_t* dsp = ds + (size_t)(seg * 32) * 32768 + (size_t)h * 8192 + idx; const float* anp = an + (size_t)(seg * 32) * 256 + h * 64 + d;
        unsigned short dq[32]; float aq[32];
#pragma unroll
        for (int j = 0; j < 32; ++j) { dq[j] = dsp[(size_t)j * 32768]; aq[j] = anp[(size_t)j * 256]; }
        float A = 1.f, B = 0.f;
#pragma unroll
        for (int j = 0; j < 32; ++j) { B = aq[j] * (B + bf2f(dq[j])); A *= aq[j]; }
        xa[seg * 64 + (tid & 63)] = A; xb[seg * 64 + (tid & 63)] = B;
        __syncthreads();
        float S = 0.f;
#pragma unroll
        for (int k = 0; k < 7; ++k) if (k < seg) S = xa[k * 64 + (tid & 63)] * S + xb[k * 64 + (tid & 63)];
#pragma unroll
        for (int j = 0; j < 32; ++j) { dsp[(size_t)j * 32768] = (bf16_t)f2bf(S); S = aq[j] * (S + bf2f(dq[j])); }
        if (seg == 7) p.out[O_GLAP + (size_t)l * 32768 + (size_t)h * 8192 + d * 128 + e] = S;
        __syncthreads();
    }
}

__device__ __forceinline__ void copy8(const bf16_t* s, float* d) { const u32x4 v = *(const u32x4*)s; *(f32x4*)d = (f32x4){bflo(v.x), bfhi(v.x), bflo(v.y), bfhi(v.y)}; *(f32x4*)(d + 4) = (f32x4){bflo(v.z), bfhi(v.z), bflo(v.w), bfhi(v.w)}; }
__device__ __forceinline__ void phase_copies(const Params& p, int l, int tid, int vcu, int G) {
    const bf16_t* act = (const bf16_t*)(p.ws + WS_ACT); float* out = p.out;
    const int gt = vcu * 512 + tid, NGT = G * 512;
    constexpr int NKP = 512 * 64, NKS_ = 256 * 64, NPP = 15 * 64, NPS = 8 * 15 * 64, NTOT = 2 * NKP + 2 * NKS_ + NPP + NPS;
    for (int i = gt; i < NTOT; i += NGT) {
        int r = i;
        if (r < 2 * NKP) { const int v = r >= NKP; if (v) r -= NKP; const int row = r >> 6, c8 = r & 63; copy8(act + (size_t)(SEQ - 512 + row) * APITCH + (v ? C_VC : C_KC) + 8 * c8, out + (v ? O_VP : O_KP) + (size_t)l * 262144 + (size_t)row * 512 + 8 * c8); continue; } r -= 2 * NKP;
        if (r < 2 * NKS_) { const int v = r >= NKS_; if (v) r -= NKS_; const int row = r >> 6, c8 = r & 63; copy8(act + (size_t)(SEQ + row) * APITCH + (v ? C_VC : C_KC) + 8 * c8, out + (v ? O_VS : O_KS) + (size_t)l * 131072 + (size_t)row * 512 + 8 * c8); continue; } r -= 2 * NKS_;
        if (r < NPP) { const int row = r >> 6, c8 = r & 63; copy8(act + (size_t)(SEQ - 15 + row) * APITCH + C_UA + 8 * c8, out + O_POOLP + (size_t)l * 7680 + (size_t)row * 512 + 8 * c8); continue; } r -= NPP;
        { const int b = r / (15 * 64), rr = r % (15 * 64), row = rr >> 6, c8 = rr & 63; copy8(act + (size_t)(SEQ + 32 * b + 17 + row) * APITCH + C_UA + 8 * c8, out + O_POOLS + (size_t)l * 61440 + (size_t)(b * 15 + row) * 512 + 8 * c8); }
    }
}

constexpr int CW_BAR = 4096;
constexpr int NPHASE = 19;

__global__ void __launch_bounds__(512, 2) mk_fwd(Params p) {
    extern __shared__ __attribute__((aligned(16))) unsigned char lds_raw[];
    LAS unsigned char* lds = (LAS unsigned char*)lds_raw;
    const int tid0 = threadIdx.x;
    const int G0 = gridDim.x; const int bx = blockIdx.x;
    volatile LAS unsigned* MISC = (volatile LAS unsigned*)(lds + LDS_MISC);
    if (tid0 < 64) MISC[tid0] = 0u;
    __syncthreads();
    unsigned* ctl = (unsigned*)(p.ws + WS_CTL);
    XcdBarrier bar; bar.bar = ctl + CW_BAR; bar.x = 0; bar.st = nullptr;
    if (p.ph_hi - p.ph_lo > 1) bar = xcd_barrier_post(ctl + CW_BAR, MISC + 8);

    unsigned long long ts_acc = 0ull;
    for (int ph = p.ph_lo; ph < p.ph_hi; ++ph) {
        unsigned long long ts0 = 0ull; if (TS_MASK) ts0 = __builtin_amdgcn_s_memrealtime();
        if ((SEC_PH >> ph) & 1) { TSEC_B(10); }
        int tid = tid0; asm volatile("" : "+v"(tid));
        const int lane = tid & 63, wave = __builtin_amdgcn_readfirstlane(tid >> 6);
        int G = G0; asm volatile("" : "+s"(G));
        const int vcu = (G % 8 == 0) ? (bx % 8) * (G / 8) + bx / 8 : bx;
        unsigned char* ws = p.ws; asm volatile("" : "+s"(ws));
        bf16_t* act = (bf16_t*)(ws + WS_ACT); float* ss = (float*)(ws + WS_SS); bf16_t* wbase = (bf16_t*)(ws + WS_W);
        const int l = ph == 0 ? 0 : (ph - 1) / 9, sub = ph == 0 ? -1 : (ph - 1) % 9;
        if (ph == 0) { if (PHON(9)) for (int rep = 0; rep < REP_WCONV; ++rep) { int t2 = tid; asm volatile("" : "+v"(t2)); phase_wconv(p, 0, lds, t2, wave, t2 & 63, vcu, G); } }
        else if (sub == 0 && PHON(0)) {
            typedef SchedDense<64, 27, true, (unsigned)(WS_ACT + C_XB * 2), (unsigned)(WS_W + W_IN), 16, 2048u> SA;
            SA S{G, bx}; EpiA E{act, ss, p.out, ws};
            for (int rep = 0; rep < REP_PA; ++rep) { int t2 = tid; asm volatile("" : "+v"(t2)); pg8::gemm_phase<EpiA, SA, true, APITCH, 1024>(lds, (const char*)ws, S, E, t2); }
        } else if (sub == 1 && PHON(1)) {
            const float* bsrc = (const float*)(ws + WS_BIAS); LAS float* tab = (LAS float*)(lds + LDS_BIAS);
            for (int i = tid; i < 8 * 260; i += 512) tab[i] = bsrc[i];
            __syncthreads();
            LAS unsigned char* vbuf = lds + wave * 16384; LAS float* wsf = (LAS float*)(lds + LDS_WSF) + wave * 128;
            const bf16_t* kvs = (const bf16_t*)(ws + WS_KVS);
            if (!DSKIP(1)) for (int U = vcu; U < 512; U += G) { int ln = lane; asm volatile("" : "+v"(ln));
                attn_unit_wg(act, U >> 6, 4 * (U & 63), lds, lds + 32768 + wave * 4096, wsf, tab + (U >> 6) * 260, wave, ln); }
            __syncthreads();
            if (!DSKIP(1)) for (int U = G - 1 - vcu; U < 64; U += G) { int ln = lane; asm volatile("" : "+v"(ln));
                attn_sample_wg(act, kvs, U >> 3, U & 7, lds, (LAS float*)(lds + LDS_WSF), tab + (U & 7) * 260, tid, wave, ln); }
            VM_WAIT(); LGKM_WAIT();
            __syncthreads();
            const bf16_t* w2t = (const bf16_t*)(ws + WS_W2T); const float* bgate = p.in[9] + l * 256; float* an = (float*)(ws + WS_AN); bf16_t* ds = (bf16_t*)(ws + WS_DS);
            int cnt = 0;
            if (!DSKIP(2)) for (int u = vcu; u < 1024; u += G) { gla1_unit<64>(act, w2t, bgate, an, ds, u, (u >> 2) * 64, u & 3, cnt & 1, lds, tid, wave, lane, nullptr, nullptr); ++cnt; }
            if (!DSKIP(2)) for (int su = vcu; su < 32; su += G) { gla1_unit<32>(act, w2t, bgate, an, ds, 1024 + su, SEQ + 32 * (su >> 2), su & 3, cnt & 1, lds, tid, wave, lane, p.in[3] + (size_t)l * 262144 + (size_t)su * 8192, p.out + O_GLAS + (size_t)l * 262144 + (size_t)su * 8192); ++cnt; }
            if (!DSKIP(4)) phase_copies(p, l, tid, vcu, G);
        } else if (sub == 2 && PHON(2)) {
            phase_scan(p, l, lds, tid, vcu, G);
            {
                const int gw = vcu * 8 + wave, NGW = G * 8; LAS unsigned char* wl = lds + wave * 16384;
                const bf16_t* pmt = (const bf16_t*)(ws + WS_PMT); const float* psc = p.in[12] + l * 512;
                if (!DSKIP(16)) for (int t = gw; t < 520 * 4; t += NGW) { int ln = lane; asm volatile("" : "+v"(ln)); const int tt = t >> 2, g = t & 3; const bool sm = tt >= 512;
                    const int row0 = sm ? SEQ + 32 * (tt - 512) : 32 * tt, pos0 = sm ? 2048 : 32 * tt; const float* hist = sm ? p.in[2] + (size_t)((l * 8 + (tt - 512)) * 15) * 512 : nullptr;
                    if (g == 0) pool_task<0>(act, hist, pmt, psc, row0, pos0, wl, ln); else if (g == 1) pool_task<1>(act, hist, pmt, psc, row0, pos0, wl, ln);
                    else if (g == 2) pool_task<2>(act, hist, pmt, psc, row0, pos0, wl, ln); else pool_task<3>(act, hist, pmt, psc, row0, pos0, wl, ln); }
                const bf16_t* dsb = (const bf16_t*)(ws + WS_DS); const float* gn = p.in[10] + l * 128;
                if (!DSKIP(8)) for (int t = NGW - 1 - gw; t < 32; t += NGW) { int ln = lane; asm volatile("" : "+v"(ln)); gla3_task<32>(act, dsb, gn, 1024 + t, SEQ + 32 * (t >> 2), t & 3, 0, wl, ln); }
            }
        }
        else if (sub == 3 && PHON(3)) {
            const int gw = vcu * 8 + wave, NGW = G * 8; LAS unsigned char* wl = lds + wave * 16384;
            const bf16_t* ds = (const bf16_t*)(ws + WS_DS); const float* gn = p.in[10] + l * 128;
            if (!DSKIP(8)) for (int t = gw; t < 2048; t += NGW) { int ln = lane; asm volatile("" : "+v"(ln)); const int u = t >> 1; gla3_task<64>(act, ds, gn, u, (u >> 2) * 64, u & 3, t & 1, wl, ln); }
        } else if (sub == 4 && PHON(4)) {
            SchedMerge S{G, bx}; EpiMerge E{act, p.out, ws};
            for (int rep = 0; rep < REP_PC; ++rep) { int t2 = tid; asm volatile("" : "+v"(t2)); pg8::gemm_phase<EpiMerge, SchedMerge, true, APITCH, 1024>(lds, (const char*)ws, S, E, t2); }
            LAS float* red = (LAS float*)lds;
            for (int T = vcu; T < 256; T += G) { const int rb = T >> 4, cb = T & 15, row0 = SEQ + 16 * rb, col0 = 64 * cb, row = row0 + (tid >> 5), col = col0 + 2 * (tid & 31);
                f32x4 accb[3][4]; f32x2 bv[3]; unsigned gq[3];
#pragma unroll
                for (int g = 0; g < 3; ++g) gq[g] = *(const unsigned*)(g_row(p.out, ws, row) + g * 1024 + col);
#pragma unroll
                for (int g = 0; g < 3; ++g) { const int yc = g == 0 ? C_YA : g == 1 ? C_YB : C_YC; small_tile_partial<2>(act + (size_t)row0 * APITCH + yc, APITCH, wbase + W_B / 2 + (size_t)(g * 1024 + col0) * 1024, 1024, wave, lane, accb[g]); }
                small_tile_reduce3(red, accb, wave, lane, tid, bv);
                f32x2 m2 = {0.f, 0.f};
#pragma unroll
                for (int g = 0; g < 3; ++g) { m2[0] += bflo(gq[g]) * bv[g][0]; m2[1] += bfhi(gq[g]) * bv[g][1]; }
                *(unsigned*)(act + (size_t)row * APITCH + C_M + col) = pk2(m2[0], m2[1]); }
        } else if ((sub == 5 || sub == 7) && PHON(5)) {
            const bool fo = sub == 7; EpiRes<false> E{p.out, act, ss};
            if (!fo) { typedef SchedDense<64, 4, false, (unsigned)(WS_ACT + C_M * 2), (unsigned)(WS_W + W_O), 16, 2048u> SD; SD S{G, bx}; pg8::gemm_phase<EpiRes<false>, SD, true, APITCH, 1024>(lds, (const char*)ws, S, E, tid); }
            else { typedef SchedDense<64, 4, false, (unsigned)(WS_ACT + C_HID * 2), (unsigned)(WS_W + W_FO), 44, 5632u> SF; SF S{G, bx}; pg8::gemm_phase<EpiRes<false>, SF, true, APITCH, 2816>(lds, (const char*)ws, S, E, tid); }
            LAS float* red = (LAS float*)lds;
            for (int T = vcu; T < 256; T += G) { const int rb = T >> 4, cb = T & 15, row0 = SEQ + 16 * rb, col0 = 64 * cb, row = row0 + (tid >> 5), col = col0 + 2 * (tid & 31);
                f32x4 acc[4];
                if (!fo) small_tile_partial<4>(act + (size_t)row0 * APITCH + C_M, APITCH, wbase + W_O / 2 + (size_t)col0 * 1024, 1024, wave, lane, acc);
                else small_tile_partial<11>(act + (size_t)row0 * APITCH + C_HID, APITCH, wbase + W_FO / 2 + (size_t)col0 * 2816, 2816, wave, lane, acc);
                const f32x2 v = small_tile_reduce(red, acc, wave, lane, tid);
                const unsigned rw = *(const unsigned*)(act + (size_t)row * APITCH + C_XB + col);
                const f32x2 x = (f32x2){bflo(rw), bfhi(rw)} + v;
                *(unsigned*)(act + (size_t)row * APITCH + C_XB + col) = pk2(x[0], x[1]);
                float q = x[0] * x[0] + x[1] * x[1];
#pragma unroll
                for (int o = 1; o < 32; o <<= 1) q += __shfl_xor(q, o);
                if ((tid & 31) == 0) ss[(size_t)row * 16 + cb] = q; }
        } else if (sub == 6 && PHON(6)) {
            typedef SchedDense<64, 22, true, (unsigned)(WS_ACT + C_XB * 2), (unsigned)(WS_W + W_FI), 16, 2048u> SE;
            SE S{G, bx}; EpiE E{act, ss};
            for (int rep = 0; rep < REP_PE; ++rep) { int t2 = tid; asm volatile("" : "+v"(t2)); pg8::gemm_phase<EpiE, SE, true, APITCH, 1024>(lds, (const char*)ws, S, E, t2); }
        } else if (sub == 8 && l == 0) { if (PHON(9)) for (int rep = 0; rep < REP_WCONV; ++rep) { int t2 = tid; asm volatile("" : "+v"(t2)); phase_wconv(p, 1, lds, t2, wave, t2 & 63, vcu, G); } }
        else if (sub == 8 && PHON(8)) {
            const float* fg = p.in[19]; const int gw = vcu * 8 + wave, NGW = G * 8;
            for (int m = gw; m < MROWS; m += NGW) { const float rs = row_rstd_full(ss, m); float* yr = p.out + (size_t)m * DM; const bf16_t* xr = act + (size_t)m * APITCH + C_XB;
#pragma unroll
                for (int j = 0; j < 4; ++j) { const u32x2 w = *(const u32x2*)(xr + 256 * j + 4 * lane); const f32x4 g = *(const f32x4*)(fg + 256 * j + 4 * lane);
                    *(f32x4*)(yr + 256 * j + 4 * lane) = (f32x4){bflo(w.x), bfhi(w.x), bflo(w.y), bfhi(w.y)} * rs * g; } }
        }
        if ((SEC_PH >> ph) & 1) { TSEC_E(10); TSEC_B(11); }
        if (ph + 1 < p.ph_hi) for (int rep = 0; rep < REP_BAR; ++rep) xcd_barrier(bar);
        if ((SEC_PH >> ph) & 1) { TSEC_E(11); }
        if (TS_MASK) { if ((TS_MASK >> ph) & 1) ts_acc += __builtin_amdgcn_s_memrealtime() - ts0; }
    }
    if (TS_MASK) { if (bx == (TS_SEC ? TS_BLK : 0)) { if (TS_SEC) ts_acc = *(volatile LAS unsigned long long*)(lds + LDS_MISC + 136); const float f = 1.0f + (float)ts_acc * (1.0f / 100000.0f); for (int i = tid0; i < 15360; i += 512) p.out[O_POOLP + i] *= f; } }
}

extern "C" void kernel_launch(void* const* d_in, const int* in_sizes, int n_in, void* d_out, int out_size, void* d_ws, size_t ws_size, hipStream_t stream) {
    static int grid = 0;
    if (grid == 0) {
        if (n_in != 20 || out_size != (int)O_TOTAL || ws_size < WS_END) { fprintf(stderr, "kernel_launch: unexpected problem (n_in %d out %d ws %zu)\n", n_in, out_size, ws_size); grid = -1; return; }
        int dev = 0, cus = 0, per_cu = 0;
        if (hipGetDevice(&dev) != hipSuccess || hipDeviceGetAttribute(&cus, hipDeviceAttributeMultiprocessorCount, dev) != hipSuccess) { grid = -1; return; }
        if (hipFuncSetAttribute((const void*)mk_fwd, hipFuncAttributeMaxDynamicSharedMemorySize, LDS_BYTES) != hipSuccess) { fprintf(stderr, "kernel_launch: hipFuncSetAttribute failed\n"); grid = -1; return; }
        if (hipOccupancyMaxActiveBlocksPerMultiprocessor(&per_cu, (const void*)mk_fwd, 512, LDS_BYTES) != hipSuccess || per_cu < 1) { fprintf(stderr, "kernel_launch: occupancy query says %d\n", per_cu); per_cu = 1; }
        (void)hipGetLastError();
        grid = cus;
    }
    if (grid < 0) return;
    (void)hipMemsetAsync((char*)d_ws + WS_CTL, 0, CTL_BYTES, stream);
    Params a{};
    for (int i = 0; i < 20; ++i) a.in[i] = (const float*)d_in[i];
    a.out = (float*)d_out; a.ws = (unsigned char*)d_ws;
#if MK_ONE_LAUNCH
    a.ph_lo = 0; a.ph_hi = NPHASE;
    hipLaunchKernelGGL(mk_fwd, dim3(grid), dim3(512), LDS_BYTES, stream, a);
#else
    for (int ph = 0; ph < NPHASE; ++ph) { a.ph_lo = ph; a.ph_hi = ph + 1; hipLaunchKernelGGL(mk_fwd, dim3(grid), dim3(512), LDS_BYTES, stream, a); }
#endif
}
```

```cpp
#include <hip/hip_runtime.h>
#include <hip/hip_bf16.h>
#include <cstdio>
#include <cstdint>

#ifndef MK_ONE_LAUNCH
#define MK_ONE_LAUNCH 1
#endif
#ifndef PH_MASK
#define PH_MASK 0x3ff
#endif
#define PHON(i) (((PH_MASK) >> (i)) & 1)
#ifndef TS_MASK
#define TS_MASK 0
#endif
#ifndef TS_BLK
#define TS_BLK 0
#endif
#ifndef SEC_PH
#define SEC_PH 0
#endif
#ifndef TS_SEC
#define TS_SEC 0
#endif
#define TSEC_B(id) do { if (TS_SEC == (id) && blockIdx.x == TS_BLK && threadIdx.x == 0) *(volatile LAS unsigned long long*)(lds + LDS_MISC + 128) = __builtin_amdgcn_s_memrealtime(); } while (0)
#define TSEC_E(id) do { if (TS_SEC == (id) && blockIdx.x == TS_BLK && threadIdx.x == 0) { volatile LAS unsigned long long* w_ = (volatile LAS unsigned long long*)(lds + LDS_MISC + 128); w_[1] += __builtin_amdgcn_s_memrealtime() - w_[0]; } } while (0)
#ifndef DBG_SKIP
#define DBG_SKIP 0
#endif
#define DSKIP(b) ((DBG_SKIP & (b)) && l == 1)
#ifndef REP_WCONV
#define REP_WCONV 1
#endif
#ifndef REP_PA
#define REP_PA 1
#endif
#ifndef REP_PC
#define REP_PC 1
#endif
#ifndef REP_PE
#define REP_PE 1
#endif
#ifndef REP_BAR
#define REP_BAR 1
#endif

#define LAS __attribute__((address_space(3)))
#define GAS __attribute__((address_space(1)))
typedef unsigned short bf16_t;
typedef short bf16x8 __attribute__((ext_vector_type(8)));
typedef short s16x4 __attribute__((ext_vector_type(4)));
typedef float f32x4 __attribute__((ext_vector_type(4)));
typedef float f32x2 __attribute__((ext_vector_type(2)));
typedef float f32x16 __attribute__((ext_vector_type(16)));
typedef unsigned u32x4 __attribute__((ext_vector_type(4)));
typedef unsigned u32x2 __attribute__((ext_vector_type(2)));
typedef GAS unsigned gu32;

constexpr int DM = 1024, SEQ = 16384, NSB = 8, NST = 32, MROWS = SEQ + NSB * NST;
constexpr int NPAN = MROWS / 256;
constexpr int DIN = 6672, DFF = 2816;
constexpr float EPS = 1e-6f;
constexpr float LOG2E = 1.4426950408889634f;
constexpr int APITCH = 4864;
constexpr int C_UA = 0, C_QB = 512, C_KB = 768, C_VB = 1024, C_RB = 1536, C_Z = 2048, C_QC = 2304, C_KC = 2816, C_VC = 3328, C_XB = 3840;
constexpr int C_M = 0;
constexpr int C_YA = C_KC, C_YB = C_RB, C_YC = C_QC;
constexpr int C_HID = 0;
constexpr size_t MiB = 1u << 20;
constexpr size_t WS_CTL = 0, CTL_BYTES = 1 * MiB;
constexpr size_t WS_SS = 1 * MiB;
constexpr size_t WS_AN = 3 * MiB;
constexpr size_t WS_BIAS = 3 * MiB + 512 * 1024;
constexpr size_t WS_W2T = WS_BIAS + 16384;
constexpr size_t WS_PMT = WS_W2T + 16384;
constexpr size_t WS_W = 4 * MiB;
constexpr size_t W_IN = 0, W_G = W_IN + (size_t)3840 * 1024 * 2, W_B = W_G + (size_t)3072 * 1024 * 2, W_O = W_B + (size_t)3072 * 1024 * 2,
                 W_FI = W_O + (size_t)1024 * 1024 * 2, W_FO = W_FI + (size_t)5632 * 1024 * 2, W_END = W_FO + (size_t)1024 * 2816 * 2;
static_assert(W_END <= 38 * MiB, "weights");
constexpr size_t WS_KVS = 42 * MiB;
constexpr size_t WS_DS = 50 * MiB;
constexpr int NGU = 1024 + 32;
constexpr size_t WS_ACT = 67 * MiB;
constexpr size_t WS_G = WS_ACT + (size_t)MROWS * APITCH * 2;
constexpr int GSPLIT = 43 * 256;
constexpr size_t WS_END = WS_G + (size_t)(MROWS - GSPLIT) * 3072 * 2;
static_assert(WS_DS + (size_t)NGU * 16384 <= WS_ACT && WS_END <= 256 * MiB && (size_t)GSPLIT * 3072 * 2 <= (size_t)MROWS * DM * 4, "ws map");
constexpr size_t O_Y = 0, O_POOLP = 17039360, O_POOLS = 17054720, O_GLAP = 17177600, O_GLAS = 17243136, O_KP = 17767424, O_KS = 18291712, O_VP = 18553856, O_VS = 19078144, O_TOTAL = 19340288;
constexpr int RING_BYTES = 131072, LDS_BIAS = 131072, LDS_WSF = 131072 + 8448, LDS_MISC = 144 * 1024 - 256, LDS_BYTES = 147456;

struct Params {
    const float* in[20];
    float* out;
    unsigned char* ws;
    int ph_lo, ph_hi;
};

__device__ __forceinline__ unsigned f2bf(float f) { unsigned u = __builtin_bit_cast(unsigned, f); return (u + 0x7fffu + ((u >> 16) & 1u)) >> 16; }
__device__ __forceinline__ unsigned pk2(float lo, float hi) { typedef __bf16 b2 __attribute__((ext_vector_type(2))); f32x2 v = {lo, hi}; b2 b = __builtin_convertvector(v, b2); return __builtin_bit_cast(unsigned, b); }
__device__ __forceinline__ float bf2f(unsigned short h) { return __builtin_bit_cast(float, (unsigned)h << 16); }
__device__ __forceinline__ float bflo(unsigned w) { return __builtin_bit_cast(float, w << 16); }
__device__ __forceinline__ float bfhi(unsigned w) { return __builtin_bit_cast(float, w & 0xffff0000u); }
__device__ __forceinline__ bf16_t* g_row(float* out, unsigned char* ws, int row) { return row < GSPLIT ? (bf16_t*)out + (size_t)row * 3072 : (bf16_t*)(ws + WS_G) + (size_t)(row - GSPLIT) * 3072; }
__device__ __forceinline__ int crow(int r, int hi) { return (r & 3) + 8 * (r >> 2) + 4 * hi; }
__device__ __forceinline__ float fast_sigmoid(float x) { return __builtin_amdgcn_rcpf(1.0f + __builtin_amdgcn_exp2f(-x * LOG2E)); }
#define VM_WAIT() asm volatile("s_waitcnt vmcnt(0)" ::: "memory")
#define LGKM_WAIT() asm volatile("s_waitcnt lgkmcnt(0)" ::: "memory")
#define SBAR() __builtin_amdgcn_sched_barrier(0)
__device__ __forceinline__ s16x4 vtr(const LAS unsigned char* p) { typedef short v4 __attribute__((ext_vector_type(4))); return __builtin_bit_cast(s16x4, __builtin_amdgcn_ds_read_tr16_b64_v4i16((LAS v4*)p)); }
__device__ __forceinline__ bf16x8 cat8(s16x4 a, s16x4 b) { return (bf16x8){a[0], a[1], a[2], a[3], b[0], b[1], b[2], b[3]}; }
__device__ __forceinline__ void dma16(const void* gsrc, LAS unsigned char* dst) { __builtin_amdgcn_global_load_lds((const unsigned*)gsrc, (LAS unsigned*)dst, 16, 0, 0); }
__device__ __forceinline__ float row_rstd_full(const float* ss, int row) {
    const f32x4* p = (const f32x4*)(ss + (size_t)row * 16); f32x4 a = p[0], b = p[1], c = p[2], d = p[3];
    const float s = ((a[0] + a[1]) + (a[2] + a[3])) + ((b[0] + b[1]) + (b[2] + b[3])) + ((c[0] + c[1]) + (c[2] + c[3])) + ((d[0] + d[1]) + (d[2] + d[3]));
    return __builtin_amdgcn_rsqf(s * (1.0f / DM) + EPS);
}

namespace pg8 {
constexpr int BM = 256, BK = 64, HALF = 128, HTB = HALF * BK * 2, STAGE_BYTES = 8 * HTB, NXCD = 8, WGM = 8;
__host__ __device__ __forceinline__ int lds_byte(int r, int c) { const int st = (r >> 4) * 2 + (c >> 5), rr = r & 15, cc = c & 31, ob = rr * 64 + cc * 2; return st * 1024 + (ob ^ (((ob >> 9) & 1) << 5)); }
__host__ __device__ __forceinline__ void stage_rc(int b, int& R, int& C) { const int st = b / 1024, sb = b % 1024, swz = sb ^ (((sb >> 9) & 1) << 5); R = (st >> 1) * 16 + swz / 64; C = (st & 1) * 32 + (swz % 64) / 2; }
__host__ __device__ __forceinline__ int perm32(int rho) { const int n = rho >> 4, i = rho & 15; return 8 * (i >> 2) + 4 * n + (i & 3); }

struct Unit { unsigned A, B; int nt, pm, pn, kind; };
template <int nM, int nN, bool EXTRA>
__device__ __forceinline__ bool tile_of(int L, int& pm, int& pn) {
    constexpr int nwg = nM * nN; static_assert(nM % 8 == 0, "nM");
    if (L >= nwg) { if (EXTRA && L < nwg + nN) { pm = nM; pn = L - nwg; return true; } return false; }
    int wgid = L; { constexpr int q = nwg / NXCD, r = nwg % NXCD; const int xcd = wgid % NXCD, off = wgid / NXCD; wgid = (xcd < r ? xcd * (q + 1) : r * (q + 1) + (xcd - r) * q) + off; }
    constexpr int nig = WGM * nN; const int gid = wgid / nig, rem = wgid - gid * nig;
    pm = gid * WGM + (rem & (WGM - 1)); pn = rem / WGM; return true;
}

template <class Epi, class Sched, bool ALIGN_EPI, int lda, int ldb>
__device__ __forceinline__ void gemm_phase(LAS unsigned char* lds, const char* wsb, const Sched& S, const Epi& E, const int tid) {
    const int wid = __builtin_amdgcn_readfirstlane(tid >> 6), lane = tid & 63, wr = wid >> 2, wc = wid & 3, fr = lane & 15, fq = lane >> 4;
    unsigned voffA[2], voffB[2];
#pragma unroll
    for (int i = 0; i < 2; ++i) { int R, C; stage_rc(tid * 16 + i * 8192, R, C); const int Rb = Epi::PERM ? ((R & ~31) + perm32(R & 31)) : R;
        voffA[i] = (unsigned)(R * lda + C) * 2u; voffB[i] = (unsigned)(Rb * ldb + C) * 2u; }
    const size_t kstep = (size_t)(BK * 2);
    const size_t hstepA = (size_t)HALF * lda * 2, hstepB = (size_t)HALF * ldb * 2;
    const unsigned ldsw = (unsigned)wid * 1024u;
    const int aoff = lds_byte(wr * 64 + fr, fq * 8), boff = lds_byte(wc * 32 + fr, fq * 8);
#define PG8_SA(b, h) (((b) * 2 + (h)) * HTB)
#define PG8_SB(b, h) ((4 + (b) * 2 + (h)) * HTB)
#define PG8_STAGE(bufoff, gbase, voff) do { _Pragma("unroll") for (int _i = 0; _i < 2; ++_i) \
        __builtin_amdgcn_global_load_lds((const unsigned*)((const char*)(gbase) + (voff)[_i]), (LAS unsigned*)(lds + (bufoff) + ldsw + _i * 8192), 16, 0, 0); } while (0)
#define PG8_LDA(dst, b, h) do { _Pragma("unroll") for (int m = 0; m < 4; ++m) _Pragma("unroll") for (int k = 0; k < 2; ++k) dst[m][k] = *(const LAS bf16x8*)(lds + PG8_SA(b, h) + aoff + m * 2048 + k * 1024); } while (0)
#define PG8_LDB(dst, b, h) do { _Pragma("unroll") for (int n = 0; n < 2; ++n) _Pragma("unroll") for (int k = 0; k < 2; ++k) dst[n][k] = *(const LAS bf16x8*)(lds + PG8_SB(b, h) + boff + n * 2048 + k * 1024); } while (0)
#define PG8_MMA(ai, bj, At, Bt) do { __builtin_amdgcn_s_setprio(1); _Pragma("unroll") for (int m = 0; m < 4; ++m) _Pragma("unroll") for (int n = 0; n < 2; ++n) _Pragma("unroll") for (int k = 0; k < 2; ++k) \
        acc[ai][bj][m][n] = __builtin_amdgcn_mfma_f32_16x16x32_bf16(Bt[n][k], At[m][k], acc[ai][bj][m][n], 0, 0, 0); __builtin_amdgcn_s_setprio(0); } while (0)
#define PG8_WAIT_V(n) asm volatile("s_waitcnt vmcnt(" #n ")" ::: "memory")
#define PG8_WAIT_L(n) asm volatile("s_waitcnt lgkmcnt(" #n ")" ::: "memory")
#define PG8_BAR __builtin_amdgcn_s_barrier()
#define PG8_SCHED __builtin_amdgcn_sched_barrier(0)
    Unit cur, nxt; int ui = 0;
    if (!S.next(0, cur)) return;
    f32x4 acc[2][2][4][2];
#pragma unroll
    for (int a = 0; a < 2; ++a)
#pragma unroll
        for (int b = 0; b < 2; ++b)
#pragma unroll
            for (int m = 0; m < 4; ++m)
#pragma unroll
                for (int n = 0; n < 2; ++n) acc[a][b][m][n] = (f32x4){0.f, 0.f, 0.f, 0.f};
    bf16x8 At[4][2], B0[2][2], B1[2][2];
    const char* cA = wsb + cur.A; const char* cB = wsb + cur.B;
    PG8_STAGE(PG8_SB(0, 0), cB, voffB); PG8_STAGE(PG8_SB(0, 1), cB + hstepB, voffB); PG8_STAGE(PG8_SA(0, 0), cA, voffA); PG8_STAGE(PG8_SA(0, 1), cA + hstepA, voffA);
    if (wr == 1) PG8_BAR;
    PG8_WAIT_V(2); PG8_BAR;
    PG8_STAGE(PG8_SB(1, 0), cB + kstep, voffB); PG8_STAGE(PG8_SA(1, 0), cA + kstep, voffA); PG8_STAGE(PG8_SB(1, 1), cB + hstepB + kstep, voffB);
    PG8_WAIT_V(6); PG8_BAR;
    for (;;) {
        const bool has_next = S.next(ui + 1, nxt);
        const char* nA = has_next ? wsb + nxt.A : cA; const char* nB = has_next ? wsb + nxt.B : cB;
        const int nt = cur.nt;
        for (int t = 0; t < nt; t += 2) {
            const bool last = (t == nt - 2);
            const char* a1 = cA + (size_t)(t + 1) * kstep;
            const char* a2 = last ? nA : cA + (size_t)(t + 2) * kstep; const char* b2 = last ? nB : cB + (size_t)(t + 2) * kstep;
            const char* a3 = a2 + kstep; const char* b3 = b2 + kstep;
            PG8_LDB(B0, 0, 0); PG8_LDB(B1, 0, 1); PG8_SCHED; PG8_LDA(At, 0, 0); PG8_STAGE(PG8_SA(1, 1), a1 + hstepA, voffA);
            PG8_WAIT_V(8); PG8_WAIT_L(0); PG8_BAR; PG8_MMA(0, 0, At, B0); PG8_MMA(0, 1, At, B1); PG8_BAR; PG8_SCHED;
            PG8_LDA(At, 0, 1); PG8_STAGE(PG8_SB(0, 0), b2, voffB); PG8_STAGE(PG8_SB(0, 1), b2 + hstepB, voffB); PG8_STAGE(PG8_SA(0, 0), a2, voffA);
            PG8_WAIT_V(8); PG8_WAIT_L(0); PG8_BAR; PG8_MMA(1, 0, At, B0); PG8_MMA(1, 1, At, B1); PG8_BAR; PG8_SCHED;
            PG8_LDB(B0, 1, 0); PG8_LDB(B1, 1, 1); PG8_SCHED; PG8_LDA(At, 1, 0); PG8_STAGE(PG8_SA(0, 1), a2 + hstepA, voffA);
            PG8_WAIT_V(8); PG8_WAIT_L(0); PG8_BAR; PG8_MMA(0, 0, At, B0); PG8_MMA(0, 1, At, B1); PG8_BAR; PG8_SCHED;
            PG8_LDA(At, 1, 1); PG8_STAGE(PG8_SB(1, 0), b3, voffB); PG8_STAGE(PG8_SB(1, 1), b3 + hstepB, voffB); PG8_STAGE(PG8_SA(1, 0), a3, voffA);
            PG8_WAIT_V(8); PG8_WAIT_L(0); PG8_BAR; PG8_MMA(1, 0, At, B0); PG8_MMA(1, 1, At, B1); PG8_BAR; PG8_SCHED;
        }
        if constexpr (ALIGN_EPI) { if (wr == 0) PG8_BAR; }
        E(acc, cur, wr, wc, fr, fq);
        if (!has_next) break;
        if (!Epi::keep_acc(cur))
#pragma unroll
        for (int a = 0; a < 2; ++a)
#pragma unroll
            for (int b = 0; b < 2; ++b)
#pragma unroll
                for (int m = 0; m < 4; ++m)
#pragma unroll
                    for (int n = 0; n < 2; ++n) acc[a][b][m][n] = (f32x4){0.f, 0.f, 0.f, 0.f};
        cur = nxt; cA = nA; cB = nB; ++ui;
        if constexpr (ALIGN_EPI) { if (wr == 1) PG8_BAR; }
    }
    PG8_WAIT_V(0);
    if constexpr (!ALIGN_EPI) { if (wr == 0) PG8_BAR; }
    PG8_BAR;
#undef PG8_SA
#undef PG8_SB
#undef PG8_STAGE
#undef PG8_LDA
#undef PG8_LDB
#undef PG8_MMA
#undef PG8_WAIT_V
#undef PG8_WAIT_L
#undef PG8_BAR
#undef PG8_SCHED
}
}

using pg8::Unit;
template <int nM, int nN, bool EXTRA, unsigned ABASE, unsigned WBASE, int NT, unsigned WROWB>
struct SchedDense {
    int G, c;
    __device__ __forceinline__ bool next(int i, Unit& u) const {
        int pm, pn; if (!pg8::tile_of<nM, nN, EXTRA>(i * G + c, pm, pn)) return false;
        u.pm = pm; u.pn = pn; u.kind = 0; u.nt = NT; u.A = ABASE + (unsigned)pm * (256u * APITCH * 2u); u.B = WBASE + (unsigned)pn * (256u * WROWB); return true; }
};
struct SchedMerge {
    int G, c;
    __device__ __forceinline__ bool next(int i, Unit& u) const {
        const int su = i / 3, g = i - su * 3; int pm, pn; if (!pg8::tile_of<64, 4, false>(su * G + c, pm, pn)) return false;
        u.pm = pm; u.pn = pn; u.kind = g; u.nt = 8;
        const int yc = g == 0 ? C_YA : g == 1 ? C_YB : C_YC;
        u.A = (unsigned)WS_ACT + (unsigned)pm * (256u * APITCH * 2u) + yc * 2; u.B = (unsigned)(WS_W + W_B) + (unsigned)(g * 1024 + pn * 256) * 2048u;
        return true; }
};

__device__ __forceinline__ float row_rstd_q(const float* ss, int row, int fq) {
    const f32x4 a = *(const f32x4*)(ss + (size_t)row * 16 + 4 * fq); float s = (a[0] + a[1]) + (a[2] + a[3]);
    s += __shfl_xor(s, 16); s += __shfl_xor(s, 32); return __builtin_amdgcn_rsqf(s * (1.0f / DM) + EPS);
}
struct EpiA {
    static constexpr bool PERM = true;
    __device__ static __forceinline__ bool keep_acc(const Unit&) { return false; }
    bf16_t* act; const float* ss; float* out; unsigned char* ws;
    __device__ __forceinline__ void operator()(f32x4 (&acc)[2][2][4][2], const Unit& u, int wr, int wc, int fr, int fq) const {
        const int row0 = u.pm * 256 + wr * 64 + fr; const bool gate = u.pn >= 15; const int col0 = (gate ? u.pn - 15 : u.pn) * 256 + wc * 32 + 8 * fq;
        float rsv[2][4];
#pragma unroll
        for (int ai = 0; ai < 2; ++ai)
#pragma unroll
            for (int m = 0; m < 4; ++m) rsv[ai][m] = row_rstd_q(ss, row0 + ai * 128 + m * 16, fq);
#pragma unroll
        for (int ai = 0; ai < 2; ++ai)
#pragma unroll
            for (int m = 0; m < 4; ++m) { const int row = row0 + ai * 128 + m * 16; const float rs = rsv[ai][m]; bf16_t* rowp = (gate ? g_row(out, ws, row) : act + (size_t)row * APITCH) + col0;
#pragma unroll
                for (int bj = 0; bj < 2; ++bj) { f32x4 v0 = acc[ai][bj][m][0] * rs, v1 = acc[ai][bj][m][1] * rs;
                    if (gate) {
#pragma unroll
                        for (int e = 0; e < 4; ++e) { v0[e] = fmaxf(fast_sigmoid(v0[e]), 1e-30f); v1[e] = fmaxf(fast_sigmoid(v1[e]), 1e-30f); } }
                    u32x4 w; w.x = pk2(v0[0], v0[1]); w.y = pk2(v0[2], v0[3]); w.z = pk2(v1[0], v1[1]); w.w = pk2(v1[2], v1[3]); *(u32x4*)(rowp + bj * 128) = w; } }
    }
};
struct EpiE {
    static constexpr bool PERM = true;
    __device__ static __forceinline__ bool keep_acc(const Unit&) { return false; }
    bf16_t* act; const float* ss;
    __device__ __forceinline__ void operator()(f32x4 (&acc)[2][2][4][2], const Unit& u, int wr, int wc, int fr, int fq) const {
        const int row0 = u.pm * 256 + wr * 64 + fr, col0 = C_HID + u.pn * 128 + wc * 32 + 8 * fq;
        float rsv[2][4];
#pragma unroll
        for (int ai = 0; ai < 2; ++ai)
#pragma unroll
            for (int m = 0; m < 4; ++m) rsv[ai][m] = row_rstd_q(ss, row0 + ai * 128 + m * 16, fq);
#pragma unroll
        for (int ai = 0; ai < 2; ++ai)
#pragma unroll
            for (int m = 0; m < 4; ++m) { const int row = row0 + ai * 128 + m * 16; const float rs = rsv[ai][m];
                float h[8];
#pragma unroll
                for (int n = 0; n < 2; ++n)
#pragma unroll
                    for (int e = 0; e < 4; ++e) { const float a = acc[ai][0][m][n][e] * rs, g = acc[ai][1][m][n][e] * rs; h[n * 4 + e] = a * fast_sigmoid(a) * g; }
                u32x4 w; w.x = pk2(h[0], h[1]); w.y = pk2(h[2], h[3]); w.z = pk2(h[4], h[5]); w.w = pk2(h[6], h[7]); *(u32x4*)(act + (size_t)row * APITCH + col0) = w; }
    }
};
template <bool F32OUT>
struct EpiRes {
    static constexpr bool PERM = false;
    __device__ static __forceinline__ bool keep_acc(const Unit&) { return false; }
    float* out; bf16_t* act; float* ss;
    __device__ __forceinline__ void operator()(f32x4 (&acc)[2][2][4][2], const Unit& u, int wr, int wc, int fr, int fq) const {
        const int row0 = u.pm * 256 + wr * 64 + fr, col0 = u.pn * 256 + wc * 32 + 4 * fq;
#pragma unroll
        for (int ai = 0; ai < 2; ++ai) {
            u32x2 rv[4][2][2];
#pragma unroll
            for (int m = 0; m < 4; ++m)
#pragma unroll
                for (int bj = 0; bj < 2; ++bj)
#pragma unroll
                    for (int n = 0; n < 2; ++n) rv[m][bj][n] = *(const u32x2*)(act + (size_t)(row0 + ai * 128 + m * 16) * APITCH + C_XB + col0 + bj * 128 + n * 16);
            asm volatile("" ::: "memory");
#pragma unroll
            for (int m = 0; m < 4; ++m) { const int row = row0 + ai * 128 + m * 16; float q = 0.f;
#pragma unroll
                for (int bj = 0; bj < 2; ++bj)
#pragma unroll
                    for (int n = 0; n < 2; ++n) { const int c = col0 + bj * 128 + n * 16; const u32x2 r2 = rv[m][bj][n];
                        const f32x4 x = (f32x4){bflo(r2.x), bfhi(r2.x), bflo(r2.y), bfhi(r2.y)} + acc[ai][bj][m][n];
                        if (F32OUT) *(f32x4*)(out + (size_t)row * DM + c) = x;
                        q += (x[0] * x[0] + x[1] * x[1]) + (x[2] * x[2] + x[3] * x[3]);
                        u32x2 w; w.x = pk2(x[0], x[1]); w.y = pk2(x[2], x[3]); *(u32x2*)(act + (size_t)row * APITCH + C_XB + c) = w; }
                q += __shfl_xor(q, 16); q += __shfl_xor(q, 32);
                if (fq == 0) ss[(size_t)row * 16 + 4 * u.pn + wc] = q; }
            asm volatile("" ::: "memory");
        }
    }
};
struct EpiMerge {
    static constexpr bool PERM = true;
    __device__ static __forceinline__ bool keep_acc(const Unit& u) { return u.kind < 2; }
    bf16_t* act; float* out; unsigned char* ws;
    __device__ __forceinline__ void operator()(f32x4 (&acc)[2][2][4][2], const Unit& u, int wr, int wc, int fr, int fq) const {
        const int row0 = u.pm * 256 + wr * 64 + fr, cin = wc * 32 + 8 * fq, gcol = u.kind * 1024 + u.pn * 256 + cin, mcol = C_M + u.pn * 256 + cin;
        const bool lastg = (u.kind == 2);
#pragma unroll
        for (int ai = 0; ai < 2; ++ai)
#pragma unroll
          for (int mh = 0; mh < 2; ++mh) {
            u32x4 ga[2][2], gb[2][2];
#pragma unroll
            for (int m2 = 0; m2 < 2; ++m2)
#pragma unroll
                for (int bj = 0; bj < 2; ++bj) { const bf16_t* gp = g_row(out, ws, row0 + ai * 128 + (2 * mh + m2) * 16) + gcol + bj * 128; ga[m2][bj] = *(const u32x4*)gp;
                    gb[m2][bj] = ga[m2][bj]; if (!lastg) gb[m2][bj] = *(const u32x4*)(gp + 1024); }
            asm volatile("" ::: "memory");
            if (!lastg) {
#pragma unroll
                for (int m2 = 0; m2 < 2; ++m2)
#pragma unroll
                    for (int bj = 0; bj < 2; ++bj) { const int m = 2 * mh + m2; const u32x4 a4 = ga[m2][bj], b4 = gb[m2][bj]; f32x4& a0 = acc[ai][bj][m][0]; f32x4& a1 = acc[ai][bj][m][1];
                        a0[0] *= bflo(a4.x) * __builtin_amdgcn_rcpf(bflo(b4.x)); a0[1] *= bfhi(a4.x) * __builtin_amdgcn_rcpf(bfhi(b4.x)); a0[2] *= bflo(a4.y) * __builtin_amdgcn_rcpf(bflo(b4.y)); a0[3] *= bfhi(a4.y) * __builtin_amdgcn_rcpf(bfhi(b4.y));
                        a1[0] *= bflo(a4.z) * __builtin_amdgcn_rcpf(bflo(b4.z)); a1[1] *= bfhi(a4.z) * __builtin_amdgcn_rcpf(bfhi(b4.z)); a1[2] *= bflo(a4.w) * __builtin_amdgcn_rcpf(bflo(b4.w)); a1[3] *= bfhi(a4.w) * __builtin_amdgcn_rcpf(bfhi(b4.w)); }
            } else {
#pragma unroll
                for (int m2 = 0; m2 < 2; ++m2) { const int m = 2 * mh + m2; bf16_t* rowp = act + (size_t)(row0 + ai * 128 + m * 16) * APITCH;
#pragma unroll
                    for (int bj = 0; bj < 2; ++bj) { const u32x4 g4 = ga[m2][bj]; const f32x4 a0 = acc[ai][bj][m][0], a1 = acc[ai][bj][m][1];
                        u32x4 w; w.x = pk2(a0[0] * bflo(g4.x), a0[1] * bfhi(g4.x)); w.y = pk2(a0[2] * bflo(g4.y), a0[3] * bfhi(g4.y)); w.z = pk2(a1[0] * bflo(g4.z), a1[1] * bfhi(g4.z)); w.w = pk2(a1[2] * bflo(g4.w), a1[3] * bfhi(g4.w));
                        *(u32x4*)(rowp + mcol + bj * 128) = w; } }
            }
            asm volatile("" ::: "memory");
          }
    }
};

template <int KSTEPS>
__device__ __forceinline__ void small_tile_partial(const bf16_t* A, int lda, const bf16_t* Bt, int ldb, int wave, int lane, f32x4 (&acc)[4]) {
    const int kk0 = wave * KSTEPS * 32 + 8 * (lane >> 4); const bf16_t* ap = A + (size_t)(lane & 15) * lda + kk0; const bf16_t* bp = Bt + (size_t)(lane & 15) * ldb + kk0;
#pragma unroll
    for (int j = 0; j < 4; ++j) acc[j] = (f32x4){0.f, 0.f, 0.f, 0.f};
#pragma unroll
    for (int s = 0; s < KSTEPS; ++s) { const bf16x8 a = *(const bf16x8*)(ap + 32 * s);
#pragma unroll
        for (int j = 0; j < 4; ++j) { const bf16x8 b = *(const bf16x8*)(bp + (size_t)(16 * j) * ldb + 32 * s); acc[j] = __builtin_amdgcn_mfma_f32_16x16x32_bf16(a, b, acc[j], 0, 0, 0); } }
}
__device__ __forceinline__ f32x2 small_tile_reduce(LAS float* red, const f32x4 (&acc)[4], int wave, int lane, int tid) {
#pragma unroll
    for (int j = 0; j < 4; ++j)
#pragma unroll
        for (int r = 0; r < 4; ++r) red[(wave * 16 + 4 * (lane >> 4) + r) * 68 + 16 * j + (lane & 15)] = acc[j][r];
    __syncthreads();
    const int row = tid >> 5, c2 = 2 * (tid & 31); f32x2 s = {0.f, 0.f};
#pragma unroll
    for (int w = 0; w < 8; ++w) { const f32x2 v = *(const LAS f32x2*)(red + (w * 16 + row) * 68 + c2); s += v; }
    __syncthreads();
    return s;
}

__device__ __forceinline__ void small_tile_reduce3(LAS float* red, const f32x4 (&acc)[3][4], int wave, int lane, int tid, f32x2 (&out)[3]) {
#pragma unroll
    for (int g = 0; g < 3; ++g)
#pragma unroll
        for (int j = 0; j < 4; ++j)
#pragma unroll
            for (int r = 0; r < 4; ++r) red[g * 8704 + (wave * 16 + 4 * (lane >> 4) + r) * 68 + 16 * j + (lane & 15)] = acc[g][j][r];
    __syncthreads();
    const int row = tid >> 5, c2 = 2 * (tid & 31);
#pragma unroll
    for (int g = 0; g < 3; ++g) { f32x2 s = {0.f, 0.f};
#pragma unroll
        for (int w = 0; w < 8; ++w) { const f32x2 v = *(const LAS f32x2*)(red + g * 8704 + (w * 16 + row) * 68 + c2); s += v; }
        out[g] = s; }
    __syncthreads();
}

constexpr float ATT_THR = 8.0f;
template <bool SAMP>
__device__ __forceinline__ void attn_task(bf16_t* act, const bf16_t* kvs, int cb, int h, int qb0, LAS unsigned char* vbuf, LAS float* wsf, const LAS float* tab, int lane) {
    constexpr int NQB = 1;
    const int r32 = lane & 31, hi = lane >> 5;
    const int nt = SAMP ? 9 : ((cb < 8 ? cb : 8) + 1);
    const int qrow0 = SAMP ? SEQ + 32 * cb : 64 * cb + 32 * qb0;
    const int vp0 = ((lane >> 4) & 1) * 32 + (lane & 3) * 8 + (4 * hi + ((lane & 15) >> 2)) * 64;
    bf16x8 qr[NQB][4];
#pragma unroll
    for (int qb = 0; qb < NQB; ++qb)
#pragma unroll
        for (int j = 0; j < 4; ++j) qr[qb][j] = *(const bf16x8*)(act + (size_t)(qrow0 + 32 * qb + r32) * APITCH + C_QC + h * 64 + 16 * j + 8 * hi);
    float mhat[NQB], lsum[NQB]; f32x16 o[NQB][2];
#pragma unroll
    for (int qb = 0; qb < NQB; ++qb) { mhat[qb] = 0.f; lsum[qb] = 0.f;
#pragma unroll
        for (int r = 0; r < 16; ++r) { o[qb][0][r] = 0.f; o[qb][1][r] = 0.f; } }
    const float bconst = tab[256];
#define ATT_TILE(t, kp, vp, pitch) do { if (SAMP && (t) < 8) { const size_t off_ = ((size_t)(cb * 512 + 64 * (t)) * 512 + h * 64) * 2; kp = (const char*)kvs + off_; vp = (const char*)kvs + (size_t)8 * 512 * 512 * 2 + off_; pitch = 1024; } \
        else { const int row_ = SAMP ? SEQ + 32 * cb : 64 * (cb - (nt - 1) + (t)); kp = (const char*)(act + (size_t)row_ * APITCH + C_KC + h * 64); vp = (const char*)(act + (size_t)row_ * APITCH + C_VC + h * 64); pitch = (size_t)APITCH * 2; } } while (0)
#define ATT_VDMA(vp, pitch, buf) do { _Pragma("unroll") for (int p_ = 0; p_ < 8; ++p_) dma16((vp) + (size_t)(16 * (p_ & 3) + (lane >> 2)) * (pitch) + ((p_ >> 2) * 32 + (lane & 3) * 8) * 2, (buf) + p_ * 1024); } while (0)
#define ATT_KLOAD(kf, kp, pitch) do { _Pragma("unroll") for (int j_ = 0; j_ < 4; ++j_) { kf[2 * j_] = *(const bf16x8*)((kp) + (size_t)r32 * (pitch) + (16 * j_ + 8 * hi) * 2); kf[2 * j_ + 1] = *(const bf16x8*)((kp) + (size_t)(32 + r32) * (pitch) + (16 * j_ + 8 * hi) * 2); } } while (0)
    bf16x8 kf[8], kn[8];
    { const char* kp; const char* vp; size_t pitch; ATT_TILE(0, kp, vp, pitch); LGKM_WAIT(); ATT_VDMA(vp, pitch, vbuf); ATT_KLOAD(kn, kp, pitch); }
    for (int t = 0; t < nt; ++t) {
        const int delta = nt - 1 - t; const bool half = SAMP && (t == 8);
        LAS unsigned char* vcur = vbuf + (t & 1) * 8192;
        VM_WAIT();
#pragma unroll
        for (int j = 0; j < 8; ++j) kf[j] = kn[j];
        asm volatile("" ::: "memory");
        if (t + 1 < nt) { const char* kpn; const char* vpn; size_t pitchn; ATT_TILE(t + 1, kpn, vpn, pitchn); LGKM_WAIT(); ATT_VDMA(vpn, pitchn, vbuf + ((t + 1) & 1) * 8192); ATT_KLOAD(kn, kpn, pitchn); }
#pragma unroll
        for (int qb = 0; qb < NQB; ++qb) {
            f32x16 c0, c1;
            if (delta >= 3) { const float cbv = bconst - mhat[qb];
#pragma unroll
                for (int r = 0; r < 16; ++r) { c0[r] = cbv; c1[r] = cbv; } }
            else { const int base = 64 * delta + 32 * (qb0 + qb) + r32 + 128;
#pragma unroll
                for (int r = 0; r < 16; ++r) { const int i0 = base - crow(r, hi), i1 = i0 - 32; c0[r] = tab[i0 < 256 ? i0 : 256] - mhat[qb]; c1[r] = tab[i1 < 256 ? i1 : 256] - mhat[qb]; } }
#pragma unroll
            for (int j = 0; j < 4; ++j) { c0 = __builtin_amdgcn_mfma_f32_32x32x16_bf16(kf[2 * j], qr[qb][j], c0, 0, 0, 0); if (!half) c1 = __builtin_amdgcn_mfma_f32_32x32x16_bf16(kf[2 * j + 1], qr[qb][j], c1, 0, 0, 0); }
            float rm = c0[0];
#pragma unroll
            for (int r = 1; r < 16; ++r) rm = fmaxf(rm, c0[r]);
            if (!half) {
#pragma unroll
                for (int r = 0; r < 16; ++r) rm = fmaxf(rm, c1[r]); }
            rm = fmaxf(rm, __shfl_xor(rm, 32));
            if (t == 0) { mhat[qb] += rm;
#pragma unroll
                for (int r = 0; r < 16; ++r) { c0[r] -= rm; c1[r] -= rm; } }
            else if (__any(rm > ATT_THR)) { const float dl = fmaxf(rm, 0.f); mhat[qb] += dl;
#pragma unroll
                for (int r = 0; r < 16; ++r) { c0[r] -= dl; c1[r] -= dl; }
                const float f = __builtin_amdgcn_exp2f(-dl); lsum[qb] *= f; if (hi == 0) wsf[r32] = f;
#pragma unroll
                for (int r = 0; r < 16; ++r) { const float fr_ = wsf[crow(r, hi)]; o[qb][0][r] *= fr_; o[qb][1][r] *= fr_; } }
            float ps = 0.f;
#pragma unroll
            for (int r = 0; r < 16; ++r) { c0[r] = __builtin_amdgcn_exp2f(c0[r]); ps += c0[r]; }
            if (!half) {
#pragma unroll
                for (int r = 0; r < 16; ++r) { c1[r] = __builtin_amdgcn_exp2f(c1[r]); ps += c1[r]; } }
            lsum[qb] += ps;
            u32x4 pw[4];
            pw[0] = (u32x4){pk2(c0[0], c0[1]), pk2(c0[2], c0[3]), pk2(c0[4], c0[5]), pk2(c0[6], c0[7])};
            pw[1] = (u32x4){pk2(c0[8], c0[9]), pk2(c0[10], c0[11]), pk2(c0[12], c0[13]), pk2(c0[14], c0[15])};
            pw[2] = (u32x4){pk2(c1[0], c1[1]), pk2(c1[2], c1[3]), pk2(c1[4], c1[5]), pk2(c1[6], c1[7])};
            pw[3] = (u32x4){pk2(c1[8], c1[9]), pk2(c1[10], c1[11]), pk2(c1[12], c1[13]), pk2(c1[14], c1[15])};
#pragma unroll
            for (int d0 = 0; d0 < 2; ++d0)
#pragma unroll
                for (int ks = 0; ks < 4; ++ks) { if (half && ks >= 2) continue;
                    const bf16x8 vf = cat8(vtr(vcur + d0 * 4096 + ks * 1024 + vp0), vtr(vcur + d0 * 4096 + ks * 1024 + vp0 + 512));
                    o[qb][d0] = __builtin_amdgcn_mfma_f32_32x32x16_bf16(__builtin_bit_cast(bf16x8, pw[ks]), vf, o[qb][d0], 0, 0, 0); }
        }
    }
#undef ATT_TILE
#undef ATT_VDMA
#undef ATT_KLOAD
    LAS bf16_t* stg = (LAS bf16_t*)vbuf;
#pragma unroll
    for (int qb = 0; qb < NQB; ++qb) {
        float lt = lsum[qb]; lt += __shfl_xor(lt, 32);
        if (hi == 0) wsf[32 + r32] = lt;
#pragma unroll
        for (int r = 0; r < 16; ++r) { const float rl = __builtin_amdgcn_rcpf(wsf[32 + crow(r, hi)]); const int orow = crow(r, hi);
            stg[orow * 64 + r32] = (bf16_t)f2bf(o[qb][0][r] * rl); stg[orow * 64 + 32 + r32] = (bf16_t)f2bf(o[qb][1][r] * rl); }
#pragma unroll
        for (int i = 0; i < 4; ++i) { const int row = i * 8 + (lane >> 3), ch = lane & 7; const u32x4 v = *(const LAS u32x4*)(stg + row * 64 + ch * 8);
            *(u32x4*)(act + (size_t)(qrow0 + 32 * qb + row) * APITCH + C_YC + h * 64 + ch * 8) = v; }
        LGKM_WAIT();
    }
}

__device__ __forceinline__ void attn_unit_wg(bf16_t* act, int h, int c0, LAS unsigned char* ring, LAS unsigned char* stage, LAS float* wsf, const LAS float* tab, int wave, int lane) {
    const int r32 = lane & 31, hi = lane >> 5, pr = wave >> 1, qb0 = wave & 1;
    const int qrow0 = 64 * (c0 + pr) + 32 * qb0;
    const int vp0 = ((lane >> 4) & 1) * 32 + (lane & 3) * 8 + (4 * hi + ((lane & 15) >> 2)) * 64;
    bf16x8 qr[4];
#pragma unroll
    for (int j = 0; j < 4; ++j) qr[j] = *(const bf16x8*)(act + (size_t)(qrow0 + r32) * APITCH + C_QC + h * 64 + 16 * j + 8 * hi);
    float mhat = 0.f, lsum = 0.f; f32x16 o[2];
#pragma unroll
    for (int r = 0; r < 16; ++r) { o[0][r] = 0.f; o[1][r] = 0.f; }
    const float bconst = tab[256];
    const int smin = c0 >= 8 ? 0 : 8 - c0;
    const bf16_t* ksrc = act + (size_t)(64 * (c0 - 8) + lane) * APITCH + C_KC + h * 64 + wave * 8;
    const bf16_t* vsrc = act + (size_t)(64 * (c0 - 8) + 16 * (wave & 3) + (lane >> 2)) * APITCH + C_VC + h * 64 + (wave >> 2) * 32 + (lane & 3) * 8;
#define AW_DMA(s_) do { LAS unsigned char* sl_ = ring + ((s_) & 1) * 16384; dma16(ksrc + (size_t)(s_) * 64 * APITCH, sl_ + wave * 1024); dma16(vsrc + (size_t)(s_) * 64 * APITCH, sl_ + 8192 + wave * 1024); } while (0)
    asm volatile("s_waitcnt lgkmcnt(0)" ::: "memory"); __builtin_amdgcn_s_barrier();
    AW_DMA(smin);
    for (int s = smin; s < 12; ++s) {
        asm volatile("s_waitcnt vmcnt(0) lgkmcnt(0)" ::: "memory"); __builtin_amdgcn_s_barrier(); asm volatile("" ::: "memory");
        if (s + 1 < 12) AW_DMA(s + 1);
        if (s < pr || s > pr + 8) continue;
        const int delta = pr + 8 - s; const bool first = (s == (pr > smin ? pr : smin));
        const LAS unsigned char* kb = ring + (s & 1) * 16384 + hi * 1024 + r32 * 16; const LAS unsigned char* vcur = ring + (s & 1) * 16384 + 8192;
        f32x16 c0v, c1v;
        if (delta >= 3) { const float cbv = bconst - mhat;
#pragma unroll
            for (int r = 0; r < 16; ++r) { c0v[r] = cbv; c1v[r] = cbv; } }
        else { const int base = 64 * delta + 32 * qb0 + r32 + 128;
#pragma unroll
            for (int r = 0; r < 16; ++r) { const int i0 = base - crow(r, hi), i1 = i0 - 32; c0v[r] = tab[i0 < 256 ? i0 : 256] - mhat; c1v[r] = tab[i1 < 256 ? i1 : 256] - mhat; } }
#pragma unroll
        for (int j = 0; j < 4; ++j) { const bf16x8 k0 = *(const LAS bf16x8*)(kb + j * 2048), k1 = *(const LAS bf16x8*)(kb + j * 2048 + 512);
            c0v = __builtin_amdgcn_mfma_f32_32x32x16_bf16(k0, qr[j], c0v, 0, 0, 0); c1v = __builtin_amdgcn_mfma_f32_32x32x16_bf16(k1, qr[j], c1v, 0, 0, 0); }
        float rm = c0v[0];
#pragma unroll
        for (int r = 1; r < 16; ++r) rm = fmaxf(rm, c0v[r]);
#pragma unroll
        for (int r = 0; r < 16; ++r) rm = fmaxf(rm, c1v[r]);
        rm = fmaxf(rm, __shfl_xor(rm, 32));
        if (first) { mhat += rm;
#pragma unroll
            for (int r = 0; r < 16; ++r) { c0v[r] -= rm; c1v[r] -= rm; } }
        else if (__any(rm > ATT_THR)) { const float dl = fmaxf(rm, 0.f); mhat += dl;
#pragma unroll
            for (int r = 0; r < 16; ++r) { c0v[r] -= dl; c1v[r] -= dl; }
            const float f = __builtin_amdgcn_exp2f(-dl); lsum *= f; if (hi == 0) wsf[r32] = f;
#pragma unroll
            for (int r = 0; r < 16; ++r) { const float fr_ = wsf[crow(r, hi)]; o[0][r] *= fr_; o[1][r] *= fr_; } }
        float ps = 0.f;
#pragma unroll
        for (int r = 0; r < 16; ++r) { c0v[r] = __builtin_amdgcn_exp2f(c0v[r]); ps += c0v[r]; }
#pragma unroll
        for (int r = 0; r < 16; ++r) { c1v[r] = __builtin_amdgcn_exp2f(c1v[r]); ps += c1v[r]; }
        lsum += ps;
        u32x4 pw[4];
        pw[0] = (u32x4){pk2(c0v[0], c0v[1]), pk2(c0v[2], c0v[3]), pk2(c0v[4], c0v[5]), pk2(c0v[6], c0v[7])};
        pw[1] = (u32x4){pk2(c0v[8], c0v[9]), pk2(c0v[10], c0v[11]), pk2(c0v[12], c0v[13]), pk2(c0v[14], c0v[15])};
        pw[2] = (u32x4){pk2(c1v[0], c1v[1]), pk2(c1v[2], c1v[3]), pk2(c1v[4], c1v[5]), pk2(c1v[6], c1v[7])};
        pw[3] = (u32x4){pk2(c1v[8], c1v[9]), pk2(c1v[10], c1v[11]), pk2(c1v[12], c1v[13]), pk2(c1v[14], c1v[15])};
#pragma unroll
        for (int d0 = 0; d0 < 2; ++d0)
#pragma unroll
            for (int ks = 0; ks < 4; ++ks) { const bf16x8 vf = cat8(vtr(vcur + d0 * 4096 + ks * 1024 + vp0), vtr(vcur + d0 * 4096 + ks * 1024 + vp0 + 512));
                o[d0] = __builtin_amdgcn_mfma_f32_32x32x16_bf16(__builtin_bit_cast(bf16x8, pw[ks]), vf, o[d0], 0, 0, 0); }
    }
#undef AW_DMA
    LAS bf16_t* stg = (LAS bf16_t*)stage;
    float lt = lsum; lt += __shfl_xor(lt, 32);
    if (hi == 0) wsf[32 + r32] = lt;
#pragma unroll
    for (int r = 0; r < 16; ++r) { const float rl = __builtin_amdgcn_rcpf(wsf[32 + crow(r, hi)]); const int orow = crow(r, hi);
        stg[orow * 64 + r32] = (bf16_t)f2bf(o[0][r] * rl); stg[orow * 64 + 32 + r32] = (bf16_t)f2bf(o[1][r] * rl); }
#pragma unroll
    for (int i = 0; i < 4; ++i) { const int row = i * 8 + (lane >> 3), ch = lane & 7; const u32x4 v = *(const LAS u32x4*)(stg + row * 64 + ch * 8);
        *(u32x4*)(act + (size_t)(qrow0 + row) * APITCH + C_YC + h * 64 + ch * 8) = v; }
    LGKM_WAIT();
}

__device__ __forceinline__ void attn_sample_wg(bf16_t* act, const bf16_t* kvs, int b, int h, LAS unsigned char* lds, LAS float* wsfall, const LAS float* tab, int tid, int wave, int lane) {
    const int r32 = lane & 31, hi = lane >> 5;
    const int vp0 = ((lane >> 4) & 1) * 32 + (lane & 3) * 8 + (4 * hi + ((lane & 15) >> 2)) * 64;
    LAS unsigned char* vbuf = lds + wave * 16384; LAS float* po = (LAS float*)(lds + wave * 16384 + 8192); LAS float* ml = wsfall;
    const int qrow0 = SEQ + 32 * b;
    bf16x8 qr[4];
#pragma unroll
    for (int j = 0; j < 4; ++j) qr[j] = *(const bf16x8*)(act + (size_t)(qrow0 + r32) * APITCH + C_QC + h * 64 + 16 * j + 8 * hi);
    float mhat = 0.f, lsum = 0.f; f32x16 o[2];
#pragma unroll
    for (int r = 0; r < 16; ++r) { o[0][r] = 0.f; o[1][r] = 0.f; }
    const float bconst = tab[256];
    asm volatile("s_waitcnt lgkmcnt(0)" ::: "memory"); __builtin_amdgcn_s_barrier();
    for (int t = wave; t < 9; t += 8) {
        const bool half = (t == 8); const int delta = 8 - t;
        const char* kp; const char* vp; size_t pitch;
        if (t < 8) { const size_t off_ = ((size_t)(b * 512 + 64 * t) * 512 + h * 64) * 2; kp = (const char*)kvs + off_; vp = (const char*)kvs + (size_t)8 * 512 * 512 * 2 + off_; pitch = 1024; }
        else { kp = (const char*)(act + (size_t)qrow0 * APITCH + C_KC + h * 64); vp = (const char*)(act + (size_t)qrow0 * APITCH + C_VC + h * 64); pitch = (size_t)APITCH * 2; }
        LGKM_WAIT();
#pragma unroll
        for (int p_ = 0; p_ < 8; ++p_) dma16(vp + (size_t)(16 * (p_ & 3) + (lane >> 2)) * pitch + ((p_ >> 2) * 32 + (lane & 3) * 8) * 2, vbuf + p_ * 1024);
        bf16x8 kf[8];
#pragma unroll
        for (int j = 0; j < 4; ++j) { kf[2 * j] = *(const bf16x8*)(kp + (size_t)r32 * pitch + (16 * j + 8 * hi) * 2); kf[2 * j + 1] = *(const bf16x8*)(kp + (size_t)(32 + r32) * pitch + (16 * j + 8 * hi) * 2); }
        VM_WAIT();
        f32x16 c0v, c1v;
        if (delta >= 3) { const float cbv = bconst - mhat;
#pragma unroll
            for (int r = 0; r < 16; ++r) { c0v[r] = cbv; c1v[r] = cbv; } }
        else { const int base = 64 * delta + r32 + 128;
#pragma unroll
            for (int r = 0; r < 16; ++r) { const int i0 = base - crow(r, hi), i1 = i0 - 32; c0v[r] = tab[i0 < 256 ? i0 : 256] - mhat; c1v[r] = tab[i1 < 256 ? i1 : 256] - mhat; } }
#pragma unroll
        for (int j = 0; j < 4; ++j) { c0v = __builtin_amdgcn_mfma_f32_32x32x16_bf16(kf[2 * j], qr[j], c0v, 0, 0, 0); if (!half) c1v = __builtin_amdgcn_mfma_f32_32x32x16_bf16(kf[2 * j + 1], qr[j], c1v, 0, 0, 0); }
        float rm = c0v[0];
#pragma unroll
        for (int r = 1; r < 16; ++r) rm = fmaxf(rm, c0v[r]);
        if (!half) {
#pragma unroll
            for (int r = 0; r < 16; ++r) rm = fmaxf(rm, c1v[r]); }
        rm = fmaxf(rm, __shfl_xor(rm, 32));
        if (t == wave) { mhat += rm;
#pragma unroll
            for (int r = 0; r < 16; ++r) { c0v[r] -= rm; c1v[r] -= rm; } }
        else { const float dl = fmaxf(rm, 0.f); mhat += dl;
#pragma unroll
            for (int r = 0; r < 16; ++r) { c0v[r] -= dl; c1v[r] -= dl; }
            const float f = __builtin_amdgcn_exp2f(-dl); lsum *= f; if (hi == 0) ml[512 + r32] = f;
#pragma unroll
            for (int r = 0; r < 16; ++r) { const float fr_ = ml[512 + crow(r, hi)]; o[0][r] *= fr_; o[1][r] *= fr_; } }
        float ps = 0.f;
#pragma unroll
        for (int r = 0; r < 16; ++r) { c0v[r] = __builtin_amdgcn_exp2f(c0v[r]); ps += c0v[r]; }
        if (!half) {
#pragma unroll
            for (int r = 0; r < 16; ++r) { c1v[r] = __builtin_amdgcn_exp2f(c1v[r]); ps += c1v[r]; } }
        lsum += ps;
        u32x4 pw[4];
        pw[0] = (u32x4){pk2(c0v[0], c0v[1]), pk2(c0v[2], c0v[3]), pk2(c0v[4], c0v[5]), pk2(c0v[6], c0v[7])};
        pw[1] = (u32x4){pk2(c0v[8], c0v[9]), pk2(c0v[10], c0v[11]), pk2(c0v[12], c0v[13]), pk2(c0v[14], c0v[15])};
        pw[2] = (u32x4){pk2(c1v[0], c1v[1]), pk2(c1v[2], c1v[3]), pk2(c1v[4], c1v[5]), pk2(c1v[6], c1v[7])};
        pw[3] = (u32x4){pk2(c1v[8], c1v[9]), pk2(c1v[10], c1v[11]), pk2(c1v[12], c1v[13]), pk2(c1v[14], c1v[15])};
#pragma unroll
        for (int d0 = 0; d0 < 2; ++d0)
#pragma unroll
            for (int ks = 0; ks < 4; ++ks) { if (half && ks >= 2) continue;
                const bf16x8 vf = cat8(vtr(vbuf + d0 * 4096 + ks * 1024 + vp0), vtr(vbuf + d0 * 4096 + ks * 1024 + vp0 + 512));
                o[d0] = __builtin_amdgcn_mfma_f32_32x32x16_bf16(__builtin_bit_cast(bf16x8, pw[ks]), vf, o[d0], 0, 0, 0); }
    }
    { float lt = lsum; lt += __shfl_xor(lt, 32); if (hi == 0) { ml[(wave * 2) * 32 + r32] = mhat; ml[(wave * 2 + 1) * 32 + r32] = lt; }
#pragma unroll
        for (int r = 0; r < 16; ++r) { const int q = crow(r, hi); po[q * 64 + r32] = o[0][r]; po[q * 64 + 32 + r32] = o[1][r]; } }
    __syncthreads();
    { const int q = tid >> 4, d4 = (tid & 15) * 4; float M = ml[q];
#pragma unroll
        for (int w = 1; w < 8; ++w) M = fmaxf(M, ml[(w * 2) * 32 + q]);
        float L = 0.f; f32x4 acc = {0.f, 0.f, 0.f, 0.f};
#pragma unroll
        for (int w = 0; w < 8; ++w) { const float sc = __builtin_amdgcn_exp2f(ml[(w * 2) * 32 + q] - M); L += ml[(w * 2 + 1) * 32 + q] * sc; const f32x4 v = *(const LAS f32x4*)(lds + w * 16384 + 8192 + (q * 64 + d4) * 4); acc += v * sc; }
        const float rl = __builtin_amdgcn_rcpf(L);
        u32x2 wv; wv.x = pk2(acc[0] * rl, acc[1] * rl); wv.y = pk2(acc[2] * rl, acc[3] * rl);
        *(u32x2*)(act + (size_t)(qrow0 + q) * APITCH + C_YC + h * 64 + d4) = wv; }
}

__device__ __forceinline__ float log_sigmoid_f(float x) { const float ax = fabsf(x); return fminf(x, 0.f) - 0.6931471805599453f * __builtin_amdgcn_logf(1.0f + __builtin_amdgcn_exp2f(-ax * LOG2E)); }
template <int L>
__device__ __forceinline__ void gla1_unit(bf16_t* act, const bf16_t* w2t, const float* bgate, float* an, bf16_t* ds, int u, int tok0, int h, int parity, LAS unsigned char* lds, int tid, int wave, int lane, const float* s0  , float* sout  ) {
    constexpr int NTB = L / 32, NKS = L / 16;
    const int r32 = lane & 31, hi = lane >> 5;
    LAS float* Ep = (LAS float*)lds; LAS float* Em = (LAS float*)(lds + 16384); LAS unsigned char* kimg = lds + 32768; LAS unsigned char* vimg = lds + 40960 + parity * 16384; LAS float* totl = (LAS float*)(lds + 73728);
    const int vp0 = ((lane >> 4) & 1) * 32 + (lane & 3) * 8 + (4 * hi + ((lane & 15) >> 2)) * 64;
    TSEC_B(1); TSEC_B(5);
    float b[16]; const int tb = wave >> 1, db = wave & 1;
    const int tok2 = tid >> 3, c82 = tid & 7; bf16_t* qp = act + (size_t)(tok0 + tok2) * APITCH + C_QB + h * 64 + 8 * c82; bf16_t* kp = act + (size_t)(tok0 + tok2) * APITCH + C_KB + h * 64 + 8 * c82;
    u32x4 qv = (u32x4){0u, 0u, 0u, 0u}, kv = qv; if (tid < L * 8) { qv = *(const u32x4*)qp; kv = *(const u32x4*)kp; }
    if (wave < 2 * NTB) {
        const bf16x8 A = *(const bf16x8*)(act + (size_t)(tok0 + 32 * tb + r32) * APITCH + C_Z + 8 * hi);
        const bf16x8 B = *(const bf16x8*)(w2t + (h * 64 + 32 * db + r32) * 16 + 8 * hi);
        const float bg = bgate[h * 64 + 32 * db + r32]; f32x16 X;
#pragma unroll
        for (int r = 0; r < 16; ++r) X[r] = bg;
        X = __builtin_amdgcn_mfma_f32_32x32x16_bf16(A, B, X, 0, 0, 0);
        float la[16], seg[4], oth[4];
#pragma unroll
        for (int r = 0; r < 16; ++r) la[r] = log_sigmoid_f(X[r]) * 0.0625f;
#pragma unroll
        for (int q = 0; q < 4; ++q) { seg[q] = (la[4 * q] + la[4 * q + 1]) + (la[4 * q + 2] + la[4 * q + 3]); oth[q] = __shfl_xor(seg[q], 32); }
        float run = 0.f;
#pragma unroll
        for (int q = 0; q < 4; ++q) { float st = run + (hi ? oth[q] : 0.f);
#pragma unroll
            for (int i = 0; i < 4; ++i) { st += la[4 * q + i]; b[4 * q + i] = st; }
            run += seg[q] + oth[q]; }
        if (NTB == 2 && tb == 0 && hi == 0) totl[db * 32 + r32] = run;
    } else if (wave >= 4) {
        const int eb = wave - 4;
#pragma unroll
        for (int ks = 0; ks < NKS; ++ks) dma16(act + (size_t)(tok0 + 16 * ks + (lane >> 2)) * APITCH + C_VB + h * 128 + 32 * eb + (lane & 3) * 8, vimg + (eb * 4 + ks) * 1024);
        VM_WAIT();
    }
    __syncthreads();
    TSEC_E(1); TSEC_B(2);
    if (wave < 2 * NTB) {
        if (NTB == 2 && tb == 1) { const float carry = totl[db * 32 + r32];
#pragma unroll
            for (int r = 0; r < 16; ++r) b[r] += carry; }
#pragma unroll
        for (int r = 0; r < 16; ++r) { const int tok = 32 * tb + crow(r, hi); const float bl = b[r] * LOG2E; Ep[tok * 64 + 32 * db + r32] = __builtin_amdgcn_exp2f(bl); Em[tok * 64 + 32 * db + r32] = __builtin_amdgcn_exp2f(-bl); }
        if (tb == NTB - 1 && hi == 1) an[(size_t)u * 64 + 32 * db + r32] = __builtin_amdgcn_exp2f(b[15] * LOG2E);
    }
    __syncthreads();
    TSEC_E(2); TSEC_B(3);
    if (tid < L * 8) {
        const int tok = tok2, c8 = c82;
        const f32x4 e0 = *(const LAS f32x4*)(Ep + tok * 64 + 8 * c8), e1 = *(const LAS f32x4*)(Ep + tok * 64 + 8 * c8 + 4), m0 = *(const LAS f32x4*)(Em + tok * 64 + 8 * c8), m1 = *(const LAS f32x4*)(Em + tok * 64 + 8 * c8 + 4);
        u32x4 qo, ko;
        qo.x = pk2(bflo(qv.x) * e0[0], bfhi(qv.x) * e0[1]); qo.y = pk2(bflo(qv.y) * e0[2], bfhi(qv.y) * e0[3]); qo.z = pk2(bflo(qv.z) * e1[0], bfhi(qv.z) * e1[1]); qo.w = pk2(bflo(qv.w) * e1[2], bfhi(qv.w) * e1[3]);
        ko.x = pk2(bflo(kv.x) * m0[0], bfhi(kv.x) * m0[1]); ko.y = pk2(bflo(kv.y) * m0[2], bfhi(kv.y) * m0[3]); ko.z = pk2(bflo(kv.z) * m1[0], bfhi(kv.z) * m1[1]); ko.w = pk2(bflo(kv.w) * m1[2], bfhi(kv.w) * m1[3]);
        *(u32x4*)qp = qo; *(u32x4*)kp = ko;
        *(LAS u32x4*)(kimg + ((c8 >> 2) * 4 + (tok >> 4)) * 1024 + (tok & 15) * 64 + (c8 & 3) * 16) = ko;
    }
    __syncthreads();
    TSEC_E(3); TSEC_B(4);
    {
        const int eb = wave & 3, db2 = wave >> 2; f32x16 acc;
#pragma unroll
        for (int r = 0; r < 16; ++r) acc[r] = 0.f;
#pragma unroll
        for (int ks = 0; ks < NKS; ++ks) { const bf16x8 va = cat8(vtr(vimg + (eb * 4 + ks) * 1024 + vp0), vtr(vimg + (eb * 4 + ks) * 1024 + vp0 + 512));
            const bf16x8 kb = cat8(vtr(kimg + (db2 * 4 + ks) * 1024 + vp0), vtr(kimg + (db2 * 4 + ks) * 1024 + vp0 + 512));
            acc = __builtin_amdgcn_mfma_f32_32x32x16_bf16(va, kb, acc, 0, 0, 0); }
        bf16_t* dp = ds + (size_t)u * 8192 + 32 * db2 + r32;
        if (L == 32) {
            const int d = 32 * db2 + r32; const float a = Ep[(L - 1) * 64 + d]; float sv[16];
#pragma unroll
            for (int r = 0; r < 16; ++r) sv[r] = s0[(size_t)d * 128 + 32 * eb + crow(r, hi)];
#pragma unroll
            for (int r = 0; r < 16; ++r) { const int e = 32 * eb + crow(r, hi); dp[e * 64] = (bf16_t)f2bf(sv[r]); sout[(size_t)d * 128 + e] = a * (sv[r] + acc[r]); }
        } else {
#pragma unroll
            for (int r = 0; r < 16; ++r) dp[(32 * eb + crow(r, hi)) * 64] = (bf16_t)f2bf(acc[r]); }
    }
    TSEC_E(4); TSEC_E(5);
}
template <int L>
__device__ __forceinline__ void gla3_task(bf16_t* act, const bf16_t* ds, const float* gn, int u, int tok0, int h, int ib, LAS unsigned char* vimg, int lane) {
    constexpr int NKS = L / 16;
    const int r32 = lane & 31, hi = lane >> 5;
    const int vp0 = ((lane >> 4) & 1) * 32 + (lane & 3) * 8 + (4 * hi + ((lane & 15) >> 2)) * 64;
    LGKM_WAIT();
#pragma unroll
    for (int eb = 0; eb < 4; ++eb)
#pragma unroll
        for (int ks = 0; ks < NKS; ++ks) dma16(act + (size_t)(tok0 + 16 * ks + (lane >> 2)) * APITCH + C_VB + h * 128 + 32 * eb + (lane & 3) * 8, vimg + (eb * 4 + ks) * 1024);
    bf16x8 qf[4], sa[4][4], kfr[2][4];
#pragma unroll
    for (int s = 0; s < 4; ++s) qf[s] = *(const bf16x8*)(act + (size_t)(tok0 + 32 * ib + r32) * APITCH + C_QB + h * 64 + 16 * s + 8 * hi);
    const bf16_t* sg = ds + (size_t)u * 8192;
#pragma unroll
    for (int eb = 0; eb < 4; ++eb)
#pragma unroll
        for (int s = 0; s < 4; ++s) sa[eb][s] = *(const bf16x8*)(sg + (32 * eb + r32) * 64 + 16 * s + 8 * hi);
#pragma unroll
    for (int jb = 0; jb < 2; ++jb)
#pragma unroll
        for (int s = 0; s < 4; ++s) kfr[jb][s] = *(const bf16x8*)(act + (size_t)(tok0 + 32 * (jb <= ib ? jb : 0) + r32) * APITCH + C_KB + h * 64 + 16 * s + 8 * hi);
    VM_WAIT();
    f32x16 acc[4];
#pragma unroll
    for (int eb = 0; eb < 4; ++eb)
#pragma unroll
        for (int r = 0; r < 16; ++r) acc[eb][r] = 0.f;
#pragma unroll
    for (int eb = 0; eb < 4; ++eb)
#pragma unroll
        for (int s = 0; s < 4; ++s) acc[eb] = __builtin_amdgcn_mfma_f32_32x32x16_bf16(sa[eb][s], qf[s], acc[eb], 0, 0, 0);
    bf16_t* rowp = act + (size_t)(tok0 + 32 * ib + r32) * APITCH + C_RB + h * 128;
    u32x2 rv[4][4]; f32x4 gv[4][4];
#pragma unroll
    for (int eb = 0; eb < 4; ++eb)
#pragma unroll
        for (int q = 0; q < 4; ++q) { const int e0 = 32 * eb + 8 * q + 4 * hi; rv[eb][q] = *(const u32x2*)(rowp + e0); gv[eb][q] = *(const f32x4*)(gn + e0); }
#pragma unroll
    for (int jb = 0; jb < 2; ++jb) {
        if (jb > ib) break;
        f32x16 X;
#pragma unroll
        for (int r = 0; r < 16; ++r) X[r] = 0.f;
#pragma unroll
        for (int s = 0; s < 4; ++s) X = __builtin_amdgcn_mfma_f32_32x32x16_bf16(kfr[jb][s], qf[s], X, 0, 0, 0);
        if (jb == ib) {
#pragma unroll
            for (int r = 0; r < 16; ++r) if (crow(r, hi) > r32) X[r] = 0.f; }
        const u32x4 x0 = (u32x4){pk2(X[0], X[1]), pk2(X[2], X[3]), pk2(X[4], X[5]), pk2(X[6], X[7])}, x1 = (u32x4){pk2(X[8], X[9]), pk2(X[10], X[11]), pk2(X[12], X[13]), pk2(X[14], X[15])};
#pragma unroll
        for (int eb = 0; eb < 4; ++eb)
#pragma unroll
            for (int s2 = 0; s2 < 2; ++s2) { const int ks = 2 * jb + s2; const bf16x8 vf = cat8(vtr(vimg + (eb * 4 + ks) * 1024 + vp0), vtr(vimg + (eb * 4 + ks) * 1024 + vp0 + 512));
                acc[eb] = __builtin_amdgcn_mfma_f32_32x32x16_bf16(vf, __builtin_bit_cast(bf16x8, s2 ? x1 : x0), acc[eb], 0, 0, 0); }
    }
    float ssq = 0.f;
#pragma unroll
    for (int eb = 0; eb < 4; ++eb)
#pragma unroll
        for (int r = 0; r < 16; ++r) ssq += acc[eb][r] * acc[eb][r];
    ssq += __shfl_xor(ssq, 32);
    const float rs = __builtin_amdgcn_rsqf(ssq * (1.0f / 128.0f) + EPS);
#pragma unroll
    for (int eb = 0; eb < 4; ++eb)
#pragma unroll
        for (int q = 0; q < 4; ++q) { const int e0 = 32 * eb + 8 * q + 4 * hi; const f32x4 g = gv[eb][q];
            const float r0 = bflo(rv[eb][q].x), r1 = bfhi(rv[eb][q].x), r2 = bflo(rv[eb][q].y), r3 = bfhi(rv[eb][q].y);
            u32x2 w; w.x = pk2(acc[eb][4 * q] * rs * g[0] * r0 * fast_sigmoid(r0), acc[eb][4 * q + 1] * rs * g[1] * r1 * fast_sigmoid(r1));
            w.y = pk2(acc[eb][4 * q + 2] * rs * g[2] * r2 * fast_sigmoid(r2), acc[eb][4 * q + 3] * rs * g[3] * r3 * fast_sigmoid(r3)); *(u32x2*)(rowp + e0) = w; }
}

template <int GI>
__device__ __forceinline__ void pool_task(bf16_t* act, const float* hist  , const bf16_t* pmt, const float* pscale, int row0, int pos0, LAS unsigned char* ptile, int lane) {
    constexpr int W = 2 << GI;
    const int r32 = lane & 31, hi = lane >> 5;
    const int col = 128 * GI + 2 * lane;
    f32x2 uv[W - 1 + 32];
    if (hist != nullptr) {
#pragma unroll
        for (int j = 0; j < W - 1; ++j) uv[j] = *(const f32x2*)(hist + (size_t)(15 + j - (W - 1)) * 512 + col);
    } else {
        unsigned hw[W - 1];
#pragma unroll
        for (int j = 0; j < W - 1; ++j) { const int r = row0 + j - (W - 1); hw[j] = *(const unsigned*)(act + (size_t)(r < 0 ? 0 : r) * APITCH + C_UA + col); }
#pragma unroll
        for (int j = 0; j < W - 1; ++j) { const bool ok = row0 + j - (W - 1) >= 0; uv[j] = (f32x2){ok ? bflo(hw[j]) : 0.f, ok ? bfhi(hw[j]) : 0.f}; }
    }
    {
        unsigned cw[32];
#pragma unroll
        for (int t = 0; t < 32; ++t) cw[t] = *(const unsigned*)(act + (size_t)(row0 + t) * APITCH + C_UA + col);
#pragma unroll
        for (int t = 0; t < 32; ++t) uv[W - 1 + t] = (f32x2){bflo(cw[t]), bfhi(cw[t])};
    }
    f32x2 sum = {0.f, 0.f};
#pragma unroll
    for (int j = 0; j < W - 1; ++j) sum += uv[j];
    LGKM_WAIT();
#pragma unroll
    for (int t = 0; t < 32; ++t) { sum += uv[t + W - 1]; const int pos = pos0 + t; const float inv = 1.0f / (float)(pos + 1 < W ? pos + 1 : W);
        const f32x2 p = sum * inv - uv[t + W - 1]; *(LAS unsigned*)(ptile + (t * 136 + 2 * lane) * 2) = pk2(p[0], p[1]); sum -= uv[t]; }
    f32x16 acc[4];
#pragma unroll
    for (int db = 0; db < 4; ++db)
#pragma unroll
        for (int r = 0; r < 16; ++r) acc[db][r] = 0.f;
#pragma unroll
    for (int sh = 0; sh < 2; ++sh) {
        bf16x8 mf[4][4];
#pragma unroll
        for (int s = 0; s < 4; ++s)
#pragma unroll
            for (int db = 0; db < 4; ++db) mf[s][db] = *(const bf16x8*)(pmt + (size_t)GI * 16384 + (32 * db + r32) * 128 + 16 * (4 * sh + s) + 8 * hi);
        asm volatile("" ::: "memory");
#pragma unroll
        for (int s = 0; s < 4; ++s) { const bf16x8 pf = *(const LAS bf16x8*)(ptile + (r32 * 136 + 16 * (4 * sh + s) + 8 * hi) * 2);
#pragma unroll
            for (int db = 0; db < 4; ++db) acc[db] = __builtin_amdgcn_mfma_f32_32x32x16_bf16(mf[s][db], pf, acc[db], 0, 0, 0); }
    }
    bf16_t* rowp = act + (size_t)(row0 + r32) * APITCH + C_YA + 128 * GI;
    f32x4 sc[4][4];
#pragma unroll
    for (int db = 0; db < 4; ++db)
#pragma unroll
        for (int q = 0; q < 4; ++q) sc[db][q] = *(const f32x4*)(pscale + 128 * GI + 32 * db + 8 * q + 4 * hi);
#pragma unroll
    for (int db = 0; db < 4; ++db)
#pragma unroll
        for (int q = 0; q < 4; ++q) { const int d0 = 32 * db + 8 * q + 4 * hi;
            u32x2 w; w.x = pk2(acc[db][4 * q] * sc[db][q][0], acc[db][4 * q + 1] * sc[db][q][1]); w.y = pk2(acc[db][4 * q + 2] * sc[db][q][2], acc[db][4 * q + 3] * sc[db][q][3]); *(u32x2*)(rowp + d0) = w; }
}

#define XB_TMO      128
#define XB_XCNT(j)  (256  + 64 * (j))
#define XB_XSUB(j)  (1280 + 64 * (j))
#define XB_XGEN(j)  (2304 + 64 * (j))
#define XB_TOP      3328
#define XB_TOPGEN   3392
#define XCD_BAR_WORDS 3456
#define XB_SPIN_CAP (1u << 22)
__device__ __forceinline__ unsigned xb_ld(unsigned* p)              { return __hip_atomic_load(p, __ATOMIC_RELAXED, __HIP_MEMORY_SCOPE_AGENT); }
__device__ __forceinline__ unsigned xb_add(unsigned* p, unsigned v) { return __hip_atomic_fetch_add(p, v, __ATOMIC_RELAXED, __HIP_MEMORY_SCOPE_AGENT); }
__device__ __forceinline__ unsigned xb_xcc_id() { return (unsigned)__builtin_amdgcn_s_getreg((3 << 11) | 20) & 0xFu; }
#define XB_SPIN(cond, bar) do { unsigned _sp = 0; while (cond) { __builtin_amdgcn_s_sleep(1); \
    if ((++_sp & 255u) == 0u) { if (xb_ld(&(bar)[XB_TMO])) break; if (_sp > XB_SPIN_CAP) { atomicAdd(&(bar)[XB_TMO], 1u); break; } } } } while (0)
struct XcdBarrier { unsigned* bar; unsigned x; volatile LAS unsigned* st; };
__device__ __forceinline__ XcdBarrier xcd_barrier_post(unsigned* bar, volatile LAS unsigned* st) {
    XcdBarrier b; b.bar = bar; b.x = xb_xcc_id(); b.st = st;
    if (threadIdx.x == 0) (void)xb_add(&bar[XB_XCNT(b.x)], 1u);
    return b;
}
__device__ __forceinline__ void xcd_barrier_complete(unsigned* bar, unsigned x, unsigned& nloc, unsigned& nx) {
    const unsigned G = gridDim.x * gridDim.y * gridDim.z;
    unsigned sum, cnt, mine, sp = 0u;
    for (;;) {
        sum = 0u; cnt = 0u; mine = 0u;
#pragma unroll
        for (unsigned j = 0; j < 16; ++j) { const unsigned c = xb_ld(&bar[XB_XCNT(j)]); sum += c; cnt += (c > 0u) ? 1u : 0u; mine = (j == x) ? c : mine; }
        if (sum == G) break;
        __builtin_amdgcn_s_sleep(1);
        if ((++sp & 255u) == 0u) { if (xb_ld(&bar[XB_TMO])) break; if (sp > XB_SPIN_CAP) { atomicAdd(&bar[XB_TMO], 1u); break; } }
    }
    nloc = mine > 0u ? mine : 1u; nx = cnt > 0u ? cnt : 1u;
}
__device__ __forceinline__ void xcd_barrier(const XcdBarrier& b) {
    asm volatile("s_waitcnt vmcnt(0)" ::: "memory");
    __syncthreads();
    if (threadIdx.x == 0) {
        unsigned* bar = b.bar;
        __builtin_amdgcn_s_waitcnt(0);
        unsigned nloc = b.st[0], nx = b.st[1];
        if (nloc == 0u) { xcd_barrier_complete(bar, b.x, nloc, nx); b.st[0] = nloc; b.st[1] = nx; }
        const unsigned old = xb_add(&bar[XB_XSUB(b.x)], 1u);
        const unsigned gen = old / nloc;
        if (old + 1u == (gen + 1u) * nloc) {
            __builtin_amdgcn_fence(__ATOMIC_RELEASE, "agent");
            asm volatile("s_waitcnt vmcnt(0)" ::: "memory");
            const unsigned og = xb_add(&bar[XB_TOP], 1u);
            const unsigned tg = og / nx;
            if (og + 1u == (tg + 1u) * nx) xb_add(&bar[XB_TOPGEN], 1u);
            else XB_SPIN(xb_ld(&bar[XB_TOPGEN]) == tg, bar);
            __builtin_amdgcn_fence(__ATOMIC_ACQUIRE, "agent");
            xb_add(&bar[XB_XGEN(b.x)], 1u);
            asm volatile("s_waitcnt vmcnt(0)" ::: "memory");
        } else {
            XB_SPIN(xb_ld(&bar[XB_XGEN(b.x)]) == gen, bar);
            __builtin_amdgcn_fence(__ATOMIC_ACQUIRE, "agent");
            asm volatile("s_waitcnt vmcnt(0)" ::: "memory");
        }
    }
    __syncthreads();
}

__device__ __forceinline__ float wave_sum(float v) {
#pragma unroll
    for (int o = 1; o < 64; o <<= 1) v += __shfl_xor(v, o);
    return v;
}
__device__ __forceinline__ int src_col(int sel, int n) {
    if (sel == 1) return n < 2064 ? n : (n < 2304 ? -1 : n - 240);
    if (sel == 2) { const int pn = n >> 8, jj = n & 255; return jj < 128 ? 128 * pn + jj : 2816 + 128 * pn + (jj - 128); }
    return n;
}
__device__ __forceinline__ void tr_item(const float* W, int ldw, int sel, int coff, const float* gain, bf16_t* WT, int dpitch, int kb, int nb, LAS float* scr, int lane) {
    const int k0 = 64 * kb, n0 = 32 * nb, n4 = lane & 7, kr = lane >> 3;
    int sc[4];
#pragma unroll
    for (int e = 0; e < 4; ++e) sc[e] = src_col(sel, n0 + 4 * n4 + e);
    const bool vec = (sc[0] >= 0) && (sc[3] == sc[0] + 3) && (((coff + sc[0]) & 3) == 0) && ((ldw & 3) == 0);
    f32x4 v[8];
#pragma unroll
    for (int i = 0; i < 8; ++i) { const int kk = 8 * i + kr; const float* rp = W + (size_t)(k0 + kk) * ldw + coff;
        if (vec) v[i] = *(const f32x4*)(rp + sc[0]);
        else {
#pragma unroll
            for (int e = 0; e < 4; ++e) v[i][e] = sc[e] >= 0 ? rp[sc[e]] : 0.f; } }
    LGKM_WAIT();
#pragma unroll
    for (int i = 0; i < 8; ++i) { const int kk = 8 * i + kr; const float g = gain ? gain[k0 + kk] : 1.f;
#pragma unroll
        for (int e = 0; e < 4; ++e) scr[kk * 33 + 4 * n4 + e] = v[i][e] * g; }
    LGKM_WAIT(); asm volatile("" ::: "memory");
    const int c = lane & 7;
#pragma unroll
    for (int j = 0; j < 4; ++j) { const int n = (lane >> 3) + 8 * j; const LAS float* s = scr + (8 * c) * 33 + n; const int dn = n0 + n;
        float rsc = 1.f; if (sel == 1) rsc = (dn >= 512 && dn < 768) ? 0.125f : ((dn >= 2304 && dn < 2816) ? 0.125f * LOG2E : 1.f);
        u32x4 o; o.x = pk2(s[0 * 33] * rsc, s[1 * 33] * rsc); o.y = pk2(s[2 * 33] * rsc, s[3 * 33] * rsc); o.z = pk2(s[4 * 33] * rsc, s[5 * 33] * rsc); o.w = pk2(s[6 * 33] * rsc, s[7 * 33] * rsc);
        *(u32x4*)(WT + (size_t)dn * dpitch + k0 + 8 * c) = o; }
    LGKM_WAIT(); asm volatile("" ::: "memory");
}
__device__ __forceinline__ void phase_wconv(const Params& p, int l, LAS unsigned char* lds, int tid, int wave, int lane, int vcu, int G) {
    LAS float* scr = (LAS float*)(lds + wave * 16384);
    unsigned char* ws = p.ws; bf16_t* wbase = (bf16_t*)(ws + WS_W);
    const int gw = vcu * 8 + wave, NGW = G * 8;
    const float* w_in = p.in[7] + (size_t)l * DM * DIN; const float* ang = p.in[6] + l * DM; const float* fng = p.in[16] + l * DM;
    constexpr int I0 = 120 * 16, I1 = 96 * 16, I2 = 3 * 32 * 8, I3 = 32 * 16, I4 = 176 * 16, I5 = 32 * 44, I6 = 4 * 4 * 2, NIT = I0 + I1 + I2 + I3 + I4 + I5 + I6;
    for (int it = gw; it < NIT; it += NGW) {
        int r = it;
        if (r < I0) { tr_item(w_in, DIN, 1, 0, ang, wbase + W_IN / 2, 1024, r % 16, r / 16, scr, lane); continue; } r -= I0;
        if (r < I1) { tr_item(w_in, DIN, 0, 3600, ang, wbase + W_G / 2, 1024, r % 16, r / 16, scr, lane); continue; } r -= I1;
        if (r < I2) { const int g = r / 256, rr = r % 256; tr_item(p.in[14] + (size_t)(l * 3 + g) * 512 * 1024, 1024, 0, 0, nullptr, wbase + W_B / 2 + (size_t)g * 1024 * 1024, 1024, rr % 8, rr / 8, scr, lane); continue; } r -= I2;
        if (r < I3) { tr_item(p.in[15] + (size_t)l * 1024 * 1024, 1024, 0, 0, nullptr, wbase + W_O / 2, 1024, r % 16, r / 16, scr, lane); continue; } r -= I3;
        if (r < I4) { tr_item(p.in[17] + (size_t)l * 1024 * 5632, 5632, 2, 0, fng, wbase + W_FI / 2, 1024, r % 16, r / 16, scr, lane); continue; } r -= I4;
        if (r < I5) { tr_item(p.in[18] + (size_t)l * 2816 * 1024, 1024, 0, 0, nullptr, wbase + W_FO / 2, 2816, r % 44, r / 44, scr, lane); continue; } r -= I5;
        { const int g = r / 8, rr = r % 8; tr_item(p.in[11] + (size_t)(l * 4 + g) * 128 * 128, 128, 0, 0, nullptr, (bf16_t*)(ws + WS_PMT) + (size_t)g * 16384, 128, rr % 2, rr / 2, scr, lane); }
    }
    const int gt = vcu * 512 + tid, NGT = G * 512;
    for (int i = gt; i < 4096; i += NGT) { const int col = i >> 4, k = i & 15; ((bf16_t*)(ws + WS_W2T))[i] = (bf16_t)f2bf(p.in[8][(size_t)l * 16 * 256 + k * 256 + col]); }
    for (int i = gt; i < 8 * 260; i += NGT) { const int h = i / 260, j = i % 260; ((float*)(ws + WS_BIAS))[i] = j < 257 ? p.in[13][(size_t)(l * 8 + h) * 257 + j] * LOG2E : 0.f; }
    { const float* ck = p.in[4] + (size_t)l * 2097152; const float* cv = p.in[5] + (size_t)l * 2097152; bf16_t* kd = (bf16_t*)(ws + WS_KVS);
        for (int i = gt; i < 2 * 262144; i += NGT) { const int which = i >= 262144, j = which ? i - 262144 : i; const float* s = (which ? cv : ck) + (size_t)j * 8; const f32x4 a = *(const f32x4*)s, b = *(const f32x4*)(s + 4);
            u32x4 o; o.x = pk2(a[0], a[1]); o.y = pk2(a[2], a[3]); o.z = pk2(b[0], b[1]); o.w = pk2(b[2], b[3]); *(u32x4*)(kd + (size_t)which * 2097152 + (size_t)j * 8) = o; } }
    if (l == 0) {
        bf16_t* act = (bf16_t*)(ws + WS_ACT); float* ss = (float*)(ws + WS_SS);
        for (int m = gw; m < MROWS; m += NGW) { const float* xr = m < SEQ ? p.in[0] + (size_t)m * DM : p.in[1] + (size_t)(m - SEQ) * DM; float q = 0.f;
#pragma unroll
            for (int j = 0; j < 4; ++j) { const f32x4 v = *(const f32x4*)(xr + 256 * j + 4 * lane); q += (v[0] * v[0] + v[1] * v[1]) + (v[2] * v[2] + v[3] * v[3]);
                u32x2 w; w.x = pk2(v[0], v[1]); w.y = pk2(v[2], v[3]); *(u32x2*)(act + (size_t)m * APITCH + C_XB + 256 * j + 4 * lane) = w; }
            q = wave_sum(q); if (lane < 16) ss[(size_t)m * 16 + lane] = lane == 0 ? q : 0.f; }
    }
}

__device__ __forceinline__ void phase_scan(const Params& p, int l, LAS unsigned char* lds, int tid, int vcu, int G) {
    unsigned char* ws = p.ws; bf16_t* ds = (bf16_t*)(ws + WS_DS); const float* an = (const float*)(ws + WS_AN);
    LAS float* xa = (LAS float*)lds;
    LAS float* xb = xa + 512;
    for (int blk = vcu; blk < 512; blk += G) {
        const int seg = tid >> 6, el = blk * 64 + (tid & 63), h = el >> 13, idx = el & 8191, d = idx & 63, e = idx >> 6;
        bf16_t* dsp = ds + (size_t)(seg * 32) * 32768 + (size_t)h * 8192 + idx; const float* anp = an + (size_t)(seg * 32) * 256 + h * 64 + d;
        unsigned short dq[32]; float aq[32];
#pragma unroll
        for (int j = 0; j < 32; ++j) { dq[j] = dsp[(size_t)j * 32768]; aq[j] = anp[(size_t)j * 256]; }
        float A = 1.f, B = 0.f;
#pragma unroll
        for (int j = 0; j < 32; ++j) { B = aq[j] * (B + bf2f(dq[j])); A *= aq[j]; }
        xa[seg * 64 + (tid & 63)] = A; xb[seg * 64 + (tid & 63)] = B;
        __syncthreads();
        float S = 0.f;
#pragma unroll
        for (int k = 0; k < 7; ++k) if (k < seg) S = xa[k * 64 + (tid & 63)] * S + xb[k * 64 + (tid & 63)];
#pragma unroll
        for (int j = 0; j < 32; ++j) { dsp[(size_t)j * 32768] = (bf16_t)f2bf(S); S = aq[j] * (S + bf2f(dq[j])); }
        if (seg == 7) p.out[O_GLAP + (size_t)l * 32768 + (size_t)h * 8192 + d * 128 + e] = S;
        __syncthreads();
    }
}

__device__ __forceinline__ void copy8(const bf16_t* s, float* d) { const u32x4 v = *(const u32x4*)s; *(f32x4*)d = (f32x4){bflo(v.x), bfhi(v.x), bflo(v.y), bfhi(v.y)}; *(f32x4*)(d + 4) = (f32x4){bflo(v.z), bfhi(v.z), bflo(v.w), bfhi(v.w)}; }
__device__ __forceinline__ void phase_copies(const Params& p, int l, int tid, int vcu, int G) {
    const bf16_t* act = (const bf16_t*)(p.ws + WS_ACT); float* out = p.out;
    const int gt = vcu * 512 + tid, NGT = G * 512;
    constexpr int NKP = 512 * 64, NKS_ = 256 * 64, NPP = 15 * 64, NPS = 8 * 15 * 64, NTOT = 2 * NKP + 2 * NKS_ + NPP + NPS;
    for (int i = gt; i < NTOT; i += NGT) {
        int r = i;
        if (r < 2 * NKP) { const int v = r >= NKP; if (v) r -= NKP; const int row = r >> 6, c8 = r & 63; copy8(act + (size_t)(SEQ - 512 + row) * APITCH + (v ? C_VC : C_KC) + 8 * c8, out + (v ? O_VP : O_KP) + (size_t)l * 262144 + (size_t)row * 512 + 8 * c8); continue; } r -= 2 * NKP;
        if (r < 2 * NKS_) { const int v = r >= NKS_; if (v) r -= NKS_; const int row = r >> 6, c8 = r & 63; copy8(act + (size_t)(SEQ + row) * APITCH + (v ? C_VC : C_KC) + 8 * c8, out + (v ? O_VS : O_KS) + (size_t)l * 131072 + (size_t)row * 512 + 8 * c8); continue; } r -= 2 * NKS_;
        if (r < NPP) { const int row = r >> 6, c8 = r & 63; copy8(act + (size_t)(SEQ - 15 + row) * APITCH + C_UA + 8 * c8, out + O_POOLP + (size_t)l * 7680 + (size_t)row * 512 + 8 * c8); continue; } r -= NPP;
        { const int b = r / (15 * 64), rr = r % (15 * 64), row = rr >> 6, c8 = rr & 63; copy8(act + (size_t)(SEQ + 32 * b + 17 + row) * APITCH + C_UA + 8 * c8, out + O_POOLS + (size_t)l * 61440 + (size_t)(b * 15 + row) * 512 + 8 * c8); }
    }
}

constexpr int CW_BAR = 4096;
constexpr int NPHASE = 19;

__global__ void __launch_bounds__(512, 2) mk_fwd(Params p) {
    extern __shared__ __attribute__((aligned(16))) unsigned char lds_raw[];
    LAS unsigned char* lds = (LAS unsigned char*)lds_raw;
    const int tid0 = threadIdx.x;
    const int G0 = gridDim.x; const int bx = blockIdx.x;
    volatile LAS unsigned* MISC = (volatile LAS unsigned*)(lds + LDS_MISC);
    if (tid0 < 64) MISC[tid0] = 0u;
    __syncthreads();
    unsigned* ctl = (unsigned*)(p.ws + WS_CTL);
    XcdBarrier bar; bar.bar = ctl + CW_BAR; bar.x = 0; bar.st = nullptr;
    if (p.ph_hi - p.ph_lo > 1) bar = xcd_barrier_post(ctl + CW_BAR, MISC + 8);

    unsigned long long ts_acc = 0ull;
    for (int ph = p.ph_lo; ph < p.ph_hi; ++ph) {
        unsigned long long ts0 = 0ull; if (TS_MASK) ts0 = __builtin_amdgcn_s_memrealtime();
        if ((SEC_PH >> ph) & 1) { TSEC_B(10); }
        int tid = tid0; asm volatile("" : "+v"(tid));
        const int lane = tid & 63, wave = __builtin_amdgcn_readfirstlane(tid >> 6);
        int G = G0; asm volatile("" : "+s"(G));
        const int vcu = (G % 8 == 0) ? (bx % 8) * (G / 8) + bx / 8 : bx;
        unsigned char* ws = p.ws; asm volatile("" : "+s"(ws));
        bf16_t* act = (bf16_t*)(ws + WS_ACT); float* ss = (float*)(ws + WS_SS); bf16_t* wbase = (bf16_t*)(ws + WS_W);
        const int l = ph == 0 ? 0 : (ph - 1) / 9, sub = ph == 0 ? -1 : (ph - 1) % 9;
        if (ph == 0) { if (PHON(9)) for (int rep = 0; rep < REP_WCONV; ++rep) { int t2 = tid; asm volatile("" : "+v"(t2)); phase_wconv(p, 0, lds, t2, wave, t2 & 63, vcu, G); } }
        else if (sub == 0 && PHON(0)) {
            typedef SchedDense<64, 27, true, (unsigned)(WS_ACT + C_XB * 2), (unsigned)(WS_W + W_IN), 16, 2048u> SA;
            SA S{G, bx}; EpiA E{act, ss, p.out, ws};
            for (int rep = 0; rep < REP_PA; ++rep) { int t2 = tid; asm volatile("" : "+v"(t2)); pg8::gemm_phase<EpiA, SA, true, APITCH, 1024>(lds, (const char*)ws, S, E, t2); }
        } else if (sub == 1 && PHON(1)) {
            const float* bsrc = (const float*)(ws + WS_BIAS); LAS float* tab = (LAS float*)(lds + LDS_BIAS);
            for (int i = tid; i < 8 * 260; i += 512) tab[i] = bsrc[i];
            __syncthreads();
            LAS unsigned char* vbuf = lds + wave * 16384; LAS float* wsf = (LAS float*)(lds + LDS_WSF) + wave * 128;
            const bf16_t* kvs = (const bf16_t*)(ws + WS_KVS);
            if (!DSKIP(1)) for (int U = vcu; U < 512; U += G) { int ln = lane; asm volatile("" : "+v"(ln));
                attn_unit_wg(act, U >> 6, 4 * (U & 63), lds, lds + 32768 + wave * 4096, wsf, tab + (U >> 6) * 260, wave, ln); }
            __syncthreads();
            if (!DSKIP(1)) for (int U = G - 1 - vcu; U < 64; U += G) { int ln = lane; asm volatile("" : "+v"(ln));
                attn_sample_wg(act, kvs, U >> 3, U & 7, lds, (LAS float*)(lds + LDS_WSF), tab + (U & 7) * 260, tid, wave, ln); }
            VM_WAIT(); LGKM_WAIT();
            __syncthreads();
            const bf16_t* w2t = (const bf16_t*)(ws + WS_W2T); const float* bgate = p.in[9] + l * 256; float* an = (float*)(ws + WS_AN); bf16_t* ds = (bf16_t*)(ws + WS_DS);
            int cnt = 0;
            if (!DSKIP(2)) for (int u = vcu; u < 1024; u += G) { gla1_unit<64>(act, w2t, bgate, an, ds, u, (u >> 2) * 64, u & 3, cnt & 1, lds, tid, wave, lane, nullptr, nullptr); ++cnt; }
            if (!DSKIP(2)) for (int su = vcu; su < 32; su += G) { gla1_unit<32>(act, w2t, bgate, an, ds, 1024 + su, SEQ + 32 * (su >> 2), su & 3, cnt & 1, lds, tid, wave, lane, p.in[3] + (size_t)l * 262144 + (size_t)su * 8192, p.out + O_GLAS + (size_t)l * 262144 + (size_t)su * 8192); ++cnt; }
            if (!DSKIP(4)) phase_copies(p, l, tid, vcu, G);
        } else if (sub == 2 && PHON(2)) {
            phase_scan(p, l, lds, tid, vcu, G);
            {
                const int gw = vcu * 8 + wave, NGW = G * 8; LAS unsigned char* wl = lds + wave * 16384;
                const bf16_t* pmt = (const bf16_t*)(ws + WS_PMT); const float* psc = p.in[12] + l * 512;
                if (!DSKIP(16)) for (int t = gw; t < 520 * 4; t += NGW) { int ln = lane; asm volatile("" : "+v"(ln)); const int tt = t >> 2, g = t & 3; const bool sm = tt >= 512;
                    const int row0 = sm ? SEQ + 32 * (tt - 512) : 32 * tt, pos0 = sm ? 2048 : 32 * tt; const float* hist = sm ? p.in[2] + (size_t)((l * 8 + (tt - 512)) * 15) * 512 : nullptr;
                    if (g == 0) pool_task<0>(act, hist, pmt, psc, row0, pos0, wl, ln); else if (g == 1) pool_task<1>(act, hist, pmt, psc, row0, pos0, wl, ln);
                    else if (g == 2) pool_task<2>(act, hist, pmt, psc, row0, pos0, wl, ln); else pool_task<3>(act, hist, pmt, psc, row0, pos0, wl, ln); }
                const bf16_t* dsb = (const bf16_t*)(ws + WS_DS); const float* gn = p.in[10] + l * 128;
                if (!DSKIP(8)) for (int t = NGW - 1 - gw; t < 32; t += NGW) { int ln = lane; asm volatile("" : "+v"(ln)); gla3_task<32>(act, dsb, gn, 1024 + t, SEQ + 32 * (t >> 2), t & 3, 0, wl, ln); }
            }
        }
        else if (sub == 3 && PHON(3)) {
            const int gw = vcu * 8 + wave, NGW = G * 8; LAS unsigned char* wl = lds + wave * 16384;
            const bf16_t* ds = (const bf16_t*)(ws + WS_DS); const float* gn = p.in[10] + l * 128;
            if (!DSKIP(8)) for (int t = gw; t < 2048; t += NGW) { int ln = lane; asm volatile("" : "+v"(ln)); const int u = t >> 1; gla3_task<64>(act, ds, gn, u, (u >> 2) * 64, u & 3, t & 1, wl, ln); }
        } else if (sub == 4 && PHON(4)) {
            SchedMerge S{G, bx}; EpiMerge E{act, p.out, ws};
            for (int rep = 0; rep < REP_PC; ++rep) { int t2 = tid; asm volatile("" : "+v"(t2)); pg8::gemm_phase<EpiMerge, SchedMerge, true, APITCH, 1024>(lds, (const char*)ws, S, E, t2); }
            LAS float* red = (LAS float*)lds;
            for (int T = vcu; T < 256; T += G) { const int rb = T >> 4, cb = T & 15, row0 = SEQ + 16 * rb, col0 = 64 * cb, row = row0 + (tid >> 5), col = col0 + 2 * (tid & 31);
                f32x4 accb[3][4]; f32x2 bv[3]; unsigned gq[3];
#pragma unroll
                for (int g = 0; g < 3; ++g) gq[g] = *(const unsigned*)(g_row(p.out, ws, row) + g * 1024 + col);
#pragma unroll
                for (int g = 0; g < 3; ++g) { const int yc = g == 0 ? C_YA : g == 1 ? C_YB : C_YC; small_tile_partial<2>(act + (size_t)row0 * APITCH + yc, APITCH, wbase + W_B / 2 + (size_t)(g * 1024 + col0) * 1024, 1024, wave, lane, accb[g]); }
                small_tile_reduce3(red, accb, wave, lane, tid, bv);
                f32x2 m2 = {0.f, 0.f};
#pragma unroll
                for (int g = 0; g < 3; ++g) { m2[0] += bflo(gq[g]) * bv[g][0]; m2[1] += bfhi(gq[g]) * bv[g][1]; }
                *(unsigned*)(act + (size_t)row * APITCH + C_M + col) = pk2(m2[0], m2[1]); }
        } else if ((sub == 5 || sub == 7) && PHON(5)) {
            const bool fo = sub == 7; EpiRes<false> E{p.out, act, ss};
            if (!fo) { typedef SchedDense<64, 4, false, (unsigned)(WS_ACT + C_M * 2), (unsigned)(WS_W + W_O), 16, 2048u> SD; SD S{G, bx}; pg8::gemm_phase<EpiRes<false>, SD, true, APITCH, 1024>(lds, (const char*)ws, S, E, tid); }
            else { typedef SchedDense<64, 4, false, (unsigned)(WS_ACT + C_HID * 2), (unsigned)(WS_W + W_FO), 44, 5632u> SF; SF S{G, bx}; pg8::gemm_phase<EpiRes<false>, SF, true, APITCH, 2816>(lds, (const char*)ws, S, E, tid); }
            LAS float* red = (LAS float*)lds;
            for (int T = vcu; T < 256; T += G) { const int rb = T >> 4, cb = T & 15, row0 = SEQ + 16 * rb, col0 = 64 * cb, row = row0 + (tid >> 5), col = col0 + 2 * (tid & 31);
                f32x4 acc[4];
                if (!fo) small_tile_partial<4>(act + (size_t)row0 * APITCH + C_M, APITCH, wbase + W_O / 2 + (size_t)col0 * 1024, 1024, wave, lane, acc);
                else small_tile_partial<11>(act + (size_t)row0 * APITCH + C_HID, APITCH, wbase + W_FO / 2 + (size_t)col0 * 2816, 2816, wave, lane, acc);
                const f32x2 v = small_tile_reduce(red, acc, wave, lane, tid);
                const unsigned rw = *(const unsigned*)(act + (size_t)row * APITCH + C_XB + col);
                const f32x2 x = (f32x2){bflo(rw), bfhi(rw)} + v;
                *(unsigned*)(act + (size_t)row * APITCH + C_XB + col) = pk2(x[0], x[1]);
                float q = x[0] * x[0] + x[1] * x[1];
#pragma unroll
                for (int o = 1; o < 32; o <<= 1) q += __shfl_xor(q, o);
                if ((tid & 31) == 0) ss[(size_t)row * 16 + cb] = q; }
        } else if (sub == 6 && PHON(6)) {
            typedef SchedDense<64, 22, true, (unsigned)(WS_ACT + C_XB * 2), (unsigned)(WS_W + W_FI), 16, 2048u> SE;
            SE S{G, bx}; EpiE E{act, ss};
            for (int rep = 0; rep < REP_PE; ++rep) { int t2 = tid; asm volatile("" : "+v"(t2)); pg8::gemm_phase<EpiE, SE, true, APITCH, 1024>(lds, (const char*)ws, S, E, t2); }
        } else if (sub == 8 && l == 0) { if (PHON(9)) for (int rep = 0; rep < REP_WCONV; ++rep) { int t2 = tid; asm volatile("" : "+v"(t2)); phase_wconv(p, 1, lds, t2, wave, t2 & 63, vcu, G); } }
        else if (sub == 8 && PHON(8)) {
            const float* fg = p.in[19]; const int gw = vcu * 8 + wave, NGW = G * 8;
            for (int m = gw; m < MROWS; m += NGW) { const float rs = row_rstd_full(ss, m); float* yr = p.out + (size_t)m * DM; const bf16_t* xr = act + (size_t)m * APITCH + C_XB;
#pragma unroll
                for (int j = 0; j < 4; ++j) { const u32x2 w = *(const u32x2*)(xr + 256 * j + 4 * lane); const f32x4 g = *(const f32x4*)(fg + 256 * j + 4 * lane);
                    *(f32x4*)(yr + 256 * j + 4 * lane) = (f32x4){bflo(w.x), bfhi(w.x), bflo(w.y), bfhi(w.y)} * rs * g; } }
        }
        if ((SEC_PH >> ph) & 1) { TSEC_E(10); TSEC_B(11); }
        if (ph + 1 < p.ph_hi) for (int rep = 0; rep < REP_BAR; ++rep) xcd_barrier(bar);
        if ((SEC_PH >> ph) & 1) { TSEC_E(11); }
        if (TS_MASK) { if ((TS_MASK >> ph) & 1) ts_acc += __builtin_amdgcn_s_memrealtime() - ts0; }
    }
    if (TS_MASK) { if (bx == (TS_SEC ? TS_BLK : 0)) { if (TS_SEC) ts_acc = *(volatile LAS unsigned long long*)(lds + LDS_MISC + 136); const float f = 1.0f + (float)ts_acc * (1.0f / 100000.0f); for (int i = tid0; i < 15360; i += 512) p.out[O_POOLP + i] *= f; } }
}

extern "C" void kernel_launch(void* const* d_in, const int* in_sizes, int n_in, void* d_out, int out_size, void* d_ws, size_t ws_size, hipStream_t stream) {
    static int grid = 0;
    if (grid == 0) {
        if (n_in != 20 || out_size != (int)O_TOTAL || ws_size < WS_END) { fprintf(stderr, "kernel_launch: unexpected problem (n_in %d out %d ws %zu)\n", n_in, out_size, ws_size); grid = -1; return; }
        int dev = 0, cus = 0, per_cu = 0;
        if (hipGetDevice(&dev) != hipSuccess || hipDeviceGetAttribute(&cus, hipDeviceAttributeMultiprocessorCount, dev) != hipSuccess) { grid = -1; return; }
        if (hipFuncSetAttribute((const void*)mk_fwd, hipFuncAttributeMaxDynamicSharedMemorySize, LDS_BYTES) != hipSuccess) { fprintf(stderr, "kernel_launch: hipFuncSetAttribute failed\n"); grid = -1; return; }
        if (hipOccupancyMaxActiveBlocksPerMultiprocessor(&per_cu, (const void*)mk_fwd, 512, LDS_BYTES) != hipSuccess || per_cu < 1) { fprintf(stderr, "kernel_launch: occupancy query says %d\n", per_cu); per_cu = 1; }
        (void)hipGetLastError();
        grid = cus;
    }
    if (grid < 0) return;
    (void)hipMemsetAsync((char*)d_ws + WS_CTL, 0, CTL_BYTES, stream);
    Params a{};
    for (int i = 0; i < 20; ++i) a.in[i] = (const float*)d_in[i];
    a.out = (float*)d_out; a.ws = (unsigned char*)d_ws;
#if MK_ONE_LAUNCH
    a.ph_lo = 0; a.ph_hi = NPHASE;
    hipLaunchKernelGGL(mk_fwd, dim3(grid), dim3(512), LDS_BYTES, stream, a);
#else
    for (int ph = 0; ph < NPHASE; ++ph) { a.ph_lo = ph; a.ph_hi = ph + 1; hipLaunchKernelGGL(mk_fwd, dim3(grid), dim3(512), LDS_BYTES, stream, a); }
#endif
}
```
